# Optimizing an MI355X kernel written in HIP

```python
import jax, jax.numpy as jnp
from jax import lax
import numpy as np

D_MODEL = 1024
BATCH = 8
SEQ = 2048
DEPTH = 1
DEC_BATCH = 32
DEC_SEQ = 1
PAST_LEN = 8192
PAGE_SIZE = 128

D_MIX = D_MODEL
HEAD_DIM = 64
POOL_WIDTH = D_MIX // 4
POOL_WINDOWS = (2, 4, 8, 16)
POOL_GROUP = POOL_WIDTH // len(POOL_WINDOWS)
POOL_BUF = max(POOL_WINDOWS) - 1
MOBA_WIDTH = D_MIX // 2
MOBA_HEADS = MOBA_WIDTH // HEAD_DIM
MOBA_BLOCK = 256
MOBA_TOPK = 3
MOBA_Q_CHUNK = 32
MEM_WIDTH = D_MIX - POOL_WIDTH - MOBA_WIDTH
MEM_HEADS = MEM_WIDTH // HEAD_DIM
MEM_LEN = 256
ROT_DIM = HEAD_DIM // 4
ROPE_THETA = 500000.0
D_FF = 2816
RMS_EPS = 1e-6
IN_COLS = POOL_WIDTH + 3 * MOBA_WIDTH + MEM_WIDTH

kernel_name = "hymba_pool_moba_memxattn_macaron_step"


def rmsnorm(x, g):
    xf = x.astype(jnp.float32)
    y = xf * lax.rsqrt(jnp.mean(xf * xf, axis=-1, keepdims=True) + RMS_EPS)
    return (y * g.astype(jnp.float32)).astype(x.dtype)


def rotary(x, pos):
    half = ROT_DIM // 2
    inv = jnp.power(jnp.float32(ROPE_THETA), -jnp.arange(half, dtype=jnp.float32) * (2.0 / ROT_DIM))
    ang = pos.astype(jnp.float32)[:, None] * inv[None, :]
    cos = jnp.cos(ang)[None, :, None, :]
    sin = jnp.sin(ang)[None, :, None, :]
    xr = x[..., :ROT_DIM].astype(jnp.float32)
    x1, x2 = xr[..., :half], xr[..., half:]
    rot = jnp.concatenate([x1 * cos - x2 * sin, x2 * cos + x1 * sin], axis=-1).astype(x.dtype)
    return jnp.concatenate([rot, x[..., ROT_DIM:]], axis=-1)


def swiglu_ffn(x, g, w_in, w_out):
    gate, up = jnp.split(rmsnorm(x, g) @ w_in, 2, axis=-1)
    return (jax.nn.silu(gate) * up) @ w_out


def pool_mixer(u, buf, pos, pool_w, pool_scale):
    B, T, C = u.shape
    ext = jnp.concatenate([buf, u], axis=1).astype(jnp.float32)
    cs = jnp.concatenate([jnp.zeros((B, 1, C), jnp.float32), jnp.cumsum(ext, axis=1)], axis=1)
    end = cs[:, POOL_BUF + 1:]
    means = []
    for gi, w in enumerate(POOL_WINDOWS):
        sl = slice(gi * POOL_GROUP, (gi + 1) * POOL_GROUP)
        start = cs[:, POOL_BUF + 1 - w: POOL_BUF + 1 - w + T, sl]
        cnt = jnp.minimum(w, pos + 1).astype(jnp.float32)[None, :, None]
        means.append((end[..., sl] - start) / cnt)
    pooled = (jnp.concatenate(means, axis=-1) - ext[:, POOL_BUF:]).astype(u.dtype)
    pg = pooled.reshape(B, T, len(POOL_WINDOWS), POOL_GROUP)
    y = jnp.einsum("btgc,gcd->btgd", pg, pool_w).reshape(B, T, C) * pool_scale
    new_buf = ext[:, -POOL_BUF:].astype(u.dtype)
    return y, new_buf


def moba_attention(q, k, v, q_pos):
    B, Q, H, Dh = q.shape
    L = k.shape[1]
    nb = max(-(-L // MOBA_BLOCK), MOBA_TOPK)
    pad = nb * MOBA_BLOCK - L
    kb = jnp.pad(k, ((0, 0), (0, pad), (0, 0), (0, 0))).reshape(B, nb, MOBA_BLOCK, H, Dh)
    vb = jnp.pad(v, ((0, 0), (0, pad), (0, 0), (0, 0))).reshape(B, nb, MOBA_BLOCK, H, Dh)
    kmean = jnp.mean(kb.astype(jnp.float32), axis=2)
    qc = min(MOBA_Q_CHUNK, Q)
    n_ch = -(-Q // qc)
    qpad = n_ch * qc - Q
    qs = jnp.pad(q, ((0, 0), (0, qpad), (0, 0), (0, 0))).reshape(B, n_ch, qc, H, Dh).transpose(1, 0, 2, 3, 4)
    ps = jnp.pad(q_pos, (0, qpad), mode="edge").reshape(n_ch, qc)
    bi = jnp.arange(B)[:, None, None]
    hi = jnp.arange(H)[None, :, None]
    blk_pos = jnp.arange(MOBA_BLOCK, dtype=jnp.int32)
    scale = Dh ** -0.5

    def one_chunk(args):
        qch, pch = args
        qf = qch.astype(jnp.float32)
        own = pch // MOBA_BLOCK
        s = jnp.einsum("bqhd,bnhd->bhqn", qf, kmean)
        fully_past = jnp.arange(nb)[None, :] < own[:, None]
        s = jnp.where(fully_past[None, None], s, -jnp.inf)
        top_s, top_i = lax.top_k(s, MOBA_TOPK)
        idx = jnp.concatenate([top_i, jnp.broadcast_to(own[None, None, :, None], (B, H, qc, 1))], axis=-1)
        masks = [jnp.isfinite(top_s[..., i])[..., None] for i in range(MOBA_TOPK)]
        own_pos = own[:, None] * MOBA_BLOCK + blk_pos[None, :]
        masks.append((own_pos <= pch[:, None])[None, None])
        logits = []
        for i in range(MOBA_TOPK + 1):
            ks = kb[bi, idx[..., i], :, hi].astype(jnp.float32)
            lg = jnp.einsum("bqhd,bhqkd->bhqk", qf, ks) * scale
            logits.append(jnp.where(masks[i], lg, -jnp.inf))
        p = jax.nn.softmax(jnp.concatenate(logits, axis=-1), axis=-1)
        p = p.reshape(B, H, qc, MOBA_TOPK + 1, MOBA_BLOCK)
        out = sum(jnp.einsum("bhqk,bhqkd->bqhd", p[:, :, :, i], vb[bi, idx[..., i], :, hi].astype(jnp.float32))
                  for i in range(MOBA_TOPK + 1))
        return out.astype(q.dtype)

    out = lax.map(one_chunk, (qs, ps))
    return out.transpose(1, 0, 2, 3, 4).reshape(B, n_ch * qc, H, Dh)[:, :Q]


def mem_attention(q, mk, mv):
    lg = jnp.einsum("bthd,bmhd->bhtm", q.astype(jnp.float32), mk.astype(jnp.float32)) * (HEAD_DIM ** -0.5)
    p = jax.nn.softmax(lg, axis=-1)
    return jnp.einsum("bhtm,bmhd->bthd", p, mv.astype(jnp.float32)).astype(q.dtype)


def mem_kv(mem, mem_norm, mem_w_kv, mem_k_norm):
    B, M, _ = mem.shape
    mk, mv = jnp.split(rmsnorm(mem, mem_norm) @ mem_w_kv, 2, axis=-1)
    mk = rmsnorm(mk.reshape(B, M, MEM_HEADS, HEAD_DIM), mem_k_norm)
    return mk, mv.reshape(B, M, MEM_HEADS, HEAD_DIM)


def trunk_layer(x, pos, k_past, v_past, pool_buf, mk, mv,
                ffn1_norm, ffn1_w_in, ffn1_w_out, mix_norm, w_in, pool_w, pool_scale,
                q_norm, k_norm, mem_q_norm, w_out, ffn2_norm, ffn2_w_in, ffn2_w_out):
    B, T, _ = x.shape
    x = x + 0.5 * swiglu_ffn(x, ffn1_norm, ffn1_w_in, ffn1_w_out)
    h = rmsnorm(x, mix_norm)
    proj = h @ w_in
    c1 = POOL_WIDTH
    c2 = c1 + MOBA_WIDTH
    c3 = c2 + MOBA_WIDTH
    c4 = c3 + MOBA_WIDTH
    u, q, k, v, qm = proj[..., :c1], proj[..., c1:c2], proj[..., c2:c3], proj[..., c3:c4], proj[..., c4:]
    y_pool, new_buf = pool_mixer(u, pool_buf, pos, pool_w, pool_scale)
    q = rotary(rmsnorm(q.reshape(B, T, MOBA_HEADS, HEAD_DIM), q_norm), pos)
    k = rotary(rmsnorm(k.reshape(B, T, MOBA_HEADS, HEAD_DIM), k_norm), pos)
    v = v.reshape(B, T, MOBA_HEADS, HEAD_DIM)
    k_all = jnp.concatenate([k_past, k], axis=1)
    v_all = jnp.concatenate([v_past, v], axis=1)
    y_moba = moba_attention(q, k_all, v_all, pos).reshape(B, T, MOBA_WIDTH)
    qm = rmsnorm(qm.reshape(B, T, MEM_HEADS, HEAD_DIM), mem_q_norm)
    y_mem = mem_attention(qm, mk, mv).reshape(B, T, MEM_WIDTH)
    x = x + jnp.concatenate([y_pool, y_moba, y_mem], axis=-1) @ w_out
    x = x + 0.5 * swiglu_ffn(x, ffn2_norm, ffn2_w_in, ffn2_w_out)
    return x, k, v, new_buf


def setup_inputs(seed: int = 0) -> dict:
    key = jax.random.key(seed)
    ks = jax.random.split(key, 32)
    n_pages = PAST_LEN // PAGE_SIZE
    n_used = DEC_BATCH * n_pages
    n_phys = n_used + n_used // 4
    f32 = jnp.float32

    def nrm(k, shape, scale=1.0):
        return jax.random.normal(k, shape, f32) * scale

    def gain(k, shape):
        return 1.0 + 0.05 * jax.random.normal(k, shape, f32)

    page_table = jax.random.permutation(ks[8], n_phys)[:n_used].reshape(DEC_BATCH, n_pages).astype(jnp.int32)
    return {
        "x_prompt": nrm(ks[0], (BATCH, SEQ, D_MODEL)),
        "x_sample": nrm(ks[1], (DEC_BATCH, DEC_SEQ, D_MODEL)),
        "mem_prompt": nrm(ks[2], (BATCH, MEM_LEN, D_MODEL)),
        "cache_k": nrm(ks[3], (DEPTH, n_phys, PAGE_SIZE, MOBA_HEADS, HEAD_DIM)),
        "cache_v": nrm(ks[4], (DEPTH, n_phys, PAGE_SIZE, MOBA_HEADS, HEAD_DIM)),
        "cache_mem_k": nrm(ks[5], (DEPTH, DEC_BATCH, MEM_LEN, MEM_HEADS, HEAD_DIM)),
        "cache_mem_v": nrm(ks[6], (DEPTH, DEC_BATCH, MEM_LEN, MEM_HEADS, HEAD_DIM)),
        "state_pool": nrm(ks[7], (DEPTH, DEC_BATCH, POOL_BUF, POOL_WIDTH)),
        "page_table": page_table,
        "ffn1_norm": gain(ks[9], (DEPTH, D_MODEL)),
        "ffn1_w_in": nrm(ks[10], (DEPTH, D_MODEL, 2 * D_FF), D_MODEL ** -0.5),
        "ffn1_w_out": nrm(ks[11], (DEPTH, D_FF, D_MODEL), D_FF ** -0.5),
        "mix_norm": gain(ks[12], (DEPTH, D_MODEL)),
        "w_in": nrm(ks[13], (DEPTH, D_MODEL, IN_COLS), D_MODEL ** -0.5),
        "pool_w": nrm(ks[14], (DEPTH, len(POOL_WINDOWS), POOL_GROUP, POOL_GROUP), POOL_GROUP ** -0.5),
        "pool_scale": 1.0 + 0.1 * jax.random.normal(ks[15], (DEPTH, POOL_WIDTH), f32),
        "q_norm": gain(ks[16], (DEPTH, HEAD_DIM)),
        "k_norm": gain(ks[17], (DEPTH, HEAD_DIM)),
        "mem_norm": gain(ks[18], (DEPTH, D_MODEL)),
        "mem_w_kv": nrm(ks[19], (DEPTH, D_MODEL, 2 * MEM_WIDTH), D_MODEL ** -0.5),
        "mem_q_norm": gain(ks[20], (DEPTH, HEAD_DIM)),
        "mem_k_norm": gain(ks[21], (DEPTH, HEAD_DIM)),
        "w_out": nrm(ks[22], (DEPTH, D_MIX, D_MODEL), D_MIX ** -0.5),
        "ffn2_norm": gain(ks[23], (DEPTH, D_MODEL)),
        "ffn2_w_in": nrm(ks[24], (DEPTH, D_MODEL, 2 * D_FF), D_MODEL ** -0.5),
        "ffn2_w_out": nrm(ks[25], (DEPTH, D_FF, D_MODEL), D_FF ** -0.5),
    }


def reference(x_prompt, x_sample, mem_prompt, cache_k, cache_v, cache_mem_k, cache_mem_v, state_pool, page_table,
              ffn1_norm, ffn1_w_in, ffn1_w_out, mix_norm, w_in, pool_w, pool_scale, q_norm, k_norm,
              mem_norm, mem_w_kv, mem_q_norm, mem_k_norm, w_out, ffn2_norm, ffn2_w_in, ffn2_w_out):
    n_p, t_p, _ = x_prompt.shape
    n_s, t_s, _ = x_sample.shape
    past_len = page_table.shape[1] * PAGE_SIZE
    pos_p = jnp.arange(t_p, dtype=jnp.int32)
    pos_s = past_len + jnp.arange(t_s, dtype=jnp.int32)
    empty_kv = jnp.zeros((n_p, 0, MOBA_HEADS, HEAD_DIM), x_prompt.dtype)
    empty_buf = jnp.zeros((n_p, POOL_BUF, POOL_WIDTH), x_prompt.dtype)
    hp, hs = x_prompt, x_sample
    kp_l, vp_l, mkp_l, mvp_l, bp_l, ks_l, vs_l, bs_l = [], [], [], [], [], [], [], []
    for l in range(DEPTH):
        lw = (ffn1_norm[l], ffn1_w_in[l], ffn1_w_out[l], mix_norm[l], w_in[l], pool_w[l], pool_scale[l],
              q_norm[l], k_norm[l], mem_q_norm[l], w_out[l], ffn2_norm[l], ffn2_w_in[l], ffn2_w_out[l])
        mk_p, mv_p = mem_kv(mem_prompt, mem_norm[l], mem_w_kv[l], mem_k_norm[l])
        hp, kp, vp, bp = trunk_layer(hp, pos_p, empty_kv, empty_kv, empty_buf, mk_p, mv_p, *lw)
        k_past = cache_k[l][page_table].reshape(n_s, past_len, MOBA_HEADS, HEAD_DIM)
        v_past = cache_v[l][page_table].reshape(n_s, past_len, MOBA_HEADS, HEAD_DIM)
        hs, ksn, vsn, bs = trunk_layer(hs, pos_s, k_past, v_past, state_pool[l], cache_mem_k[l], cache_mem_v[l], *lw)
        kp_l.append(kp); vp_l.append(vp); mkp_l.append(mk_p); mvp_l.append(mv_p); bp_l.append(bp)
        ks_l.append(ksn); vs_l.append(vsn); bs_l.append(bs)
    return (hp, hs, jnp.stack(kp_l), jnp.stack(vp_l), jnp.stack(mkp_l), jnp.stack(mvp_l), jnp.stack(bp_l),
            jnp.stack(ks_l), jnp.stack(vs_l), jnp.stack(bs_l))
```

```cpp
#include <hip/hip_runtime.h>
#include <hip/hip_bf16.h>
#include <cstdio>
#include <cstdint>
#include <cmath>
constexpr int NWAVES = 8;
#ifndef MK_N_LAUNCHES
#define MK_N_LAUNCHES 8
#endif
constexpr int PER_PHASE = 8;
constexpr int N_LAUNCHES = MK_N_LAUNCHES;
static_assert(N_LAUNCHES == 1 || N_LAUNCHES == PER_PHASE, "MK_N_LAUNCHES is 1 or 8");

constexpr int DM = 1024, NB = 8, SEQ = 2048, MP = NB * SEQ;
constexpr int NS = 32, PAST = 8192, PAGE = 128, NPG = PAST / PAGE;
constexpr int FF = 2816, FF2 = 2 * FF, INC = 2048, MEML = 256, MM = NB * MEML;
constexpr float RMS_EPS = 1e-6f;
constexpr float C2 = 0.125f * 1.4426950408889634f;
constexpr size_t O_Y = 0, O_YS = O_Y + (size_t)MP * DM, O_KP = O_YS + (size_t)NS * DM, O_VP = O_KP + (size_t)MP * 512, O_MK = O_VP + (size_t)MP * 512, O_MV = O_MK + (size_t)MM * 256,
                 O_PS = O_MV + (size_t)MM * 256, O_KS = O_PS + (size_t)NB * 15 * 256, O_VS = O_KS + (size_t)NS * 512, O_PSS = O_VS + (size_t)NS * 512, O_END = O_PSS + (size_t)NS * 15 * 256;

constexpr size_t MiB = 1u << 20;
constexpr size_t WS_CTL = 0, CTL_ZERO_BYTES = 2 * MiB;
constexpr int CW_TMO = 0, CW_CODE = 1, CW_BAR = 4096;
constexpr int CW_SSQ1 = 16384, CW_SSQ2 = CW_SSQ1 + MP, CW_KSUM = CW_SSQ2 + MP, CW_END = CW_KSUM + NB * 8 * 8 * 64;
static_assert((size_t)CW_END * 4 <= CTL_ZERO_BYTES, "CTL words inside the memset region");
constexpr size_t WS_W1A = 2 * MiB, WS_W1B = WS_W1A + 11 * MiB, WS_W2A = WS_W1B + 6 * MiB, WS_W2B = WS_W2A + 11 * MiB, WS_WIN = WS_W2B + 6 * MiB, WS_WOUT = WS_WIN + 4 * MiB, WS_WMEM = WS_WOUT + 2 * MiB;
constexpr size_t WS_XB = WS_WMEM + 1 * MiB;
constexpr size_t WS_H = WS_XB + 32 * MiB;
constexpr size_t WS_X1 = WS_H + 88 * MiB;
constexpr size_t WS_U = WS_X1 + 64 * MiB, WS_Q = WS_U + 8 * MiB, WS_K = WS_Q + 16 * MiB, WS_V = WS_K + 16 * MiB, WS_QM = WS_V + 16 * MiB;
constexpr size_t WS_MNB = WS_QM + 8 * MiB, WS_MKB = WS_MNB + 4 * MiB, WS_MVB = WS_MKB + 1 * MiB, WS_MIX = WS_MVB + 1 * MiB;
constexpr size_t WS_ROPE = WS_MIX + 32 * MiB;
constexpr size_t WS_SKSUM = WS_ROPE + 1 * MiB;
constexpr size_t WS_SSQ0 = WS_SKSUM + 2 * MiB;
constexpr size_t WS_GAIN = WS_SSQ0 + 512 * 1024;
constexpr size_t WS_S = WS_SSQ0 + 1 * MiB;
constexpr size_t S_H = WS_S, S_X1 = S_H + 1 * MiB, S_X2 = S_X1 + 128 * 1024, S_U = S_X2 + 128 * 1024, S_Q = S_U + 32 * 1024, S_QM = S_Q + 64 * 1024, S_MIX = S_QM + 32 * 1024;
constexpr size_t WS_END = S_MIX + 128 * 1024;
static_assert(WS_W1B - WS_W1A >= (size_t)FF2 * DM * 2 && WS_W2A - WS_W1B >= (size_t)DM * FF * 2, "weight copies fit");

constexpr int RING_OFF = 0, RING_BYTES = 131072;
constexpr int LDSCTL_OFF = RING_BYTES, MISC_OFF = LDSCTL_OFF + 320;
constexpr int SM_OFF = RING_BYTES + 1024;
constexpr int LDS_BYTES = 147456;
static_assert(MISC_OFF + 128 <= SM_OFF && SM_OFF + 8192 <= LDS_BYTES, "LDS map");


namespace pg8 {
#define PG8_LAS __attribute__((address_space(3)))
typedef unsigned short bf16_t;
typedef short bf16x8 __attribute__((ext_vector_type(8)));
typedef float f32x4 __attribute__((ext_vector_type(4)));
typedef unsigned u32x4 __attribute__((ext_vector_type(4)));
constexpr int BM = 256, BK = 64, HALF = 128, HTB = HALF * BK * 2  , STAGE_BYTES = 8 * HTB, NXCD = 8, WGM = 8;

__host__ __device__ __forceinline__ int lds_byte(int r, int c) { const int st = (r >> 4) * 2 + (c >> 5), rr = r & 15, cc = c & 31, ob = rr * 64 + cc * 2; return st * 1024 + (ob ^ (((ob >> 9) & 1) << 5)); }
__host__ __device__ __forceinline__ void stage_rc(int b, int& R, int& C) { const int st = b / 1024, sb = b % 1024, swz = sb ^ (((sb >> 9) & 1) << 5); R = (st >> 1) * 16 + swz / 64; C = (st & 1) * 32 + (swz % 64) / 2; }
__host__ __device__ __forceinline__ int perm32(int rho) { const int n = rho >> 4, i = rho & 15; return 8 * (i >> 2) + 4 * n + (i & 3); }

struct Unit { int pm, pn; };
struct Gemm { const bf16_t* A; const bf16_t* Bt; int M, N, K; };

struct StaticOrder {
    int nM, nN, nwg, G, c;
    __host__ __device__ void init(int M, int N, int G_, int c_) { nM = M / BM; nN = N / BM; nwg = nM * nN; G = G_; c = c_; }
    __host__ __device__ bool next(int i, Unit& u) const {
        const long L = (long)i * G + c; if (L >= nwg) return false;
        int wgid = (int)L; { const int q = nwg / NXCD, r = nwg % NXCD, xcd = wgid % NXCD, off = wgid / NXCD; wgid = (xcd < r ? xcd * (q + 1) : r * (q + 1) + (xcd - r) * q) + off; }
        const int nig = WGM * nN, gid = wgid / nig, fm = gid * WGM, gsz = (nM - fm) < WGM ? (nM - fm) : WGM;
        u.pm = fm + ((wgid % nig) % gsz); u.pn = (wgid % nig) / gsz; return true;
    }
    __device__ __forceinline__ void a_ready(const Unit&) const {}
    __device__ __forceinline__ void done(const Unit&) const {}
};

__device__ __forceinline__ unsigned cvt_pk_bf16(float lo, float hi) { unsigned r; asm volatile("v_cvt_pk_bf16_f32 %0, %1, %2" : "=v"(r) : "v"(lo), "v"(hi)); return r; }
typedef float f32x2 __attribute__((ext_vector_type(2)));
__device__ __forceinline__ f32x2 gelu_pk(f32x2 v) {
    const f32x2 av = __builtin_elementwise_abs(v), d = av * 0.2316418882f + 1.0f;
    f32x2 t; t.x = __builtin_amdgcn_rcpf(d.x); t.y = __builtin_amdgcn_rcpf(d.y);
    f32x2 q = t * 0.5307027145f + (-0.7265760135f); q = q * t + 0.7107068705f; q = q * t + (-0.142248368f); q = q * t + 0.127414796f; q = q * t;
    const f32x2 s = (v * v) * (-0.72134752044f);
    f32x2 e; e.x = __builtin_amdgcn_exp2f(s.x); e.y = __builtin_amdgcn_exp2f(s.y);
    const f32x2 m = v * (q * e), r = v - m;
    f32x2 o; o.x = v.x < 0.f ? m.x : r.x; o.y = v.y < 0.f ? m.y : r.y; return o;
}

constexpr float RMS_EPS_ = 1e-6f;
__device__ __forceinline__ float silu_f(float x) { return x * __builtin_amdgcn_rcpf(1.0f + __builtin_amdgcn_exp2f(-1.4426950408889634f * x)); }
__device__ __forceinline__ u32x4 pack8(const f32x4 a, const f32x4 b) { u32x4 w; w.x = cvt_pk_bf16(a[0], a[1]); w.y = cvt_pk_bf16(a[2], a[3]); w.z = cvt_pk_bf16(b[0], b[1]); w.w = cvt_pk_bf16(b[2], b[3]); return w; }

struct ListOrder {
    int nM, cnt, idx;
    __device__ __forceinline__ void init(int nM_, int nN_, int first, int c) { nM = nM_; cnt = nM_ * nN_; idx = c - first; }
    __device__ __forceinline__ bool next(int i, Unit& u) const { if (i > 0 || idx < 0 || idx >= cnt) return false; u.pm = idx % nM; u.pn = idx / nM; return true; }
    __device__ __forceinline__ void a_ready(const Unit&) const {}
    __device__ __forceinline__ void done(const Unit&) const {}
};

struct EpiSwiglu {
    static constexpr bool PERM = true, AFTER_DRAIN = false;
    bf16_t* H; const float* ssq; int ldh;
    __device__ __forceinline__ void operator()(const f32x4 (&acc)[2][2][4][2], const Unit& u, int wr, int wc, int fr, int fq) const {
        const int row0 = u.pm * BM + wr * 64 + fr, col0 = u.pn * HALF + wc * 32 + 8 * fq;
#pragma unroll
        for (int ai = 0; ai < 2; ++ai)
#pragma unroll
            for (int m = 0; m < 4; ++m) { const int row = row0 + ai * HALF + m * 16; const float rr = __builtin_amdgcn_rsqf(ssq[row] * (1.0f / 1024.0f) + RMS_EPS_);
                f32x4 h0, h1;
#pragma unroll
                for (int i = 0; i < 4; ++i) { h0[i] = silu_f(acc[ai][0][m][0][i] * rr) * (acc[ai][1][m][0][i] * rr); h1[i] = silu_f(acc[ai][0][m][1][i] * rr) * (acc[ai][1][m][1][i] * rr); }
                *(u32x4*)(H + (size_t)row * ldh + col0) = pack8(h0, h1); }
    }
};

template <bool COPY> struct EpiResid {
    static constexpr bool PERM = true, AFTER_DRAIN = false;
    const float* base; float* out; bf16_t* xb; float* ssq; float alpha;
    __device__ __forceinline__ void operator()(const f32x4 (&acc)[2][2][4][2], const Unit& u, int wr, int wc, int fr, int fq) const {
        const int row0 = u.pm * BM + wr * 64 + fr, col0 = u.pn * BM + wc * 32 + 8 * fq;
#pragma unroll
        for (int ai = 0; ai < 2; ++ai)
#pragma unroll
            for (int m = 0; m < 4; ++m) { const int row = row0 + ai * HALF + m * 16; const size_t off = (size_t)row * 1024 + col0; float ss = 0.f;
#pragma unroll
                for (int bj = 0; bj < 2; ++bj) { const f32x4 b0 = *(const f32x4*)(base + off + bj * HALF), b1 = *(const f32x4*)(base + off + bj * HALF + 4);
                    const f32x4 o0 = b0 + alpha * acc[ai][bj][m][0], o1 = b1 + alpha * acc[ai][bj][m][1];
                    *(f32x4*)(out + off + bj * HALF) = o0; *(f32x4*)(out + off + bj * HALF + 4) = o1;
                    if (COPY) { *(u32x4*)(xb + off + bj * HALF) = pack8(o0, o1);
                        ss += (o0[0] * o0[0] + o0[1] * o0[1]) + (o0[2] * o0[2] + o0[3] * o0[3]) + (o1[0] * o1[0] + o1[1] * o1[1]) + (o1[2] * o1[2] + o1[3] * o1[3]); } }
                if (COPY) { ss += __shfl_xor(ss, 16); ss += __shfl_xor(ss, 32); if (fq == 0) atomicAdd(ssq + row, ss); }
                if (m & 1) asm volatile("" ::: "memory"); }
    }
};

__device__ __forceinline__ void head_rows(const f32x4 (&acc)[2][2][4][2], const int rowb, const int fq, const int fr, const float* ssq, const float* rope, float* pstate,
        const bool o_norm, const bool o_rot, const bool o_f32o, const bool o_ks, const bool o_pst, const float o_sc, bf16_t* o_ob, const int o_ldb, float* o_of, const int o_ldf, const float* o_gain, const int o_hcol, float* o_ksum) {
    f32x4 g[2][2];
#pragma unroll
    for (int bj = 0; bj < 2; ++bj)
#pragma unroll
        for (int n = 0; n < 2; ++n) g[bj][n] = o_norm ? *(const f32x4*)(o_gain + 32 * bj + 8 * fq + 4 * n) : (f32x4){1.f, 1.f, 1.f, 1.f};
    f32x4 cs[2][2];
#pragma unroll
    for (int bj = 0; bj < 2; ++bj)
#pragma unroll
        for (int n = 0; n < 2; ++n) cs[bj][n] = (f32x4){0.f, 0.f, 0.f, 0.f};
#pragma unroll
    for (int ai = 0; ai < 2; ++ai)
#pragma unroll
        for (int m = 0; m < 4; ++m) { const int row = rowb + ai * HALF + m * 16; const float rr = __builtin_amdgcn_rsqf(ssq[row] * (1.0f / 1024.0f) + RMS_EPS_);
            f32x4 v[2][2];
#pragma unroll
            for (int bj = 0; bj < 2; ++bj)
#pragma unroll
                for (int n = 0; n < 2; ++n) v[bj][n] = acc[ai][bj][m][n] * rr;
            { float ss = 0.f;
#pragma unroll
                for (int bj = 0; bj < 2; ++bj)
#pragma unroll
                    for (int n = 0; n < 2; ++n) ss += (v[bj][n][0] * v[bj][n][0] + v[bj][n][1] * v[bj][n][1]) + (v[bj][n][2] * v[bj][n][2] + v[bj][n][3] * v[bj][n][3]);
                ss += __shfl_xor(ss, 16); ss += __shfl_xor(ss, 32);
                const float hn = o_norm ? __builtin_amdgcn_rsqf(ss * (1.0f / 64.0f) + RMS_EPS_) : 1.0f;
#pragma unroll
                for (int bj = 0; bj < 2; ++bj)
#pragma unroll
                    for (int n = 0; n < 2; ++n) v[bj][n] = v[bj][n] * hn * g[bj][n];
            }
            if (o_rot) { const int pos = row & 2047; const float* rp = rope + pos * 16;
#pragma unroll
                for (int n = 0; n < 2; ++n) { const f32x4 t0 = *(const f32x4*)(rp + 8 * n), t1 = *(const f32x4*)(rp + 8 * n + 4);
                    const f32x4 x = v[0][n]; f32x4 y;
#pragma unroll
                    for (int i = 0; i < 4; ++i) y[i] = __shfl_xor(x[i], 16);
                    const float sg = (fq == 0) ? -1.f : 1.f;
                    f32x4 r_;
                    r_[0] = x[0] * t0[0] + sg * y[0] * t0[1]; r_[1] = x[1] * t0[2] + sg * y[1] * t0[3]; r_[2] = x[2] * t1[0] + sg * y[2] * t1[1]; r_[3] = x[3] * t1[2] + sg * y[3] * t1[3];
                    if (fq < 2) v[0][n] = r_; }
            }
#pragma unroll
            for (int bj = 0; bj < 2; ++bj)
#pragma unroll
                for (int n = 0; n < 2; ++n) cs[bj][n] += v[bj][n];
#pragma unroll
            for (int bj = 0; bj < 2; ++bj) { const int col = o_hcol + 32 * bj + 8 * fq;
                if (o_f32o) { *(f32x4*)(o_of + (size_t)row * o_ldf + col) = v[bj][0]; *(f32x4*)(o_of + (size_t)row * o_ldf + col + 4) = v[bj][1]; }
                if (o_pst) { const int t = row & 2047; if (t >= 2033) { float* pp = pstate + ((size_t)(row >> 11) * 15 + (t - 2033)) * 256 + col; *(f32x4*)pp = v[bj][0]; *(f32x4*)(pp + 4) = v[bj][1]; } }
                *(u32x4*)(o_ob + (size_t)row * o_ldb + col) = pack8(v[bj][0] * o_sc, v[bj][1] * o_sc); }
            asm volatile("" ::: "memory"); }
    if (o_ks) {
#pragma unroll
        for (int bj = 0; bj < 2; ++bj)
#pragma unroll
            for (int n = 0; n < 2; ++n)
#pragma unroll
                for (int i = 0; i < 4; ++i) { float s = cs[bj][n][i]; s += __shfl_xor(s, 1); s += __shfl_xor(s, 2); s += __shfl_xor(s, 4); s += __shfl_xor(s, 8);
                    if (fr == 0) atomicAdd(o_ksum + 32 * bj + 8 * fq + 4 * n + i, s); }
    }
}
template <bool MEM> struct EpiHead {
    static constexpr bool PERM = true, AFTER_DRAIN = false;
    const float* ssq; const float* rope; float* outp; float* ksum; unsigned char* ws; float c2;
    __device__ __forceinline__ void operator()(const f32x4 (&acc)[2][2][4][2], const Unit& u, int wr, int wc, int fr, int fq) const {
        const int rowb = u.pm * BM + wr * 64 + fr; const int pn = u.pn;
        const float* gains = (const float*)(ws + WS_GAIN);
        if (MEM) {
            head_rows(acc, rowb, fq, fr, ssq, rope, outp + O_PS, pn == 0, false, true, false, false, 1.f, (bf16_t*)(ws + (pn == 0 ? WS_MKB : WS_MVB)), 256, outp + (pn == 0 ? O_MK : O_MV), 256, gains + 3 * 64, 64 * wc, ksum);
        } else {
            const bool isq = (pn == 1 || pn == 2), isk = (pn == 3 || pn == 4), isv = (pn == 5 || pn == 6), ism = (pn == 7);
            const size_t boff = pn == 0 ? WS_U : (isq ? WS_Q : (isk ? WS_K : (isv ? WS_V : WS_QM)));
            head_rows(acc, rowb, fq, fr, ssq, rope, outp + O_PS, isq || isk || ism, isq || isk, isk || isv, isk, pn == 0, (isq || ism) ? c2 : 1.f, (bf16_t*)(ws + boff), (pn == 0 || ism) ? 256 : 512,
                      outp + (isk ? O_KP : O_VP), 512, gains + (isq ? 0 : (isk ? 64 : 128)), ((pn == 0 || ism) ? 0 : 256 * ((pn - 1) & 1)) + 64 * wc, ksum + (size_t)u.pm * 512 + (4 * ((pn - 1) & 1) + wc) * 64);
        }
    }
};

template <class Epi, class Sched, bool ALIGN_EPI = false, bool SP2 = false>
__device__ __forceinline__ void gemm_phase(PG8_LAS unsigned char* lds, const Gemm g, const Sched& S, const Epi& E) {
    const int tid = threadIdx.x, wid = __builtin_amdgcn_readfirstlane(tid >> 6), lane = tid & 63, wr = wid >> 2, wc = wid & 3, fr = lane & 15, fq = lane >> 4;
    const int K = g.K, nt = K / BK;
    unsigned voffA[2], voffB[2];
#pragma unroll
    for (int i = 0; i < 2; ++i) { int R, C; stage_rc(tid * 16 + i * 8192, R, C); const int Rb = Epi::PERM ? ((R & ~31) + perm32(R & 31)) : R;
        voffA[i] = (unsigned)(R * K + C) * 2u; voffB[i] = (unsigned)(Rb * K + C) * 2u; }
    const size_t kstep = (size_t)(BK * 2);
    const size_t hstep = (size_t)HALF * K * 2;
    const size_t tstep = 2 * hstep;
    const unsigned ldsw = (unsigned)wid * 1024u;
    const int aoff = lds_byte(wr * 64 + fr, fq * 8), boff = lds_byte(wc * 32 + fr, fq * 8);
#define PG8_SA(b, h) (((b) * 2 + (h)) * HTB)
#define PG8_SB(b, h) ((4 + (b) * 2 + (h)) * HTB)
#define PG8_STAGE(bufoff, gbase, voff) do { _Pragma("unroll") for (int _i = 0; _i < 2; ++_i) \
        __builtin_amdgcn_global_load_lds((const unsigned*)((const char*)(gbase) + (voff)[_i]), (PG8_LAS unsigned*)(lds + (bufoff) + ldsw + _i * 8192), 16, 0, 0); } while (0)
#define PG8_LDA(dst, b, h) do { _Pragma("unroll") for (int m = 0; m < 4; ++m) _Pragma("unroll") for (int k = 0; k < 2; ++k) dst[m][k] = *(const PG8_LAS bf16x8*)(lds + PG8_SA(b, h) + aoff + m * 2048 + k * 1024); } while (0)
#define PG8_LDB(dst, b, h) do { _Pragma("unroll") for (int n = 0; n < 2; ++n) _Pragma("unroll") for (int k = 0; k < 2; ++k) dst[n][k] = *(const PG8_LAS bf16x8*)(lds + PG8_SB(b, h) + boff + n * 2048 + k * 1024); } while (0)
#define PG8_MMA(ai, bj, At, Bt) do { __builtin_amdgcn_s_setprio(1); _Pragma("unroll") for (int m = 0; m < 4; ++m) _Pragma("unroll") for (int n = 0; n < 2; ++n) _Pragma("unroll") for (int k = 0; k < 2; ++k) \
        acc[ai][bj][m][n] = __builtin_amdgcn_mfma_f32_16x16x32_bf16(Bt[n][k], At[m][k], acc[ai][bj][m][n], 0, 0, 0); __builtin_amdgcn_s_setprio(0); } while (0)
#define PG8_WAIT_V(n) asm volatile("s_waitcnt vmcnt(" #n ")" ::: "memory")
#define PG8_WAIT_L(n) asm volatile("s_waitcnt lgkmcnt(" #n ")" ::: "memory")
#define PG8_BAR __builtin_amdgcn_s_barrier()
#define PG8_SCHED __builtin_amdgcn_sched_barrier(0)
    Unit cur, nxt; int ui = 0;
    if (!S.next(0, cur)) return;
    f32x4 acc[2][2][4][2];
#pragma unroll
    for (int a = 0; a < 2; ++a)
#pragma unroll
        for (int b = 0; b < 2; ++b)
#pragma unroll
            for (int m = 0; m < 4; ++m)
#pragma unroll
                for (int n = 0; n < 2; ++n) acc[a][b][m][n] = (f32x4){0.f, 0.f, 0.f, 0.f};
    bf16x8 At[4][2], B0[2][2], B1[2][2];
    const char* cA = (const char*)g.A + (size_t)cur.pm * tstep; const char* cB = (const char*)g.Bt + (size_t)cur.pn * tstep;
    S.a_ready(cur);
    if constexpr (SP2) {
        PG8_STAGE(PG8_SB(0, 0), cB, voffB); PG8_STAGE(PG8_SB(0, 1), cB + hstep, voffB); PG8_STAGE(PG8_SA(0, 0), cA, voffA); PG8_STAGE(PG8_SA(0, 1), cA + hstep, voffA);
        if (wr == 1) PG8_BAR;
        PG8_WAIT_V(2); PG8_BAR;
        PG8_STAGE(PG8_SB(1, 0), cB + kstep, voffB); PG8_STAGE(PG8_SA(1, 0), cA + kstep, voffA); PG8_STAGE(PG8_SB(1, 1), cB + hstep + kstep, voffB);
        PG8_WAIT_V(6); PG8_BAR;
    } else {
        PG8_STAGE(PG8_SB(0, 0), cB, voffB); PG8_STAGE(PG8_SA(0, 0), cA, voffA); PG8_STAGE(PG8_SB(0, 1), cB + hstep, voffB); PG8_STAGE(PG8_SA(0, 1), cA + hstep, voffA);
        if (wr == 1) PG8_BAR;
        PG8_WAIT_V(4); PG8_BAR;
        PG8_STAGE(PG8_SB(1, 0), cB + kstep, voffB); PG8_STAGE(PG8_SA(1, 0), cA + kstep, voffA); PG8_STAGE(PG8_SB(1, 1), cB + hstep + kstep, voffB);
        PG8_WAIT_V(6); PG8_BAR;
    }
    for (;;) {
        const bool has_next = S.next(ui + 1, nxt);
        const char* nA = has_next ? (const char*)g.A + (size_t)nxt.pm * tstep : cA; const char* nB = has_next ? (const char*)g.Bt + (size_t)nxt.pn * tstep : cB;
        for (int t = 0; t < nt; t += 2) {
            const bool last = (t == nt - 2);
            const char* a1 = cA + (size_t)(t + 1) * kstep;
            const char* a2 = last ? nA : cA + (size_t)(t + 2) * kstep; const char* b2 = last ? nB : cB + (size_t)(t + 2) * kstep;
            const char* a3 = a2 + kstep; const char* b3 = b2 + kstep;
            if (last && has_next) S.a_ready(nxt);
            if constexpr (SP2) {
            PG8_LDB(B0, 0, 0); PG8_LDB(B1, 0, 1); PG8_SCHED; PG8_LDA(At, 0, 0); PG8_STAGE(PG8_SA(1, 1), a1 + hstep, voffA);
            PG8_WAIT_V(8); PG8_WAIT_L(0); PG8_BAR; PG8_MMA(0, 0, At, B0); PG8_MMA(0, 1, At, B1); PG8_BAR; PG8_SCHED;
            PG8_LDA(At, 0, 1); PG8_STAGE(PG8_SB(0, 0), b2, voffB); PG8_STAGE(PG8_SB(0, 1), b2 + hstep, voffB); PG8_STAGE(PG8_SA(0, 0), a2, voffA);
            PG8_WAIT_V(8); PG8_WAIT_L(0); PG8_BAR; PG8_MMA(1, 0, At, B0); PG8_MMA(1, 1, At, B1); PG8_BAR; PG8_SCHED;
            PG8_LDB(B0, 1, 0); PG8_LDB(B1, 1, 1); PG8_SCHED; PG8_LDA(At, 1, 0); PG8_STAGE(PG8_SA(0, 1), a2 + hstep, voffA);
            PG8_WAIT_V(8); PG8_WAIT_L(0); PG8_BAR; PG8_MMA(0, 0, At, B0); PG8_MMA(0, 1, At, B1); PG8_BAR; PG8_SCHED;
            PG8_LDA(At, 1, 1); PG8_STAGE(PG8_SB(1, 0), b3, voffB); PG8_STAGE(PG8_SB(1, 1), b3 + hstep, voffB); PG8_STAGE(PG8_SA(1, 0), a3, voffA);
            PG8_WAIT_V(8); PG8_WAIT_L(0); PG8_BAR; PG8_MMA(1, 0, At, B0); PG8_MMA(1, 1, At, B1); PG8_BAR; PG8_SCHED;
            } else {
            PG8_LDB(B0, 0, 0); PG8_SCHED; PG8_LDA(At, 0, 0); PG8_STAGE(PG8_SA(1, 1), a1 + hstep, voffA);
            PG8_WAIT_L(8); PG8_BAR; PG8_WAIT_L(0); PG8_MMA(0, 0, At, B0); PG8_BAR; PG8_SCHED;
            PG8_LDB(B1, 0, 1); PG8_STAGE(PG8_SB(0, 0), b2, voffB);
            PG8_BAR; PG8_WAIT_L(0); PG8_MMA(0, 1, At, B1); PG8_BAR;
            PG8_LDA(At, 0, 1); PG8_STAGE(PG8_SA(0, 0), a2, voffA);
            PG8_BAR; PG8_WAIT_L(0); PG8_MMA(1, 0, At, B0); PG8_BAR; PG8_SCHED;
            PG8_STAGE(PG8_SB(0, 1), b2 + hstep, voffB);
            PG8_WAIT_V(6); PG8_BAR; PG8_MMA(1, 1, At, B1); PG8_BAR;
            PG8_LDB(B0, 1, 0); PG8_SCHED; PG8_LDA(At, 1, 0); PG8_STAGE(PG8_SA(0, 1), a2 + hstep, voffA);
            PG8_WAIT_L(8); PG8_BAR; PG8_WAIT_L(0); PG8_MMA(0, 0, At, B0); PG8_BAR; PG8_SCHED;
            PG8_LDB(B1, 1, 1); PG8_STAGE(PG8_SB(1, 0), b3, voffB);
            PG8_BAR; PG8_WAIT_L(0); PG8_MMA(0, 1, At, B1); PG8_BAR;
            PG8_LDA(At, 1, 1); PG8_STAGE(PG8_SA(1, 0), a3, voffA);
            PG8_BAR; PG8_WAIT_L(0); PG8_MMA(1, 0, At, B0); PG8_BAR; PG8_SCHED;
            PG8_STAGE(PG8_SB(1, 1), b3 + hstep, voffB);
            PG8_WAIT_V(6); PG8_BAR; PG8_MMA(1, 1, At, B1); PG8_BAR;
            }
        }
        if constexpr (ALIGN_EPI) { if (wr == 0) PG8_BAR; }
        if constexpr (!Epi::AFTER_DRAIN) { E(acc, cur, wr, wc, fr, fq); S.done(cur); }
        if (!has_next) break;
#pragma unroll
        for (int a = 0; a < 2; ++a)
#pragma unroll
            for (int b = 0; b < 2; ++b)
#pragma unroll
                for (int m = 0; m < 4; ++m)
#pragma unroll
                    for (int n = 0; n < 2; ++n) acc[a][b][m][n] = (f32x4){0.f, 0.f, 0.f, 0.f};
        cur = nxt; cA = nA; cB = nB; ++ui;
        if constexpr (ALIGN_EPI) { if (wr == 1) PG8_BAR; }
    }
    PG8_WAIT_V(0);
    if constexpr (!ALIGN_EPI) { if (wr == 0) PG8_BAR; }
    PG8_BAR;
    if constexpr (Epi::AFTER_DRAIN) { E.fused(acc, cur, wr, wc, fr, fq, lds, wid, lane); S.done(cur); }
#undef PG8_SA
#undef PG8_SB
#undef PG8_STAGE
#undef PG8_LDA
#undef PG8_LDB
#undef PG8_MMA
#undef PG8_WAIT_V
#undef PG8_WAIT_L
#undef PG8_BAR
#undef PG8_SCHED
}
}

namespace attn_body {
using bf16=__hip_bfloat16;
using bf16x8=__attribute__((ext_vector_type(8)))short;
using s16x4=__attribute__((ext_vector_type(4)))short;
using f32x16=__attribute__((ext_vector_type(16)))float;
using u32x4=__attribute__((ext_vector_type(4)))unsigned;
using f32x4_t=__attribute__((ext_vector_type(4)))float;
__device__ __forceinline__ float bf2f(short s){return __uint_as_float(((unsigned)(unsigned short)s)<<16);}
constexpr int D=64;
constexpr int NW=8,QBLK=32,QB=QBLK*NW,KVBLK=64;
constexpr int ATTN_UNIT_ROWS=QB;
__device__ __forceinline__ int crow(int r,int hi){return (r&3)+8*(r>>2)+4*hi;}
#define SBAR() __builtin_amdgcn_sched_barrier(0)
__device__ __forceinline__ void cmask(f32x16&p0,f32x16&p1,int jb,int qrel,int hi){
  const float NEG=-INFINITY; int kb=64*jb+4*hi;
  #pragma unroll
  for(int r=0;r<16;++r){int kv=kb+(r&3)+8*(r>>2); if(kv>qrel)p0[r]=NEG; if(kv+32>qrel)p1[r]=NEG;}
}

constexpr int NSLOT=3, SLOTB=8192;
constexpr int LDS_K=0, LDS_V=NSLOT*SLOTB, LDS_WS=2*NSLOT*SLOTB, LDS_OST=LDS_WS+NW*64*4, LDS_BYTES=LDS_OST+NW*4096;
constexpr float C2=0.125f*1.4426950408889634f;
__device__ __forceinline__ void glds16(const void*gsrc,unsigned lds_dst){unsigned keep;
  asm volatile("s_mov_b32 %0, m0\n\ts_mov_b32 m0, %2\n\ts_nop 0\n\tglobal_load_lds_dwordx4 %1, off\n\ts_mov_b32 m0, %0":"=&s"(keep):"v"(gsrc),"s"(lds_dst):"memory");}
__device__ __forceinline__ float max3f(float a,float b,float c){float r;asm("v_max3_f32 %0, %1, %2, %3":"=v"(r):"v"(a),"v"(b),"v"(c));return r;}
__device__ __forceinline__ float max2f(float a,float b){float r;asm("v_max_f32_e32 %0, %1, %2":"=v"(r):"v"(a),"v"(b));return r;}
__device__ __forceinline__ float fadd_s(float a,float b){float r;asm("v_add_f32_e32 %0, %1, %2":"=v"(r):"v"(a),"v"(b));return r;}
__device__ __forceinline__ float fsub_s(float a,float b){float r;asm("v_sub_f32_e32 %0, %1, %2":"=v"(r):"v"(a),"v"(b));return r;}
typedef float f32x2_t __attribute__((ext_vector_type(2))); typedef __bf16 bf16x2_t __attribute__((ext_vector_type(2)));
__device__ __forceinline__ unsigned cvtpk_s(float lo,float hi){f32x2_t v={lo,hi};bf16x2_t b=__builtin_convertvector(v,bf16x2_t);return __builtin_bit_cast(unsigned,b);}
#define WAIT_BAR(N) asm volatile("s_waitcnt vmcnt(" #N ") lgkmcnt(0)\n\ts_barrier":::"memory")

__device__ __forceinline__ void qkt(f32x16&p0,f32x16&p1,const char*Kslot,const bf16x8*qr,const f32x16&negm,int r32,int hi){
  const char*kb=Kslot+hi*1024+r32*16;
  #pragma unroll
  for(int d0=0;d0<4;++d0){
    const bf16x8 b0=*reinterpret_cast<const bf16x8*>(kb+d0*2048);
    const bf16x8 b1=*reinterpret_cast<const bf16x8*>(kb+d0*2048+512);
    if(d0==0){p0=__builtin_amdgcn_mfma_f32_32x32x16_bf16(b0,qr[0],negm,0,0,0);p1=__builtin_amdgcn_mfma_f32_32x32x16_bf16(b1,qr[0],negm,0,0,0);}
    else{p0=__builtin_amdgcn_mfma_f32_32x32x16_bf16(b0,qr[d0],p0,0,0,0);p1=__builtin_amdgcn_mfma_f32_32x32x16_bf16(b1,qr[d0],p1,0,0,0);}}
}
typedef __attribute__((address_space(3))) const char* lds_cptr;
typedef short v4i16_t __attribute__((ext_vector_type(4)));
__device__ __forceinline__ void kload8(bf16x8*kf,lds_cptr kp){
  kf[0]=*(const __attribute__((address_space(3))) bf16x8*)(kp);      kf[1]=*(const __attribute__((address_space(3))) bf16x8*)(kp+512);
  kf[2]=*(const __attribute__((address_space(3))) bf16x8*)(kp+2048); kf[3]=*(const __attribute__((address_space(3))) bf16x8*)(kp+2560);
  kf[4]=*(const __attribute__((address_space(3))) bf16x8*)(kp+4096); kf[5]=*(const __attribute__((address_space(3))) bf16x8*)(kp+4608);
  kf[6]=*(const __attribute__((address_space(3))) bf16x8*)(kp+6144); kf[7]=*(const __attribute__((address_space(3))) bf16x8*)(kp+6656);
}
__device__ __forceinline__ void kload2(bf16x8*kf,lds_cptr kp,int j){ kf[2*j]=*(const __attribute__((address_space(3))) bf16x8*)(kp+j*2048); kf[2*j+1]=*(const __attribute__((address_space(3))) bf16x8*)(kp+j*2048+512); }
__device__ __forceinline__ s16x4 vtr(lds_cptr p){ return __builtin_bit_cast(s16x4,__builtin_amdgcn_ds_read_tr16_b64_v4i16((__attribute__((address_space(3))) v4i16_t*)p)); }
__device__ __forceinline__ float rowmax(const f32x16&p0,const f32x16&p1){
  float a=max3f(p0[0],p0[1],p1[0]),b=max3f(p0[2],p0[3],p1[1]);a=max3f(a,p1[2],p1[3]);
  #pragma unroll
  for(int r=4;r<16;r+=4){a=max3f(a,p0[r],p0[r+1]);b=max3f(b,p0[r+2],p0[r+3]);a=max3f(a,p1[r],p1[r+1]);b=max3f(b,p1[r+2],p1[r+3]);}
  const float m=max2f(a,b);
  auto rr=__builtin_amdgcn_permlane32_swap(__float_as_uint(m),__float_as_uint(m),false,false);
  return max2f(__uint_as_float(rr[0]),__uint_as_float(rr[1]));
}
__device__ __forceinline__ void pv(f32x16*o,int vb,bf16x8 pa0,bf16x8 pa1,bf16x8 pa2,bf16x8 pa3){
  #pragma unroll
  for(int d0=0;d0<2;++d0){s16x4 lo[4],hi[4];
    #pragma unroll
    for(int ks=0;ks<4;++ks){
      asm volatile("ds_read_b64_tr_b16 %0,%1 offset:%c2":"=&v"(lo[ks]):"v"(vb),"i"(d0*4096+ks*1024):"memory");
      asm volatile("ds_read_b64_tr_b16 %0,%1 offset:%c2":"=&v"(hi[ks]):"v"(vb),"i"(d0*4096+ks*1024+512):"memory");}
    asm volatile("s_waitcnt lgkmcnt(0)":::"memory");SBAR();
    #define PK(k) (bf16x8){lo[k][0],lo[k][1],lo[k][2],lo[k][3],hi[k][0],hi[k][1],hi[k][2],hi[k][3]}
    o[d0]=__builtin_amdgcn_mfma_f32_32x32x16_bf16(pa0,PK(0),o[d0],0,0,0);
    o[d0]=__builtin_amdgcn_mfma_f32_32x32x16_bf16(pa1,PK(1),o[d0],0,0,0);
    o[d0]=__builtin_amdgcn_mfma_f32_32x32x16_bf16(pa2,PK(2),o[d0],0,0,0);
    o[d0]=__builtin_amdgcn_mfma_f32_32x32x16_bf16(pa3,PK(3),o[d0],0,0,0);
    #undef PK
  }
}

#ifndef ATTN_STORE16
#define ATTN_STORE16(p,v) (*(u32x4*)(p)=(v))
#endif
template<int THRL,int MODE,int QP,int KP,int OP> __device__ __forceinline__ void attn_unit(const bf16*Qu,const bf16*__restrict__ Kh,const bf16*__restrict__ Vh,bf16*Ou,const int NT,const __attribute__((address_space(3))) unsigned char*seltab,char*shm){
  const int tid=threadIdx.x,lane=tid&63,r32=lane&31,hi=lane>>5; const int wid=__builtin_amdgcn_readfirstlane(tid>>6);
  const bf16*Qw=Qu+(long)(wid*QBLK)*QP;
  const unsigned lds0=(unsigned)(uintptr_t)shm;
  float*wsf=(float*)(shm+LDS_WS)+wid*64;
  const bf16*ksrc=Kh+(long)lane*KP+wid*8;
  const bf16*vsrc=Vh+(long)(16*(wid&3)+(lane>>2))*KP+(wid>>2)*32+(lane&3)*8;
  const unsigned kdst=lds0+LDS_K+wid*1024, vdst=lds0+LDS_V+wid*1024;
  #define PHYS(t) (MODE==1?(((t)<4)?((t)+NT-4):((t)-4)):(t))
  #define DMA_K(t,slot) glds16(ksrc+(long)PHYS(t)*KVBLK*KP,(unsigned)__builtin_amdgcn_readfirstlane(kdst+(slot)))
  #define DMA_V(t,slot) glds16(vsrc+(long)PHYS(t)*KVBLK*KP,(unsigned)__builtin_amdgcn_readfirstlane(vdst+(slot)))
  const char*Kbase=shm+LDS_K; bf16x8 kf[8];
  const lds_cptr shm3=(lds_cptr)shm; const lds_cptr kp0=shm3+LDS_K+hi*1024+r32*16; const lds_cptr vp0=shm3+LDS_V+((lane>>4)&1)*32+(lane&3)*8+(4*hi+((lane&15)>>2))*64;
  DMA_K(0,0);DMA_V(0,0);DMA_K(1,SLOTB);
  bf16x8 qr[4];
  #pragma unroll
  for(int d0=0;d0<4;++d0)qr[d0]=*reinterpret_cast<const bf16x8*>(&Qw[(long)r32*QP+d0*16+hi*8]);
  unsigned sel=0x7fu; if(MODE==1) sel=(unsigned)seltab[wid*QBLK+r32];
  float mhat=0.f,l_reg=0.f;f32x16 o[2];o[0]=f32x16{};o[1]=f32x16{};const f32x16 negm=f32x16{};
  const int qrel=wid*QBLK+r32;
  #define CMASK(P0,P1,t) do{ if(MODE==1){ if((t)<4) cmask(P0,P1,(t),qrel,hi); else if(!((sel>>(((t)-4)>>2))&1u)){ _Pragma("unroll") for(int r_=0;r_<16;++r_){P0[r_]=-INFINITY;P1[r_]=-INFINITY;} } } }while(0)
  bool resc=false;
  #define START(P0,P1) do{ const float rm=rowmax(P0,P1); resc=false; \
    { const float dl=rm; mhat=fadd_s(mhat,dl); \
      _Pragma("unroll") for(int r=0;r<16;++r){P0[r]=fsub_s(P0[r],dl);P1[r]=fsub_s(P1[r],dl);} \
      } \
    _Pragma("unroll") for(int r=0;r<16;++r)P0[r]=__builtin_amdgcn_exp2f(P0[r]); }while(0)
  #define RESC() do{ if(resc){ asm volatile("s_waitcnt lgkmcnt(0)":::"memory"); \
      _Pragma("unroll") for(int d_=0;d_<2;++d_) _Pragma("unroll") for(int r=0;r<16;++r)o[d_][r]*=wsf[crow(r,hi)]; } }while(0)
  f32x16 pA0,pA1,pB0,pB1;
  int sl_prev=0,sl_cur=0,sl_next=SLOTB;
  #define ROT() do{sl_prev=sl_cur;sl_cur=sl_next;sl_next=(sl_next==(NSLOT-1)*SLOTB)?0:sl_next+SLOTB;}while(0)
  DMA_K(2,2*SLOTB);
  WAIT_BAR(3);
  qkt(pA0,pA1,Kbase,qr,negm,r32,hi);asm volatile("s_nop 15\n\ts_nop 7":"+v"(pA0),"+v"(pA1));if(MODE==1){ const int lim_=qrel-4*hi; _Pragma("unroll") for(int r_=0;r_<16;++r_){ const int c_=(r_&3)+8*(r_>>2); pA0[r_]=(c_>lim_)?-INFINITY:pA0[r_]; pA1[r_]=(c_+32>lim_)?-INFINITY:pA1[r_]; } }
  START(pA0,pA1);
  _Pragma("unroll") for(int r=0;r<16;++r)pA1[r]=__builtin_amdgcn_exp2f(pA1[r]);
  WAIT_BAR(0);
  DMA_K(3,0);DMA_V(1,SLOTB);
  ROT();
  kload8(kf,kp0+sl_cur);
  WAIT_BAR(2);
  s16x4 vlo[8],vhi[8]; u32x4 pw0,pw1,pw2,pw3;
  #define PKW(P,B) cvtpk_s(P[B],P[B+1])
  #define PAF(k) __builtin_bit_cast(bf16x8,pw##k)
  #define VFR(i) (bf16x8){vlo[i][0],vlo[i][1],vlo[i][2],vlo[i][3],vhi[i][0],vhi[i][1],vhi[i][2],vhi[i][3]}
  #define PIN(x) asm volatile("":"+v"(x))
  #define MX3(a,b,c) __builtin_fmaxf(__builtin_fmaxf((a),(b)),(c))
  #define GAPA(MF,A0,A1,A2,A3,W0,W1,PW) do{ MF; sacc+=A0; sacc+=A1; sacc+=A2; sacc+=A3; PIN(sacc); W0; W1; PIN(PW); SBAR(); }while(0)
  #define EX(v) __builtin_amdgcn_exp2f(v)
  #define GAPB(MF,X,B) do{ MF; X[B]=EX(X[B]); X[B+1]=EX(X[B+1]); X[B+2]=EX(X[B+2]); X[B+3]=EX(X[B+3]); PIN(X); SBAR(); }while(0)
  #define VRD(i) do{ vlo[i]=vtr(vp_+(((i)>>2)*4096+((i)&3)*1024)); vhi[i]=vtr(vp_+(((i)>>2)*4096+((i)&3)*1024+512)); }while(0)
  #define KRD(G,j) do{ if(G){ kload2(kf,kp0+sl_next,j); SBAR(); } }while(0)
  #define STEP(C0,C1,P0,P1,t,GK,GV,GL) do{ SBAR(); \
    const lds_cptr vp_=vp0+sl_prev; \
    VRD(0); SBAR(); float sacc=(P0[0]+P0[1]); \
    GAPA(C0=__builtin_amdgcn_mfma_f32_32x32x16_bf16(kf[0],qr[0],negm,0,0,0), P0[2],P0[3],P0[4],P0[5],     pw0[0]=PKW(P0,0), pw0[1]=PKW(P0,2), pw0); \
    VRD(4); SBAR(); GAPA(C1=__builtin_amdgcn_mfma_f32_32x32x16_bf16(kf[1],qr[0],negm,0,0,0), P0[6],P0[7],P0[8],P0[9],     pw0[2]=PKW(P0,4), pw0[3]=PKW(P0,6), pw0); \
    VRD(1); SBAR(); GAPA(C0=__builtin_amdgcn_mfma_f32_32x32x16_bf16(kf[2],qr[1],C0,0,0,0),   P0[10],P0[11],P0[12],P0[13], pw1[0]=PKW(P0,8), pw1[1]=PKW(P0,10), pw1); \
    VRD(5); SBAR(); GAPA(C1=__builtin_amdgcn_mfma_f32_32x32x16_bf16(kf[3],qr[1],C1,0,0,0),   P0[14],P0[15],P1[0],P1[1],   pw1[2]=PKW(P0,12),pw1[3]=PKW(P0,14), pw1); \
    VRD(2); SBAR(); GAPA(C0=__builtin_amdgcn_mfma_f32_32x32x16_bf16(kf[4],qr[2],C0,0,0,0),   P1[2],P1[3],P1[4],P1[5],     pw2[0]=PKW(P1,0), pw2[1]=PKW(P1,2), pw2); \
    VRD(6); SBAR(); GAPA(C1=__builtin_amdgcn_mfma_f32_32x32x16_bf16(kf[5],qr[2],C1,0,0,0),   P1[6],P1[7],P1[8],P1[9],     pw2[2]=PKW(P1,4), pw2[3]=PKW(P1,6), pw2); \
    VRD(3); SBAR(); GAPA(C0=__builtin_amdgcn_mfma_f32_32x32x16_bf16(kf[6],qr[3],C0,0,0,0),   P1[10],P1[11],P1[12],P1[13], pw3[0]=PKW(P1,8), pw3[1]=PKW(P1,10), pw3); \
    VRD(7); SBAR(); GAPA(C1=__builtin_amdgcn_mfma_f32_32x32x16_bf16(kf[7],qr[3],C1,0,0,0),   P1[14],P1[15],0.f,0.f,       pw3[2]=PKW(P1,12),pw3[3]=PKW(P1,14), pw3); \
    l_reg+=sacc; \
    if(GK){DMA_K((t)+3,sl_cur);} if(GV){DMA_V((t)+1,sl_next);} \
    if(MODE==1){ const int lim_=LIM(t); _Pragma("unroll") for(int r_=0;r_<16;++r_){ const int c_=(r_&3)+8*(r_>>2); C0[r_]=(c_>lim_)?-INFINITY:(C0[r_]-mhat); C1[r_]=(c_+32>lim_)?-INFINITY:(C1[r_]-mhat); } } \
    else { _Pragma("unroll") for(int r_=0;r_<16;++r_){ C0[r_]-=mhat; C1[r_]-=mhat; } } \
    { float a=MX3(C0[0],C0[1],C1[0]),b=MX3(C0[2],C0[3],C1[1]); a=MX3(a,C1[2],C1[3]); \
      _Pragma("unroll") for(int r=4;r<16;r+=4){a=MX3(a,C0[r],C0[r+1]);b=MX3(b,C0[r+2],C0[r+3]);a=MX3(a,C1[r],C1[r+1]);b=MX3(b,C1[r+2],C1[r+3]);} \
      float rm=__builtin_fmaxf(a,b); { auto rr=__builtin_amdgcn_permlane32_swap(__float_as_uint(rm),__float_as_uint(rm),false,false); rm=__builtin_fmaxf(__uint_as_float(rr[0]),__uint_as_float(rr[1])); } \
      resc=false; \
      if(__builtin_expect(__any(rm>(float)THRL),0)){ const float dl=__builtin_fmaxf(rm,0.f); mhat+=dl; \
        _Pragma("unroll") for(int r=0;r<16;++r){C0[r]-=dl;C1[r]-=dl;} \
        const float f=__builtin_amdgcn_exp2f(-dl); l_reg*=f; if(hi==0)wsf[r32]=f; resc=true; } } \
    SBAR(); \
    GAPB(o[0]=__builtin_amdgcn_mfma_f32_32x32x16_bf16(PAF(0),VFR(0),o[0],0,0,0), C0,0); \
    GAPB(o[1]=__builtin_amdgcn_mfma_f32_32x32x16_bf16(PAF(0),VFR(4),o[1],0,0,0), C0,4); \
    KRD(GL,0); GAPB(o[0]=__builtin_amdgcn_mfma_f32_32x32x16_bf16(PAF(1),VFR(1),o[0],0,0,0), C0,8); \
    KRD(GL,1); GAPB(o[1]=__builtin_amdgcn_mfma_f32_32x32x16_bf16(PAF(1),VFR(5),o[1],0,0,0), C0,12); \
    KRD(GL,2); GAPB(o[0]=__builtin_amdgcn_mfma_f32_32x32x16_bf16(PAF(2),VFR(2),o[0],0,0,0), C1,0); \
    KRD(GL,3); GAPB(o[1]=__builtin_amdgcn_mfma_f32_32x32x16_bf16(PAF(2),VFR(6),o[1],0,0,0), C1,4); \
    GAPB(o[0]=__builtin_amdgcn_mfma_f32_32x32x16_bf16(PAF(3),VFR(3),o[0],0,0,0), C1,8); \
    GAPB(o[1]=__builtin_amdgcn_mfma_f32_32x32x16_bf16(PAF(3),VFR(7),o[1],0,0,0), C1,12); \
    }while(0)
  #define LIM(t) (((t)<4)?(qrel-64*(t)-4*hi):((((sel>>(((t)-4)>>2))&1u)!=0u)?1000:-1000))
  int t=1;
  for(;t+5<NT;t+=2){
    STEP(pB0,pB1,pA0,pA1,t,true,true,true);     WAIT_BAR(2); RESC(); ROT();
    STEP(pA0,pA1,pB0,pB1,t+1,true,true,true);   WAIT_BAR(2); RESC(); ROT();
  }
  #define ENDW(tt) do{ if((tt)+3<NT){WAIT_BAR(2);} else if((tt)+2<NT){WAIT_BAR(1);} else {WAIT_BAR(0);} }while(0)
  for(;t+1<NT;t+=2){
    STEP(pB0,pB1,pA0,pA1,t,(t+3<NT),(t+1<NT),(t+1<NT));       ENDW(t);   RESC(); ROT();
    STEP(pA0,pA1,pB0,pB1,t+1,(t+4<NT),(t+2<NT),(t+2<NT));     ENDW(t+1); RESC(); ROT();
  }
  STEP(pB0,pB1,pA0,pA1,NT-1,false,false,false); RESC();
  { float sacc=pB0[0]+pB0[1]; _Pragma("unroll") for(int r=2;r<16;++r)sacc+=pB0[r]; _Pragma("unroll") for(int r=0;r<16;++r)sacc+=pB1[r]; l_reg+=sacc;
    pw0=(u32x4){PKW(pB0,0),PKW(pB0,2),PKW(pB0,4),PKW(pB0,6)};pw1=(u32x4){PKW(pB0,8),PKW(pB0,10),PKW(pB0,12),PKW(pB0,14)};pw2=(u32x4){PKW(pB1,0),PKW(pB1,2),PKW(pB1,4),PKW(pB1,6)};pw3=(u32x4){PKW(pB1,8),PKW(pB1,10),PKW(pB1,12),PKW(pB1,14)};
    int ln_=threadIdx.x&63; asm volatile("":"+v"(ln_)); const int vb0_=(int)(lds0+LDS_V)+((ln_>>4)&1)*32+(ln_&3)*8+(4*(ln_>>5)+((ln_&15)>>2))*64;
    SBAR(); pv(o,vb0_+sl_cur,PAF(0),PAF(1),PAF(2),PAF(3)); }
  #undef PKW
  #undef PAF
  #undef VFR
  #undef PIN
  #undef MX3
  #undef GAPA
  #undef GAPB
  #undef EX
  #undef VRD
  #undef KRD
  #undef STEP
  #undef ENDW
  #undef LIM
  {auto rr=__builtin_amdgcn_permlane32_swap(__float_as_uint(l_reg),__float_as_uint(l_reg),false,false);l_reg=__uint_as_float(rr[0])+__uint_as_float(rr[1]);}
  if(hi==0)wsf[32+r32]=l_reg;asm volatile("s_waitcnt lgkmcnt(0)":::"memory");
  float rli[16];
  #pragma unroll
  for(int r=0;r<16;++r)rli[r]=__builtin_amdgcn_rcpf(wsf[32+crow(r,hi)]);
  bf16*Ow=Ou+(long)(wid*QBLK)*OP;
  { bf16*stg=(bf16*)(shm+LDS_OST)+wid*2048;
    #pragma unroll
    for(int r=0;r<16;++r){const int orow=crow(r,hi);
      #pragma unroll
      for(int d0=0;d0<2;++d0)stg[orow*64+d0*32+r32]=__float2bfloat16(o[d0][r]*rli[r]);}
    asm volatile("s_waitcnt lgkmcnt(0)":::"memory");
    #pragma unroll
    for(int i=0;i<4;++i){const int row=i*8+(lane>>3),ch=lane&7; const u32x4 v=*(const u32x4*)(stg+row*64+ch*8); ATTN_STORE16(Ow+(long)row*OP+ch*8,v);} }
  asm volatile("s_waitcnt lgkmcnt(0)\n\ts_barrier":::"memory");
  #undef DMA_K
  #undef PHYS
  #undef DMA_V
  #undef CMASK
  #undef START
  #undef RESC
  #undef ROT
}
constexpr int ATTN_LDS_BYTES=LDS_BYTES;
#undef SBAR
#undef WAIT_BAR
}

#define GAS __attribute__((address_space(1)))
#define LAS __attribute__((address_space(3)))
typedef unsigned short bf16;
typedef unsigned v4u __attribute__((ext_vector_type(4)));
typedef float f32x4 __attribute__((ext_vector_type(4)));
typedef short bf16x8 __attribute__((ext_vector_type(8)));
typedef GAS unsigned gu32;
typedef GAS unsigned long long gu64;
#define RLX_AGENT __ATOMIC_RELAXED, __HIP_MEMORY_SCOPE_AGENT
#define LDS_WAIT() asm volatile("s_waitcnt lgkmcnt(0)" ::: "memory")
#define VM_WAIT() asm volatile("s_waitcnt vmcnt(0)" ::: "memory")
__device__ __forceinline__ unsigned long long rt() { return __builtin_amdgcn_s_memrealtime(); }
__device__ __forceinline__ unsigned f2bf(float f) { unsigned u = __builtin_bit_cast(unsigned, f); return (u + 0x7fffu + ((u >> 16) & 1u)) >> 16; }
__device__ __forceinline__ unsigned pk2(float lo, float hi) { return f2bf(lo) | (f2bf(hi) << 16); }

#define XB_TMO      128
#define XB_XCNT(j)  (256  + 64 * (j))
#define XB_XSUB(j)  (1280 + 64 * (j))
#define XB_XGEN(j)  (2304 + 64 * (j))
#define XB_TOP      3328
#define XB_TOPGEN   3392
#define XCD_BAR_WORDS 3456
#define XB_SPIN_CAP (1u << 18)

__device__ __forceinline__ unsigned xb_ld(unsigned* p)              { return __hip_atomic_load(p, __ATOMIC_RELAXED, __HIP_MEMORY_SCOPE_AGENT); }
__device__ __forceinline__ unsigned xb_add(unsigned* p, unsigned v) { return __hip_atomic_fetch_add(p, v, __ATOMIC_RELAXED, __HIP_MEMORY_SCOPE_AGENT); }
__device__ __forceinline__ unsigned xb_xcc_id() { return (unsigned)__builtin_amdgcn_s_getreg((3 << 11) | 20) & 0xFu; }
#define XB_SPIN(cond, bar) do { unsigned _sp = 0; while (cond) { __builtin_amdgcn_s_sleep(1); \
    if ((++_sp & 255u) == 0u) { if (xb_ld(&(bar)[XB_TMO])) break; if (_sp > XB_SPIN_CAP) { atomicAdd(&(bar)[XB_TMO], 1u); break; } } } } while (0)

struct XcdBarrier {
    unsigned* bar; unsigned x;
    volatile LAS unsigned* st;
};

__device__ __forceinline__ XcdBarrier xcd_barrier_post(unsigned* bar, volatile LAS unsigned* st) {
    XcdBarrier b; b.bar = bar; b.x = xb_xcc_id(); b.st = st;
    if (threadIdx.x == 0) (void)xb_add(&bar[XB_XCNT(b.x)], 1u);
    return b;
}
__device__ __forceinline__ void xcd_barrier_complete(unsigned* bar, unsigned x, unsigned& nloc, unsigned& nx) {
    const unsigned G = gridDim.x * gridDim.y * gridDim.z;
    unsigned sum, cnt, mine, sp = 0u;
    for (;;) {
        sum = 0u; cnt = 0u; mine = 0u;
#pragma unroll
        for (unsigned j = 0; j < 16; ++j) { const unsigned c = xb_ld(&bar[XB_XCNT(j)]); sum += c; cnt += (c > 0u) ? 1u : 0u; mine = (j == x) ? c : mine; }
        if (sum == G) break;
        __builtin_amdgcn_s_sleep(1);
        if ((++sp & 255u) == 0u) { if (xb_ld(&bar[XB_TMO])) break; if (sp > XB_SPIN_CAP) { atomicAdd(&bar[XB_TMO], 1u); break; } }
    }
    nloc = mine > 0u ? mine : 1u; nx = cnt > 0u ? cnt : 1u;
}

__device__ __forceinline__ void xcd_barrier(const XcdBarrier& b) {
    asm volatile("s_waitcnt vmcnt(0)" ::: "memory");
    __syncthreads();
    if (threadIdx.x == 0) {
        unsigned* bar = b.bar;
        __builtin_amdgcn_s_waitcnt(0);
        unsigned nloc = b.st[0], nx = b.st[1];
        if (nloc == 0u) { xcd_barrier_complete(bar, b.x, nloc, nx); b.st[0] = nloc; b.st[1] = nx; }
        const unsigned old = xb_add(&bar[XB_XSUB(b.x)], 1u);
        const unsigned gen = old / nloc;
        if (old + 1u == (gen + 1u) * nloc) {
            __builtin_amdgcn_fence(__ATOMIC_RELEASE, "agent");
            asm volatile("s_waitcnt vmcnt(0)" ::: "memory");
            const unsigned og = xb_add(&bar[XB_TOP], 1u);
            const unsigned tg = og / nx;
            if (og + 1u == (tg + 1u) * nx) xb_add(&bar[XB_TOPGEN], 1u);
            else XB_SPIN(xb_ld(&bar[XB_TOPGEN]) == tg, bar);
            __builtin_amdgcn_fence(__ATOMIC_ACQUIRE, "agent");
            xb_add(&bar[XB_XGEN(b.x)], 1u);
            asm volatile("s_waitcnt vmcnt(0)" ::: "memory");
        } else {
            XB_SPIN(xb_ld(&bar[XB_XGEN(b.x)]) == gen, bar);
            __builtin_amdgcn_fence(__ATOMIC_ACQUIRE, "agent");
            asm volatile("s_waitcnt vmcnt(0)" ::: "memory");
        }
    }
    __syncthreads();
}

typedef float f32x16 __attribute__((ext_vector_type(16)));
template <int I> __device__ __forceinline__ const float* karg() {
    const float* p;
    asm volatile("s_load_dwordx2 %0, %1, %2\n\ts_waitcnt lgkmcnt(0)" : "=s"(p) : "s"(__builtin_amdgcn_kernarg_segment_ptr()), "n"(I * 8) : "memory");
    return p;
}
struct Args { const float* in[26]; float* out; unsigned char* ws; int ph_lo, ph_hi; };
struct Frame {
    LAS unsigned char* lds;
    volatile LAS unsigned* MISC;
    gu32* ctl;
    unsigned char* ws;
    int tid, lane, wave, c, G;
    float* out;
};
#define WSP(T, off) ((T*)(F.ws + (off)))
__device__ __forceinline__ float wave_sum(float v) {
#pragma unroll
    for (int o = 1; o < 64; o <<= 1) v += __shfl_xor(v, o);
    return v;
}
__device__ __forceinline__ float bfbits2f(unsigned short s) { return __uint_as_float(((unsigned)s) << 16); }

__device__ __forceinline__ int map_swiglu(int c) { return c < FF ? 256 * (c >> 7) + (c & 127) : 256 * ((c - FF) >> 7) + 128 + ((c - FF) & 127); }
__device__ __forceinline__ int map_head(int c) { return (c & ~255) + 128 * ((c >> 5) & 1) + 32 * ((c >> 6) & 3) + (c & 31); }

__device__ __forceinline__ void p0_transpose_item(const float* W, int K, int N, bf16* WT, int prow0, const float* gain, LAS float* scr, int k0, int n0, int lane) {
#pragma unroll 8
    for (int i = 0; i < 32; ++i) { const int kk = 2 * i + (lane >> 5); float w = W[(size_t)(k0 + kk) * N + n0 + (lane & 31)]; if (gain) w *= gain[k0 + kk]; scr[kk * 33 + (lane & 31)] = w; }
    LDS_WAIT(); asm volatile("" ::: "memory");
    const int c = lane & 7;
#pragma unroll
    for (int j = 0; j < 4; ++j) { const int n = (lane >> 3) + 8 * j; const LAS float* s = scr + (8 * c) * 33 + n;
        v4u o; o.x = pk2(s[0 * 33], s[1 * 33]); o.y = pk2(s[2 * 33], s[3 * 33]); o.z = pk2(s[4 * 33], s[5 * 33]); o.w = pk2(s[6 * 33], s[7 * 33]);
        *(GAS v4u*)(WT + (size_t)(prow0 + n) * K + k0 + 8 * c) = o; }
    LDS_WAIT(); asm volatile("" ::: "memory");
}
__device__ __forceinline__ void row_to_bf16(Frame& F, const float* xrow, bf16* orow, float* ssq) {
    const GAS f32x4* xr = (const GAS f32x4*)xrow + F.lane;
    f32x4 v[4]; float s = 0.f;
#pragma unroll
    for (int j = 0; j < 4; ++j) { v[j] = xr[64 * j]; s += (v[j].x * v[j].x + v[j].y * v[j].y) + (v[j].z * v[j].z + v[j].w * v[j].w); }
    s = wave_sum(s);
    GAS unsigned long long* o8 = (GAS unsigned long long*)orow + F.lane;
#pragma unroll
    for (int j = 0; j < 4; ++j) o8[64 * j] = (unsigned long long)pk2(v[j].x, v[j].y) | ((unsigned long long)pk2(v[j].z, v[j].w) << 32);
    if (F.lane == 0) *ssq = s;
}
__device__ __forceinline__ void p0_prologue(Frame& F) {
    LAS float* scr = (LAS float*)(F.lds + RING_OFF + F.wave * 16384);
    const int gw = F.c * NWAVES + F.wave, NGW = F.G * NWAVES;
    {
        const int* pt = (const int*)karg<8>(); const float* ck = karg<3>(); float* sks = WSP(float, WS_SKSUM);
        LAS float* red = (LAS float*)(F.lds + RING_OFF);
        for (int it = F.c; it < NS * 32; it += F.G) {
            const int b = it >> 5, blk = it & 31;
            f32x4 a0 = {0.f, 0.f, 0.f, 0.f}, a1 = {0.f, 0.f, 0.f, 0.f};
#pragma unroll
            for (int pg = 0; pg < 2; ++pg) { const int page = pt[b * NPG + 2 * blk + pg]; const float* base = ck + ((size_t)page * PAGE + F.wave * 16) * 512 + 4 * F.lane;
#pragma unroll
                for (int r = 0; r < 16; ++r) { const f32x4 x0 = __builtin_nontemporal_load((const f32x4*)(base + (size_t)r * 512)), x1 = __builtin_nontemporal_load((const f32x4*)(base + (size_t)r * 512 + 256)); a0 += x0; a1 += x1; } }
            __syncthreads();
            *(LAS f32x4*)(red + F.wave * 512 + 4 * F.lane) = a0; *(LAS f32x4*)(red + F.wave * 512 + 256 + 4 * F.lane) = a1;
            __syncthreads();
            float s = 0.f;
#pragma unroll
            for (int w = 0; w < 8; ++w) s += red[w * 512 + F.tid];
            sks[(size_t)it * 512 + F.tid] = s;
        }
        __syncthreads();
    }
    {
        constexpr int I_A = (DM / 64) * (FF2 / 32), I_B = (FF / 64) * (DM / 32), I_IN = (DM / 64) * (INC / 32), I_OUT = (DM / 64) * (DM / 32), I_MEM = (DM / 64) * (512 / 32);
        constexpr int NITEMS = 2 * I_A + 2 * I_B + I_IN + I_OUT + I_MEM;
        for (int it = gw; it < NITEMS; it += NGW) {
            int r = it;
            if (r < 2 * I_A) { const int which = r >= I_A; r -= which * I_A; const int nblk = FF2 / 32, kb = r / nblk, nb = r % nblk;
                p0_transpose_item((which ? karg<24>() : karg<10>()), DM, FF2, WSP(bf16, which ? WS_W2A : WS_W1A), map_swiglu(32 * nb), (which ? karg<23>() : karg<9>()), scr, 64 * kb, 32 * nb, F.lane); continue; }
            r -= 2 * I_A;
            if (r < 2 * I_B) { const int which = r >= I_B; r -= which * I_B; const int nblk = DM / 32, kb = r / nblk, nb = r % nblk;
                p0_transpose_item((which ? karg<25>() : karg<11>()), FF, DM, WSP(bf16, which ? WS_W2B : WS_W1B), 32 * nb, nullptr, scr, 64 * kb, 32 * nb, F.lane); continue; }
            r -= 2 * I_B;
            if (r < I_IN) { const int nblk = INC / 32, kb = r / nblk, nb = r % nblk; p0_transpose_item(karg<13>(), DM, INC, WSP(bf16, WS_WIN), map_head(32 * nb), karg<12>(), scr, 64 * kb, 32 * nb, F.lane); continue; }
            r -= I_IN;
            if (r < I_OUT) { const int nblk = DM / 32, kb = r / nblk, nb = r % nblk; p0_transpose_item(karg<22>(), DM, DM, WSP(bf16, WS_WOUT), 32 * nb, nullptr, scr, 64 * kb, 32 * nb, F.lane); continue; }
            r -= I_OUT;
            { const int nblk = 512 / 32, kb = r / nblk, nb = r % nblk; p0_transpose_item(karg<19>(), DM, 512, WSP(bf16, WS_WMEM), map_head(32 * nb), karg<18>(), scr, 64 * kb, 32 * nb, F.lane); }
        }
    }
    { const float* xin_ = karg<0>(); const float* min_ = karg<2>();
    for (int m = gw; m < MP; m += NGW) row_to_bf16(F, xin_ + (size_t)m * DM, WSP(bf16, WS_XB) + (size_t)m * DM, WSP(float, WS_SSQ0) + m);
    for (int m = gw; m < MM; m += NGW) row_to_bf16(F, min_ + (size_t)m * DM, WSP(bf16, WS_MNB) + (size_t)m * DM, WSP(float, WS_SSQ0) + MP + m); }
    if (F.c == 0 && F.tid < 256) { const int w = F.tid >> 6, d = F.tid & 63; const float* src = w == 0 ? karg<16>() : (w == 1 ? karg<17>() : (w == 2 ? karg<20>() : karg<21>())); WSP(float, WS_GAIN)[F.tid] = src[d]; }
    for (int i = F.c * 512 + F.tid; i < (SEQ + 1) * 8; i += F.G * 512) { const int p = i >> 3, f = i & 7; const float pos = (p == SEQ) ? (float)PAST : (float)p;
        const float inv = powf(500000.0f, -(float)f * 0.125f); const float ang = pos * inv;
        const double kk = rint((double)ang * 0.15915494309189535); const float rr = (float)((double)ang - kk * 6.283185307179586);
        float* rp = WSP(float, WS_ROPE) + (size_t)i * 2; rp[0] = cosf(rr); rp[1] = sinf(rr); }
}

template <class AL, class BR, class EP>
__device__ __forceinline__ void sgemm_unit(Frame& F, const AL& al, const BR& br, const bf16* Bt, const int K, const EP& ep) {
    LAS float* red = (LAS float*)(F.lds + RING_OFF);
    const int r32 = F.lane & 31, hi = F.lane >> 5, ks = K >> 3, k0 = F.wave * ks;
    f32x16 acc0 = {}, acc1 = {};
    const bf16* b0p = Bt + (size_t)br(0, r32) * K; const bf16* b1p = Bt + (size_t)br(1, r32) * K;
#pragma unroll 2
    for (int s = 0; s < ks; s += 16) { const int k = k0 + s + 8 * hi;
        const bf16x8 a = al(r32, k); const bf16x8 b0 = *(const bf16x8*)(b0p + k), b1 = *(const bf16x8*)(b1p + k);
        acc0 = __builtin_amdgcn_mfma_f32_32x32x16_bf16(a, b0, acc0, 0, 0, 0); acc1 = __builtin_amdgcn_mfma_f32_32x32x16_bf16(a, b1, acc1, 0, 0, 0); }
#pragma unroll
    for (int r = 0; r < 16; ++r) { const int row = (r & 3) + 8 * (r >> 2) + 4 * hi; red[(F.wave * 32 + row) * 64 + r32] = acc0[r]; red[(F.wave * 32 + row) * 64 + 32 + r32] = acc1[r]; }
    __syncthreads();
    const int row = F.tid >> 4, c4 = (F.tid & 15) * 4; f32x4 s = {0.f, 0.f, 0.f, 0.f};
#pragma unroll
    for (int w = 0; w < 8; ++w) s += *(const LAS f32x4*)(red + (w * 32 + row) * 64 + c4);
    ep(row, c4, s);
    __syncthreads();
}
__device__ __forceinline__ bf16x8 pack_bf16x8(const f32x4 a, const f32x4 b) { v4u w; w.x = pk2(a[0], a[1]); w.y = pk2(a[2], a[3]); w.z = pk2(b[0], b[1]); w.w = pk2(b[2], b[3]); return __builtin_bit_cast(bf16x8, w); }
struct ALNorm { const float* x; const LAS float* rs;
    __device__ __forceinline__ bf16x8 operator()(int r, int k) const { const f32x4 a = *(const f32x4*)(x + r * DM + k), b = *(const f32x4*)(x + r * DM + k + 4); const float s = rs[r]; return pack_bf16x8(a * s, b * s); } };
struct ALPlain { const float* x; int ld;
    __device__ __forceinline__ bf16x8 operator()(int r, int k) const { const f32x4 a = *(const f32x4*)(x + r * ld + k), b = *(const f32x4*)(x + r * ld + k + 4); return pack_bf16x8(a, b); } };
struct ALSwiglu { const float* h;
    __device__ __forceinline__ bf16x8 operator()(int r, int k) const { const f32x4 g0 = *(const f32x4*)(h + r * FF2 + k), g1 = *(const f32x4*)(h + r * FF2 + k + 4), u0 = *(const f32x4*)(h + r * FF2 + FF + k), u1 = *(const f32x4*)(h + r * FF2 + FF + k + 4);
        f32x4 a, b;
#pragma unroll
        for (int i = 0; i < 4; ++i) { a[i] = pg8::silu_f(g0[i]) * u0[i]; b[i] = pg8::silu_f(g1[i]) * u1[i]; }
        return pack_bf16x8(a, b); } };
__device__ __forceinline__ void sample_rs(Frame& F, const float* x, LAS float* rs) {
#pragma unroll
    for (int i = 0; i < 4; ++i) { const int r = F.wave * 4 + i; float s = 0.f;
#pragma unroll
        for (int j = 0; j < 4; ++j) { const f32x4 v = *(const f32x4*)(x + r * DM + j * 256 + 4 * F.lane); s += (v.x * v.x + v.y * v.y) + (v.z * v.z + v.w * v.w); }
        s = wave_sum(s); if (F.lane == 0) rs[r] = 1.0f / sqrtf(s * (1.0f / DM) + RMS_EPS); }
    __syncthreads();
}
struct BRSwiglu { int v; __device__ __forceinline__ int operator()(int cb, int c) const { return 256 * (v >> 2) + 32 * (v & 3) + 128 * cb + c; } };
struct BRPlain { int v; __device__ __forceinline__ int operator()(int cb, int c) const { return 64 * v + 32 * cb + c; } };
struct BRHead { int v; __device__ __forceinline__ int operator()(int cb, int c) const { return 256 * (v >> 2) + 128 * cb + 32 * (v & 3) + c; } };
struct EPSwigluRaw { float* h; int v; __device__ __forceinline__ void operator()(int row, int c4, f32x4 s) const { *(f32x4*)(h + row * FF2 + (c4 < 32 ? 32 * v + c4 : FF + 32 * v + c4 - 32)) = s; } };
struct EPResid { const float* base; float* out; float alpha; int v; __device__ __forceinline__ void operator()(int row, int c4, f32x4 s) const { const int o = row * DM + 64 * v + c4; *(f32x4*)(out + o) = *(const f32x4*)(base + o) + alpha * s; } };
struct EPProjS { int v; unsigned char* ws; float* outp;
    __device__ __forceinline__ void operator()(int row, int c4, f32x4 s) const {
        if (v < 4) { *(f32x4*)((float*)(ws + S_U) + row * 256 + 64 * v + c4) = s; return; }
        if (v >= 20 && v < 28) { *(f32x4*)(outp + O_VS + row * 512 + 64 * (v - 20) + c4) = s; return; }
        float ss = (s.x * s.x + s.y * s.y) + (s.z * s.z + s.w * s.w);
        ss += __shfl_xor(ss, 1); ss += __shfl_xor(ss, 2); ss += __shfl_xor(ss, 4); ss += __shfl_xor(ss, 8);
        const float hn = 1.0f / sqrtf(ss * (1.0f / 64.0f) + RMS_EPS);
        const float* g = (const float*)(ws + WS_GAIN) + ((v < 12) ? 0 : (v < 20 ? 64 : 128));
        const f32x4 gv = *(const f32x4*)(g + c4); s = s * hn * gv;
        if (v < 20) {
            const float* rope8192 = (const float*)(ws + WS_ROPE) + SEQ * 16;
            f32x4 y; y.x = __shfl_xor(s.x, 2); y.y = __shfl_xor(s.y, 2); y.z = __shfl_xor(s.z, 2); y.w = __shfl_xor(s.w, 2);
            if (c4 < 16) { const int f0 = c4 & 7; const float sg = (c4 < 8) ? -1.f : 1.f; f32x4 r_;
#pragma unroll
                for (int i = 0; i < 4; ++i) { const float cs_ = rope8192[2 * (f0 + i)], sn = rope8192[2 * (f0 + i) + 1]; r_[i] = s[i] * cs_ + sg * y[i] * sn; }
                s = r_; }
        }
        if (v < 12) *(f32x4*)((float*)(ws + S_Q) + row * 512 + 64 * (v - 4) + c4) = s;
        else if (v < 20) *(f32x4*)(outp + O_KS + row * 512 + 64 * (v - 12) + c4) = s;
        else *(f32x4*)((float*)(ws + S_QM) + row * 256 + 64 * (v - 28) + c4) = s;
    } };

__device__ __forceinline__ void pool_unit(Frame& F, const int pm, const int g) {
    const bf16* U = WSP(bf16, WS_U); bf16* MIX = WSP(bf16, WS_MIX); const float* pw = karg<14>() + g * 4096; const float* psc = karg<15>() + 64 * g;
    const int r32 = F.lane & 31, hi = F.lane >> 5, row = pm * 256 + F.wave * 32 + r32, t = row & (SEQ - 1), W = 2 << g;
    const int cnt = (t + 1 < W) ? t + 1 : W; const float rc = 1.0f / (float)cnt;
    bf16x8 bfr[4][2];
#pragma unroll
    for (int s = 0; s < 4; ++s)
#pragma unroll
        for (int cb = 0; cb < 2; ++cb) { float w[8];
#pragma unroll
            for (int j = 0; j < 8; ++j) w[j] = pw[(16 * s + 8 * hi + j) * 64 + 32 * cb + r32];
            v4u p; p.x = pk2(w[0], w[1]); p.y = pk2(w[2], w[3]); p.z = pk2(w[4], w[5]); p.w = pk2(w[6], w[7]); bfr[s][cb] = __builtin_bit_cast(bf16x8, p); }
    f32x16 acc0 = {}, acc1 = {};
#pragma unroll
    for (int s = 0; s < 4; ++s) { const bf16* up = U + (size_t)row * 256 + 64 * g + 16 * s + 8 * hi;
        float sum[8], self[8];
        { const bf16x8 x = *(const bf16x8*)up;
#pragma unroll
            for (int j = 0; j < 8; ++j) { self[j] = bfbits2f((unsigned short)x[j]); sum[j] = self[j]; } }
        for (int i = 1; i < cnt; ++i) { const bf16x8 x = *(const bf16x8*)(up - (size_t)i * 256);
#pragma unroll
            for (int j = 0; j < 8; ++j) sum[j] += bfbits2f((unsigned short)x[j]); }
        v4u p;
        p.x = pk2(sum[0] * rc - self[0], sum[1] * rc - self[1]); p.y = pk2(sum[2] * rc - self[2], sum[3] * rc - self[3]); p.z = pk2(sum[4] * rc - self[4], sum[5] * rc - self[5]); p.w = pk2(sum[6] * rc - self[6], sum[7] * rc - self[7]);
        const bf16x8 a = __builtin_bit_cast(bf16x8, p);
        acc0 = __builtin_amdgcn_mfma_f32_32x32x16_bf16(a, bfr[s][0], acc0, 0, 0, 0); acc1 = __builtin_amdgcn_mfma_f32_32x32x16_bf16(a, bfr[s][1], acc1, 0, 0, 0); }
    const float sc0 = psc[r32], sc1 = psc[32 + r32];
    bf16* ob = MIX + (size_t)(pm * 256 + F.wave * 32) * DM + 64 * g;
#pragma unroll
    for (int r = 0; r < 16; ++r) { const int orow = (r & 3) + 8 * (r >> 2) + 4 * hi; ob[(size_t)orow * DM + r32] = (bf16)f2bf(acc0[r] * sc0); ob[(size_t)orow * DM + 32 + r32] = (bf16)f2bf(acc1[r] * sc1); }
}

template <class KPF, class VPF>
__device__ __forceinline__ void dec_attn(Frame& F, const float* q, const int nk, const KPF& KP, const VPF& VP, const float* xk, const float* xv, float* outp) {
    LAS float* st = (LAS float*)(F.lds + RING_OFF);
    const int l16 = F.lane & 15, grp = F.wave * 4 + (F.lane >> 4), per = nk >> 5;
    f32x4 q4 = *(const f32x4*)(q + 4 * l16); q4 = q4 * C2;
    float m = -INFINITY, l = 0.f; f32x4 o = {0.f, 0.f, 0.f, 0.f};
    for (int it = 0; it < per; ++it) { const int i = grp * per + it;
        const f32x4 kv = *(const f32x4*)(KP(i) + 4 * l16); const f32x4 vv = *(const f32x4*)(VP(i) + 4 * l16);
        float d = (q4.x * kv.x + q4.y * kv.y) + (q4.z * kv.z + q4.w * kv.w);
        d += __shfl_xor(d, 1); d += __shfl_xor(d, 2); d += __shfl_xor(d, 4); d += __shfl_xor(d, 8);
        const float mn = fmaxf(m, d), f = __builtin_amdgcn_exp2f(m - mn), p = __builtin_amdgcn_exp2f(d - mn);
        l = l * f + p; o = o * f + p * vv; m = mn; }
    if (l16 == 0) { st[grp * 68] = m; st[grp * 68 + 1] = l; }
    *(LAS f32x4*)(st + grp * 68 + 4 + 4 * l16) = o;
    if (F.wave == 0 && F.lane < 16) {
        if (xk) { const f32x4 kv = *(const f32x4*)(xk + 4 * l16); float d = (q4.x * kv.x + q4.y * kv.y) + (q4.z * kv.z + q4.w * kv.w);
            d += __shfl_xor(d, 1); d += __shfl_xor(d, 2); d += __shfl_xor(d, 4); d += __shfl_xor(d, 8);
            if (l16 == 0) { st[32 * 68] = d; st[32 * 68 + 1] = 1.f; } *(LAS f32x4*)(st + 32 * 68 + 4 + 4 * l16) = *(const f32x4*)(xv + 4 * l16); }
        else { if (l16 == 0) { st[32 * 68] = -INFINITY; st[32 * 68 + 1] = 0.f; } *(LAS f32x4*)(st + 32 * 68 + 4 + 4 * l16) = (f32x4){0.f, 0.f, 0.f, 0.f}; }
    }
    __syncthreads();
    if (F.tid < 64) { float M = -INFINITY;
        for (int i = 0; i < 33; ++i) M = fmaxf(M, st[i * 68]);
        float L = 0.f, O = 0.f;
        for (int i = 0; i < 33; ++i) { const float e = __builtin_amdgcn_exp2f(st[i * 68] - M); L += st[i * 68 + 1] * e; O += st[i * 68 + 4 + F.tid] * e; }
        outp[F.tid] = O / L; }
    __syncthreads();
}
struct KPaged { const float* base; const int* pt; unsigned blks; int hoff;
    __device__ __forceinline__ const float* operator()(int i) const { const int blk = (int)((blks >> (8 * (i >> 8))) & 0xffu), r = i & 255; const int page = pt[2 * blk + (r >> 7)]; return base + ((size_t)page * PAGE + (r & 127)) * 512 + hoff; } };
struct KLin { const float* base; int ld; __device__ __forceinline__ const float* operator()(int i) const { return base + (size_t)i * ld; } };

__device__ __forceinline__ void sample_item(Frame& F, const int item) {
    float* smix = WSP(float, S_MIX);
    if (item < 256) {
        const int b = item >> 3, h = item & 7; const float* q = WSP(float, S_Q) + b * 512 + h * 64; const float* sks = WSP(float, WS_SKSUM) + (size_t)b * 32 * 512 + h * 64;
        const int j = F.lane & 31, hh = F.lane >> 5; float sc = 0.f;
#pragma unroll
        for (int d = 0; d < 32; d += 4) { const f32x4 kv = *(const f32x4*)(sks + (size_t)j * 512 + 32 * hh + d), qv = *(const f32x4*)(q + 32 * hh + d); sc += (qv.x * kv.x + qv.y * kv.y) + (qv.z * kv.z + qv.w * kv.w); }
        sc += __shfl_xor(sc, 32);
        int cntb = 0;
        for (int i = 0; i < 32; ++i) { const float o = __shfl(sc, i); cntb += ((o > sc) || (o == sc && i < j)) ? 1 : 0; }
        const unsigned long long bal = __ballot(cntb < 3 && F.lane < 32);
        const unsigned msk = (unsigned)bal; const int b0 = __builtin_ctz(msk), b1 = __builtin_ctz(msk & (msk - 1)), b2 = __builtin_ctz(msk & (msk - 1) & ((msk & (msk - 1)) - 1));
        const int* pt = (const int*)karg<8>() + b * NPG;
        const unsigned blks = (unsigned)b0 | ((unsigned)b1 << 8) | ((unsigned)b2 << 16);
        const KPaged KPf{karg<3>(), pt, blks, h * 64}, VPf{karg<4>(), pt, blks, h * 64};
        dec_attn(F, q, 768, KPf, VPf, F.out + O_KS + b * 512 + h * 64, F.out + O_VS + b * 512 + h * 64, smix + b * DM + 256 + h * 64);
    } else if (item < 384) {
        const int b = (item - 256) >> 2, h = (item - 256) & 3; const float* q = WSP(float, S_QM) + b * 256 + h * 64;
        const KLin KPf{karg<5>() + (size_t)b * MEML * 256 + h * 64, 256}, VPf{karg<6>() + (size_t)b * MEML * 256 + h * 64, 256};
        dec_attn(F, q, 256, KPf, VPf, nullptr, nullptr, smix + b * DM + 768 + h * 64);
    } else if (item < 416) {
        const int b = item - 384; LAS float* pl = (LAS float*)(F.lds + RING_OFF);
        const float* stp = karg<7>() + (size_t)b * 15 * 256; const float* su = WSP(float, S_U) + b * 256; float* pso = F.out + O_PSS + (size_t)b * 15 * 256;
        if (F.tid < 256) { const int c = F.tid, g = c >> 6, W = 2 << g; const float u = su[c]; float s = u;
            for (int i = 1; i < W; ++i) s += stp[(15 - i) * 256 + c];
            pl[c] = s / (float)W - u;
            for (int i = 0; i < 14; ++i) pso[i * 256 + c] = stp[(i + 1) * 256 + c];
            pso[14 * 256 + c] = u; }
        __syncthreads();
        if (F.tid < 256) { const int c = F.tid, g = c >> 6, d = c & 63; const float* pw = karg<14>() + g * 4096; float a = 0.f;
            for (int cc = 0; cc < 64; ++cc) a += pl[64 * g + cc] * pw[cc * 64 + d];
            smix[b * DM + c] = a * karg<15>()[c]; }
        __syncthreads();
    }
}

__global__ void __launch_bounds__(NWAVES * 64, 2) hymba_fwd(Args args) {
    extern __shared__ __attribute__((aligned(16))) unsigned char lds[];
    Frame F;
    F.lds = (LAS unsigned char*)lds;
    F.MISC = (volatile LAS unsigned*)(F.lds + MISC_OFF);
    F.tid = threadIdx.x; F.lane = F.tid & 63; F.wave = __builtin_amdgcn_readfirstlane(F.tid >> 6);
    F.G = gridDim.x; F.c = blockIdx.x;
    F.ws = args.ws; F.ctl = (gu32*)(args.ws + WS_CTL); F.out = args.out;
    for (int u = F.tid; u < (LDS_BYTES - LDSCTL_OFF) / 4; u += NWAVES * 64) ((LAS unsigned*)(F.lds + LDSCTL_OFF))[u] = 0u;
    __syncthreads();
    XcdBarrier bar; bar.bar = (unsigned*)(F.ctl + CW_BAR); bar.x = 0; bar.st = nullptr;
    if (N_LAUNCHES == 1) bar = xcd_barrier_post((unsigned*)(F.ctl + CW_BAR), F.MISC + 8);
#define GRID_BAR() do { if (N_LAUNCHES == 1) xcd_barrier(bar); } while (0)
    const int lo = args.ph_lo, hi = args.ph_hi;
#ifdef DBG_ONLY
#define IN(k) ((k) == DBG_ONLY && lo <= (k) && (k) < hi)
#else
#define IN(k) (lo <= (k) && (k) < hi)
#endif
#define rs ((LAS float*)(F.lds + SM_OFF))
#define ssq1 ((float*)(F.ws + WS_CTL) + CW_SSQ1)
#define ssq2 ((float*)(F.ws + WS_CTL) + CW_SSQ2)
#define ksum ((float*)(F.ws + WS_CTL) + CW_KSUM)
#define ssq0 WSP(float, WS_SSQ0)

#define FRESH() do { int t2_ = threadIdx.x, c2_ = blockIdx.x; asm volatile("" : "+v"(t2_)); asm volatile("" : "+s"(c2_)); F.tid = t2_; F.lane = t2_ & 63; F.wave = __builtin_amdgcn_readfirstlane(t2_ >> 6); F.c = c2_; \
        unsigned char* w2_ = args.ws; float* o2_ = args.out; asm volatile("" : "+s"(w2_)); asm volatile("" : "+s"(o2_)); F.ws = w2_; F.out = o2_; F.ctl = (gu32*)(w2_ + WS_CTL); } while (0)
    if (IN(0)) { FRESH(); p0_prologue(F); GRID_BAR(); }

    if (IN(1)) { FRESH();
        { pg8::Gemm g{WSP(bf16, WS_XB), WSP(bf16, WS_W1A), MP, FF2, DM}; pg8::StaticOrder S; S.init(MP, FF2, F.G, F.c);
          pg8::EpiSwiglu E{WSP(bf16, WS_H), ssq0, FF};
          pg8::gemm_phase<pg8::EpiSwiglu, pg8::StaticOrder, true, true>(F.lds + RING_OFF, g, S, E); }
        if (F.c >= 128 && F.c < 144) { pg8::Gemm g{WSP(bf16, WS_MNB), WSP(bf16, WS_WMEM), MM, 512, DM}; pg8::ListOrder S; S.init(MM / 256, 2, 128, F.c);
          pg8::EpiHead<true> E{ssq0 + MP, nullptr, F.out, nullptr, F.ws, C2};
          pg8::gemm_phase<pg8::EpiHead<true>, pg8::ListOrder, true, true>(F.lds + RING_OFF, g, S, E); }
        if (F.c >= 144 && F.c < 144 + 88) { const int v = F.c - 144; sample_rs(F, karg<1>(), rs);
          sgemm_unit(F, ALNorm{karg<1>(), rs}, BRSwiglu{v}, WSP(bf16, WS_W1A), DM, EPSwigluRaw{WSP(float, S_H), v}); }
        GRID_BAR();
    }
    if (IN(2)) { FRESH();
        { pg8::Gemm g{WSP(bf16, WS_H), WSP(bf16, WS_W1B), MP, DM, FF}; pg8::StaticOrder S; S.init(MP, DM, F.G, F.c);
          pg8::EpiResid<true> E{karg<0>(), WSP(float, WS_X1), WSP(bf16, WS_XB), ssq1, 0.5f};
          pg8::gemm_phase<pg8::EpiResid<true>, pg8::StaticOrder, true, true>(F.lds + RING_OFF, g, S, E); }
        if (F.c >= 240) { const int v = F.c - 240; sgemm_unit(F, ALSwiglu{WSP(float, S_H)}, BRPlain{v}, WSP(bf16, WS_W1B), FF, EPResid{karg<1>(), WSP(float, S_X1), 0.5f, v}); }
        GRID_BAR();
    }
    if (IN(3)) { FRESH();
        { pg8::Gemm g{WSP(bf16, WS_XB), WSP(bf16, WS_WIN), MP, INC, DM}; pg8::StaticOrder S; S.init(MP, INC, F.G, F.c);
          pg8::EpiHead<false> E{ssq1, WSP(float, WS_ROPE), F.out, ksum, F.ws, C2};
          pg8::gemm_phase<pg8::EpiHead<false>, pg8::StaticOrder, true, true>(F.lds + RING_OFF, g, S, E); }
        if (F.c >= 224) { const int v = F.c - 224; sample_rs(F, WSP(float, S_X1), rs);
          sgemm_unit(F, ALNorm{WSP(float, S_X1), rs}, BRHead{v}, WSP(bf16, WS_WIN), DM,
                     EPProjS{v, F.ws, F.out}); }
        GRID_BAR();
    }
    if (IN(4)) { FRESH();
        using attn_body::bf16; char* shm = (char*)lds + RING_OFF;
#ifndef DBG_P4
#define DBG_P4 15
#endif
        if (DBG_P4 & 1) { const int bh = F.c >> 2, s = F.c & 3, b = bh >> 3, h = bh & 7;
          const bf16* Qb = (const bf16*)WSP(unsigned short, WS_Q) + (size_t)b * SEQ * 512 + h * 64; const bf16* Kb = (const bf16*)WSP(unsigned short, WS_K) + (size_t)b * SEQ * 512 + h * 64;
          const bf16* Vb = (const bf16*)WSP(unsigned short, WS_V) + (size_t)b * SEQ * 512 + h * 64; bf16* Ob = (bf16*)WSP(unsigned short, WS_MIX) + (size_t)b * SEQ * DM + 256 + h * 64;
          const float* ks = ksum + (size_t)b * 8 * 512 + h * 64;
          LAS unsigned char* selt = (LAS unsigned char*)(F.lds + SM_OFF + 512);
          { const int which = F.tid >> 8, qi = F.tid & 255, qb = which == 0 ? 7 - s : s; unsigned sel = 0x7fu;
            if (qb >= 4) { const unsigned short* qp = WSP(unsigned short, WS_Q) + ((size_t)b * SEQ + qb * 256 + qi) * 512 + h * 64; float qf[64];
#pragma unroll
              for (int d8 = 0; d8 < 8; ++d8) { const bf16x8 x = *(const bf16x8*)(qp + 8 * d8);
#pragma unroll
                for (int e = 0; e < 8; ++e) qf[8 * d8 + e] = bfbits2f((unsigned short)x[e]); }
              float sc[7];
#pragma unroll
              for (int j = 0; j < 7; ++j) { float a = 0.f; if (j < qb) {
#pragma unroll
                  for (int d4 = 0; d4 < 16; ++d4) { const f32x4 kv = *(const f32x4*)(ks + j * 512 + 4 * d4); a += (qf[4 * d4] * kv[0] + qf[4 * d4 + 1] * kv[1]) + (qf[4 * d4 + 2] * kv[2] + qf[4 * d4 + 3] * kv[3]); } } else a = -INFINITY;
                sc[j] = a; asm volatile("" : "+v"(a) :: "memory"); }
              sel = 0u;
#pragma unroll
              for (int j = 0; j < 7; ++j) { int cnt = 0;
#pragma unroll
                for (int i = 0; i < 7; ++i) { if (i != j) cnt += ((sc[i] > sc[j]) || (sc[i] == sc[j] && i < j)) ? 1 : 0; }
                if (j < qb && cnt < 3) sel |= (1u << j); } }
            selt[F.tid] = (unsigned char)sel; }
          __syncthreads();
          { const int qb = 7 - s; attn_body::attn_unit<8, 1, 512, 512, DM>(Qb + (size_t)qb * 256 * 512, Kb, Vb, Ob + (size_t)qb * 256 * DM, 4 * qb + 4, selt, shm); }
          { const int qb = s;     attn_body::attn_unit<8, 1, 512, 512, DM>(Qb + (size_t)qb * 256 * 512, Kb, Vb, Ob + (size_t)qb * 256 * DM, 4 * qb + 4, selt + 256, shm); } }
        FRESH();
        if (DBG_P4 & 2) { const int b = F.c >> 5, hm = (F.c >> 3) & 3, qb = F.c & 7;
          const bf16* Qb = (const bf16*)WSP(unsigned short, WS_QM) + ((size_t)b * SEQ + qb * 256) * 256 + hm * 64; const bf16* Kb = (const bf16*)WSP(unsigned short, WS_MKB) + (size_t)b * MEML * 256 + hm * 64;
          const bf16* Vb = (const bf16*)WSP(unsigned short, WS_MVB) + (size_t)b * MEML * 256 + hm * 64; bf16* Ob = (bf16*)WSP(unsigned short, WS_MIX) + ((size_t)b * SEQ + qb * 256) * DM + 768 + hm * 64;
          attn_body::attn_unit<8, 0, 256, 256, DM>(Qb, Kb, Vb, Ob, 4, nullptr, shm); }
        if (DBG_P4 & 4) pool_unit(F, F.c >> 2, F.c & 3);
        __syncthreads();
        if (DBG_P4 & 8) { sample_item(F, F.c);
        if (F.c + 256 < 416) sample_item(F, F.c + 256); }
        GRID_BAR();
    }
    if (IN(5)) { FRESH();
        { pg8::Gemm g{WSP(bf16, WS_MIX), WSP(bf16, WS_WOUT), MP, DM, DM}; pg8::StaticOrder S; S.init(MP, DM, F.G, F.c);
          pg8::EpiResid<true> E{WSP(float, WS_X1), WSP(float, WS_X1), WSP(bf16, WS_XB), ssq2, 1.0f};
          pg8::gemm_phase<pg8::EpiResid<true>, pg8::StaticOrder, true, true>(F.lds + RING_OFF, g, S, E); }
        if (F.c >= 240) { const int v = F.c - 240; sgemm_unit(F, ALPlain{WSP(float, S_MIX), DM}, BRPlain{v}, WSP(bf16, WS_WOUT), DM, EPResid{WSP(float, S_X1), WSP(float, S_X2), 1.0f, v}); }
        GRID_BAR();
    }
    if (IN(6)) { FRESH();
        { pg8::Gemm g{WSP(bf16, WS_XB), WSP(bf16, WS_W2A), MP, FF2, DM}; pg8::StaticOrder S; S.init(MP, FF2, F.G, F.c);
          pg8::EpiSwiglu E{WSP(bf16, WS_H), ssq2, FF};
          pg8::gemm_phase<pg8::EpiSwiglu, pg8::StaticOrder, true, true>(F.lds + RING_OFF, g, S, E); }
        if (F.c >= 144 && F.c < 144 + 88) { const int v = F.c - 144; sample_rs(F, WSP(float, S_X2), rs);
          sgemm_unit(F, ALNorm{WSP(float, S_X2), rs}, BRSwiglu{v}, WSP(bf16, WS_W2A), DM, EPSwigluRaw{WSP(float, S_H), v}); }
        GRID_BAR();
    }
    if (IN(7)) { FRESH();
        { pg8::Gemm g{WSP(bf16, WS_H), WSP(bf16, WS_W2B), MP, DM, FF}; pg8::StaticOrder S; S.init(MP, DM, F.G, F.c);
          pg8::EpiResid<false> E{WSP(float, WS_X1), F.out + O_Y, nullptr, nullptr, 0.5f};
          pg8::gemm_phase<pg8::EpiResid<false>, pg8::StaticOrder, true, true>(F.lds + RING_OFF, g, S, E); }
        if (F.c >= 240) { const int v = F.c - 240; sgemm_unit(F, ALSwiglu{WSP(float, S_H)}, BRPlain{v}, WSP(bf16, WS_W2B), FF, EPResid{WSP(float, S_X2), F.out + O_YS, 0.5f, v}); }
    }
#undef IN
#undef GRID_BAR
#undef FRESH
#undef rs
#undef ssq1
#undef ssq2
#undef ksum
#undef ssq0
}

extern "C" void kernel_launch(void* const* d_in, const int* in_sizes, int n_in, void* d_out, int out_size, void* d_ws, size_t ws_size, hipStream_t stream) {
    static int grid = 0;
    if (grid == 0) {
        if (n_in != 26 || (size_t)out_size != O_END || ws_size < WS_END) { fprintf(stderr, "kernel_launch: shape mismatch (n_in %d, out %d, ws %zu): nothing launched\n", n_in, out_size, ws_size); grid = -1; return; }
        int dev = 0, cus = 0, per_cu = 0;
        if (hipGetDevice(&dev) != hipSuccess || hipDeviceGetAttribute(&cus, hipDeviceAttributeMultiprocessorCount, dev) != hipSuccess) { grid = -1; return; }
        if (hipFuncSetAttribute((const void*)hymba_fwd, hipFuncAttributeMaxDynamicSharedMemorySize, LDS_BYTES) != hipSuccess) { fprintf(stderr, "kernel_launch: hipFuncSetAttribute failed\n"); grid = -1; return; }
        if (hipOccupancyMaxActiveBlocksPerMultiprocessor(&per_cu, (const void*)hymba_fwd, NWAVES * 64, LDS_BYTES) != hipSuccess || per_cu < 1)
            fprintf(stderr, "kernel_launch: note: occupancy query reports %d workgroups per CU\n", per_cu);
        (void)hipGetLastError();
        grid = cus < 256 ? cus : 256;
    }
    if (grid < 0) return;
    if (hipMemsetAsync((char*)d_ws + WS_CTL, 0, CTL_ZERO_BYTES, stream) != hipSuccess) return;
    Args a{};
    for (int i = 0; i < 26; ++i) a.in[i] = (const float*)d_in[i];
    a.out = (float*)d_out; a.ws = (unsigned char*)d_ws;
    for (int li = 0; li < N_LAUNCHES; ++li) {
        a.ph_lo = (N_LAUNCHES == 1) ? 0 : li; a.ph_hi = (N_LAUNCHES == 1) ? PER_PHASE : li + 1;
        hipLaunchKernelGGL(hymba_fwd, dim3(grid), dim3(NWAVES * 64), LDS_BYTES, stream, a);
        const hipError_t le = hipPeekAtLastError();
        if (le != hipSuccess) { fprintf(stderr, "kernel_launch: launch %d failed: %s\n", li, hipGetErrorName(le)); break; }
    }
}
```

```cpp
#include <hip/hip_runtime.h>
#include <hip/hip_bf16.h>
#include <cstdio>
#include <cstdint>
#include <cmath>
constexpr int NWAVES = 8;
#ifndef MK_N_LAUNCHES
#define MK_N_LAUNCHES 1
#endif
constexpr int PER_PHASE = 8;
constexpr int N_LAUNCHES = MK_N_LAUNCHES;
static_assert(N_LAUNCHES == 1 || N_LAUNCHES == PER_PHASE, "MK_N_LAUNCHES is 1 or 8");

constexpr int DM = 1024, NB = 8, SEQ = 2048, MP = NB * SEQ;
constexpr int NS = 32, PAST = 8192, PAGE = 128, NPG = PAST / PAGE;
constexpr int FF = 2816, FF2 = 2 * FF, INC = 2048, MEML = 256, MM = NB * MEML;
constexpr float RMS_EPS = 1e-6f;
constexpr float C2 = 0.125f * 1.4426950408889634f;
constexpr size_t O_Y = 0, O_YS = O_Y + (size_t)MP * DM, O_KP = O_YS + (size_t)NS * DM, O_VP = O_KP + (size_t)MP * 512, O_MK = O_VP + (size_t)MP * 512, O_MV = O_MK + (size_t)MM * 256,
                 O_PS = O_MV + (size_t)MM * 256, O_KS = O_PS + (size_t)NB * 15 * 256, O_VS = O_KS + (size_t)NS * 512, O_PSS = O_VS + (size_t)NS * 512, O_END = O_PSS + (size_t)NS * 15 * 256;

constexpr size_t MiB = 1u << 20;
constexpr size_t WS_CTL = 0, CTL_ZERO_BYTES = 4 * MiB;
constexpr int CW_TMO = 0, CW_CODE = 1, CW_BAR = 4096;
constexpr int CW_SSQ1 = 16384, CW_SSQ2 = CW_SSQ1 + MP, CW_KSUM = CW_SSQ2 + MP, CW_ZERO = CW_KSUM + NB * 8 * 8 * 64, CW_SKSUM = CW_ZERO + 1024, CW_SSQS = CW_SKSUM + NS * 32 * 512, CW_END = CW_SSQS + 128;
static_assert((size_t)CW_END * 4 <= CTL_ZERO_BYTES, "CTL words inside the memset region");
constexpr size_t WS_W1A = 4 * MiB, WS_W1B = WS_W1A + 11 * MiB, WS_W2A = WS_W1B + 6 * MiB, WS_W2B = WS_W2A + 11 * MiB, WS_WIN = WS_W2B + 6 * MiB, WS_WOUT = WS_WIN + 4 * MiB, WS_WMEM = WS_WOUT + 2 * MiB;
constexpr size_t WS_XB = WS_WMEM + 1 * MiB;
constexpr size_t WS_H = WS_XB + 32 * MiB;
constexpr size_t WS_X1 = WS_H + 88 * MiB;
constexpr size_t WS_U = WS_X1 + 64 * MiB, WS_Q = WS_U + 8 * MiB, WS_K = WS_Q + 16 * MiB, WS_V = WS_K + 16 * MiB, WS_QM = WS_V + 16 * MiB;
constexpr size_t WS_MNB = WS_QM + 8 * MiB, WS_MKB = WS_MNB + 4 * MiB, WS_MVB = WS_MKB + 1 * MiB, WS_MIX = WS_MVB + 1 * MiB;
constexpr size_t WS_ROPE = WS_MIX + 32 * MiB;
constexpr size_t WS_SKSUM = WS_CTL + (size_t)CW_SKSUM * 4;
constexpr size_t WS_SSQ0 = WS_ROPE + 1 * MiB;
constexpr size_t WS_GAIN = WS_SSQ0 + 512 * 1024;
constexpr size_t WS_S = WS_SSQ0 + 1 * MiB;
constexpr size_t S_H = WS_S, S_X1 = S_H + 1 * MiB, S_X2 = S_X1 + 128 * 1024, S_U = S_X2 + 128 * 1024, S_Q = S_U + 32 * 1024, S_QM = S_Q + 64 * 1024, S_MIX = S_QM + 32 * 1024;
constexpr size_t S_IMGX = S_MIX + 128 * 1024, S_IMGX1 = S_IMGX + 64 * 1024, S_IMGX2 = S_IMGX1 + 64 * 1024, S_IMGMIX = S_IMGX2 + 64 * 1024;
constexpr size_t WS_END = S_IMGMIX + 64 * 1024;
static_assert(WS_W1B - WS_W1A >= (size_t)FF2 * DM * 2 && WS_W2A - WS_W1B >= (size_t)DM * FF * 2, "weight copies fit");

#ifndef REP0
#define REP0 1
#endif
#ifndef REP1
#define REP1 1
#endif
#ifndef REP2
#define REP2 1
#endif
#ifndef REP3
#define REP3 1
#endif
#ifndef REP4
#define REP4 1
#endif
#ifndef REP5
#define REP5 1
#endif
#ifndef REP6
#define REP6 1
#endif
#ifndef REP7
#define REP7 1
#endif
constexpr size_t WS_DUMMY = WS_END;
constexpr int RING_OFF = 0, RING_BYTES = 131072;
constexpr int LDSCTL_OFF = RING_BYTES, MISC_OFF = LDSCTL_OFF + 320;
constexpr int SM_OFF = RING_BYTES + 1024;
constexpr int LDS_BYTES = 147456;
static_assert(MISC_OFF + 128 <= SM_OFF && SM_OFF + 8192 <= LDS_BYTES, "LDS map");


namespace pg8 {
#define PG8_LAS __attribute__((address_space(3)))
typedef unsigned short bf16_t;
typedef short bf16x8 __attribute__((ext_vector_type(8)));
typedef float f32x4 __attribute__((ext_vector_type(4)));
typedef unsigned u32x4 __attribute__((ext_vector_type(4)));
constexpr int BM = 256, BK = 64, HALF = 128, HTB = HALF * BK * 2  , STAGE_BYTES = 8 * HTB, NXCD = 8, WGM = 8;

__host__ __device__ __forceinline__ int lds_byte(int r, int c) { const int st = (r >> 4) * 2 + (c >> 5), rr = r & 15, cc = c & 31, ob = rr * 64 + cc * 2; return st * 1024 + (ob ^ (((ob >> 9) & 1) << 5)); }
__host__ __device__ __forceinline__ void stage_rc(int b, int& R, int& C) { const int st = b / 1024, sb = b % 1024, swz = sb ^ (((sb >> 9) & 1) << 5); R = (st >> 1) * 16 + swz / 64; C = (st & 1) * 32 + (swz % 64) / 2; }
__host__ __device__ __forceinline__ int perm32(int rho) { const int n = rho >> 4, i = rho & 15; return 8 * (i >> 2) + 4 * n + (i & 3); }

struct Unit { int pm, pn; };
struct Gemm { const bf16_t* A; const bf16_t* Bt; int M, N, K; };

struct StaticOrder {
    int nM, nN, nwg, G, c;
    __host__ __device__ void init(int M, int N, int G_, int c_) { nM = M / BM; nN = N / BM; nwg = nM * nN; G = G_; c = c_; }
    __host__ __device__ bool next(int i, Unit& u) const {
        const long L = (long)i * G + c; if (L >= nwg) return false;
        int wgid = (int)L; { const int q = nwg / NXCD, r = nwg % NXCD, xcd = wgid % NXCD, off = wgid / NXCD; wgid = (xcd < r ? xcd * (q + 1) : r * (q + 1) + (xcd - r) * q) + off; }
        const int nig = WGM * nN, gid = wgid / nig, fm = gid * WGM, gsz = (nM - fm) < WGM ? (nM - fm) : WGM;
        u.pm = fm + ((wgid % nig) % gsz); u.pn = (wgid % nig) / gsz; return true;
    }
    __device__ __forceinline__ void a_ready(const Unit&) const {}
    __device__ __forceinline__ void done(const Unit&) const {}
};

__device__ __forceinline__ unsigned cvt_pk_bf16(float lo, float hi) { unsigned r; asm volatile("v_cvt_pk_bf16_f32 %0, %1, %2" : "=v"(r) : "v"(lo), "v"(hi)); return r; }
typedef float f32x2 __attribute__((ext_vector_type(2)));
__device__ __forceinline__ f32x2 gelu_pk(f32x2 v) {
    const f32x2 av = __builtin_elementwise_abs(v), d = av * 0.2316418882f + 1.0f;
    f32x2 t; t.x = __builtin_amdgcn_rcpf(d.x); t.y = __builtin_amdgcn_rcpf(d.y);
    f32x2 q = t * 0.5307027145f + (-0.7265760135f); q = q * t + 0.7107068705f; q = q * t + (-0.142248368f); q = q * t + 0.127414796f; q = q * t;
    const f32x2 s = (v * v) * (-0.72134752044f);
    f32x2 e; e.x = __builtin_amdgcn_exp2f(s.x); e.y = __builtin_amdgcn_exp2f(s.y);
    const f32x2 m = v * (q * e), r = v - m;
    f32x2 o; o.x = v.x < 0.f ? m.x : r.x; o.y = v.y < 0.f ? m.y : r.y; return o;
}

constexpr float RMS_EPS_ = 1e-6f;
__device__ __forceinline__ float silu_f(float x) { return x * __builtin_amdgcn_rcpf(1.0f + __builtin_amdgcn_exp2f(-1.4426950408889634f * x)); }
__device__ __forceinline__ u32x4 pack8(const f32x4 a, const f32x4 b) { u32x4 w; w.x = cvt_pk_bf16(a[0], a[1]); w.y = cvt_pk_bf16(a[2], a[3]); w.z = cvt_pk_bf16(b[0], b[1]); w.w = cvt_pk_bf16(b[2], b[3]); return w; }

struct ListOrder {
    int nM, cnt, idx;
    __device__ __forceinline__ void init(int nM_, int nN_, int first, int c) { nM = nM_; cnt = nM_ * nN_; idx = c - first; }
    __device__ __forceinline__ bool next(int i, Unit& u) const { if (i > 0 || idx < 0 || idx >= cnt) return false; u.pm = idx % nM; u.pn = idx / nM; return true; }
    __device__ __forceinline__ void a_ready(const Unit&) const {}
    __device__ __forceinline__ void done(const Unit&) const {}
};

template <bool PF> struct EpiSwiglu {
    static constexpr bool PERM = true, AFTER_DRAIN = false;
    bf16_t* H; const float* ssq; int ldh;
    mutable float rq[8];
    __device__ __forceinline__ void prefetch(const Unit& u, int wr, int fr) const {
        if (!PF) return;
        const float* p = ssq + u.pm * BM + wr * 64 + fr;
#pragma unroll
        for (int q = 0; q < 8; ++q) asm volatile("global_load_dword %0, %1, off offset:%c2" : "=v"(rq[q]) : "v"(p + (q >> 2) * HALF), "n"((q & 3) * 64) : "memory");
    }
    __device__ __forceinline__ void operator()(const f32x4 (&acc)[2][2][4][2], const Unit& u, int wr, int wc, int fr, int fq) const {
        const int row0 = u.pm * BM + wr * 64 + fr, col0 = u.pn * HALF + wc * 32 + 8 * fq;
        if (PF) asm volatile("" : "+v"(rq[0]), "+v"(rq[1]), "+v"(rq[2]), "+v"(rq[3]), "+v"(rq[4]), "+v"(rq[5]), "+v"(rq[6]), "+v"(rq[7]) :: "memory");
        else {
#pragma unroll
            for (int q = 0; q < 8; ++q) rq[q] = ssq[row0 + (q >> 2) * HALF + (q & 3) * 16]; }
#pragma unroll
        for (int ai = 0; ai < 2; ++ai)
#pragma unroll
            for (int m = 0; m < 4; ++m) { const int row = row0 + ai * HALF + m * 16; const float rr = __builtin_amdgcn_rsqf(rq[ai * 4 + m] * (1.0f / 1024.0f) + RMS_EPS_);
                const float s1 = -1.4426950408889634f * rr, rr2 = rr * rr;
                const f32x4 g0 = acc[ai][0][m][0], g1 = acc[ai][0][m][1], u0 = acc[ai][1][m][0], u1 = acc[ai][1][m][1];
                f32x4 e0 = g0 * s1, e1 = g1 * s1;
#pragma unroll
                for (int i = 0; i < 4; ++i) { e0[i] = __builtin_amdgcn_rcpf(1.0f + __builtin_amdgcn_exp2f(e0[i])); e1[i] = __builtin_amdgcn_rcpf(1.0f + __builtin_amdgcn_exp2f(e1[i])); }
                const f32x4 h0 = (g0 * u0) * (e0 * rr2), h1 = (g1 * u1) * (e1 * rr2);
                *(u32x4*)(H + (size_t)row * ldh + col0) = pack8(h0, h1); }
    }
};

__device__ __forceinline__ f32x4 bf_lo4(const u32x4 w) { return (f32x4){__uint_as_float(w.x << 16), __uint_as_float(w.x & 0xffff0000u), __uint_as_float(w.y << 16), __uint_as_float(w.y & 0xffff0000u)}; }
__device__ __forceinline__ f32x4 bf_hi4(const u32x4 w) { return (f32x4){__uint_as_float(w.z << 16), __uint_as_float(w.z & 0xffff0000u), __uint_as_float(w.w << 16), __uint_as_float(w.w & 0xffff0000u)}; }
template <int MODE, int NBATCH = 1> struct EpiResid {
    static constexpr bool PERM = true, AFTER_DRAIN = false;
    const bf16_t* xin; bf16_t* xout; float* out; float* ssq; float alpha;
    __device__ __forceinline__ void prefetch(const Unit&, int, int) const {}
    __device__ __forceinline__ void operator()(const f32x4 (&acc)[2][2][4][2], const Unit& u, int wr, int wc, int fr, int fq) const {
        const int row0 = u.pm * BM + wr * 64 + fr, col0 = u.pn * BM + wc * 32 + 8 * fq;
        constexpr int AIB = 2 / NBATCH;
#pragma unroll
        for (int a0 = 0; a0 < 2; a0 += AIB) {
            u32x4 b[AIB][4][2];
#pragma unroll
            for (int ai = 0; ai < AIB; ++ai)
#pragma unroll
                for (int m = 0; m < 4; ++m)
#pragma unroll
                    for (int bj = 0; bj < 2; ++bj) b[ai][m][bj] = *(const u32x4*)(xin + (size_t)(row0 + (a0 + ai) * HALF + m * 16) * 1024 + col0 + bj * HALF);
#pragma unroll
            for (int ai = 0; ai < AIB; ++ai)
#pragma unroll
                for (int m = 0; m < 4; ++m) { const int row = row0 + (a0 + ai) * HALF + m * 16; const size_t off = (size_t)row * 1024 + col0; float ss = 0.f;
#pragma unroll
                    for (int bj = 0; bj < 2; ++bj) { const f32x4 o0 = bf_lo4(b[ai][m][bj]) + alpha * acc[a0 + ai][bj][m][0], o1 = bf_hi4(b[ai][m][bj]) + alpha * acc[a0 + ai][bj][m][1];
                        if (MODE == 0) { *(f32x4*)(out + off + bj * HALF) = o0; *(f32x4*)(out + off + bj * HALF + 4) = o1; }
                        else { *(u32x4*)(xout + off + bj * HALF) = pack8(o0, o1);
                            ss += (o0[0] * o0[0] + o0[1] * o0[1]) + (o0[2] * o0[2] + o0[3] * o0[3]) + (o1[0] * o1[0] + o1[1] * o1[1]) + (o1[2] * o1[2] + o1[3] * o1[3]); } }
                    if (MODE == 1) { ss += __shfl_xor(ss, 16); ss += __shfl_xor(ss, 32); if (fq == 0) atomicAdd(ssq + row, ss); } }
            if (NBATCH > 1) asm volatile("" ::: "memory");
        }
    }
};

__device__ __forceinline__ void head_rows(const f32x4 (&acc)[2][2][4][2], const int rowb, const int fq, const int fr, const float* ssq, const float* rope, float* pstate,
        const bool o_norm, const bool o_rot, const bool o_f32o, const bool o_ks, const bool o_pst, const float o_sc, bf16_t* o_ob, const int o_ldb, float* o_of, const int o_ldf, const float* o_gain, const int o_hcol, float* o_ksum) {
    f32x4 g[2][2];
#pragma unroll
    for (int bj = 0; bj < 2; ++bj)
#pragma unroll
        for (int n = 0; n < 2; ++n) g[bj][n] = o_norm ? *(const f32x4*)(o_gain + 32 * bj + 8 * fq + 4 * n) : (f32x4){1.f, 1.f, 1.f, 1.f};
    float rr8[8];
#pragma unroll
    for (int q = 0; q < 8; ++q) rr8[q] = __builtin_amdgcn_rsqf(ssq[rowb + (q >> 2) * HALF + (q & 3) * 16] * (1.0f / 1024.0f) + RMS_EPS_);
    f32x4 cs[2][2];
#pragma unroll
    for (int bj = 0; bj < 2; ++bj)
#pragma unroll
        for (int n = 0; n < 2; ++n) cs[bj][n] = (f32x4){0.f, 0.f, 0.f, 0.f};
#pragma unroll
    for (int ai = 0; ai < 2; ++ai)
#pragma unroll
        for (int m = 0; m < 4; ++m) { const int row = rowb + ai * HALF + m * 16; const float rr = rr8[ai * 4 + m];
            f32x4 v[2][2];
#pragma unroll
            for (int bj = 0; bj < 2; ++bj)
#pragma unroll
                for (int n = 0; n < 2; ++n) v[bj][n] = acc[ai][bj][m][n] * rr;
            { float ss = 0.f;
#pragma unroll
                for (int bj = 0; bj < 2; ++bj)
#pragma unroll
                    for (int n = 0; n < 2; ++n) ss += (v[bj][n][0] * v[bj][n][0] + v[bj][n][1] * v[bj][n][1]) + (v[bj][n][2] * v[bj][n][2] + v[bj][n][3] * v[bj][n][3]);
                ss += __shfl_xor(ss, 16); ss += __shfl_xor(ss, 32);
                const float hn = o_norm ? __builtin_amdgcn_rsqf(ss * (1.0f / 64.0f) + RMS_EPS_) : 1.0f;
#pragma unroll
                for (int bj = 0; bj < 2; ++bj)
#pragma unroll
                    for (int n = 0; n < 2; ++n) v[bj][n] = v[bj][n] * hn * g[bj][n];
            }
            if (o_rot) { const int pos = row & 2047; const float* rp = rope + pos * 16;
#pragma unroll
                for (int n = 0; n < 2; ++n) { const f32x4 t0 = *(const f32x4*)(rp + 8 * n), t1 = *(const f32x4*)(rp + 8 * n + 4);
                    const f32x4 x = v[0][n]; f32x4 y;
#pragma unroll
                    for (int i = 0; i < 4; ++i) y[i] = __shfl_xor(x[i], 16);
                    const float sg = (fq == 0) ? -1.f : 1.f;
                    f32x4 r_;
                    r_[0] = x[0] * t0[0] + sg * y[0] * t0[1]; r_[1] = x[1] * t0[2] + sg * y[1] * t0[3]; r_[2] = x[2] * t1[0] + sg * y[2] * t1[1]; r_[3] = x[3] * t1[2] + sg * y[3] * t1[3];
                    if (fq < 2) v[0][n] = r_; }
            }
#pragma unroll
            for (int bj = 0; bj < 2; ++bj)
#pragma unroll
                for (int n = 0; n < 2; ++n) cs[bj][n] += v[bj][n];
#pragma unroll
            for (int bj = 0; bj < 2; ++bj) { const int col = o_hcol + 32 * bj + 8 * fq;
                if (o_f32o) { *(f32x4*)(o_of + (size_t)row * o_ldf + col) = v[bj][0]; *(f32x4*)(o_of + (size_t)row * o_ldf + col + 4) = v[bj][1]; }
                if (o_pst) { const int t = row & 2047; if (t >= 2033) { float* pp = pstate + ((size_t)(row >> 11) * 15 + (t - 2033)) * 256 + col; *(f32x4*)pp = v[bj][0]; *(f32x4*)(pp + 4) = v[bj][1]; } }
                *(u32x4*)(o_ob + (size_t)row * o_ldb + col) = pack8(v[bj][0] * o_sc, v[bj][1] * o_sc); }
            if (m & 1) asm volatile("" ::: "memory"); }
    if (o_ks) {
#pragma unroll
        for (int bj = 0; bj < 2; ++bj)
#pragma unroll
            for (int n = 0; n < 2; ++n)
#pragma unroll
                for (int i = 0; i < 4; ++i) { float s = cs[bj][n][i]; s += __shfl_xor(s, 1); s += __shfl_xor(s, 2); s += __shfl_xor(s, 4); s += __shfl_xor(s, 8);
                    if (fr == 0) atomicAdd(o_ksum + 32 * bj + 8 * fq + 4 * n + i, s); }
    }
}
template <bool MEM> struct EpiHead {
    static constexpr bool PERM = true, AFTER_DRAIN = false;
    const float* ssq; const float* rope; float* outp; float* ksum; unsigned char* ws; float c2;
    __device__ __forceinline__ void prefetch(const Unit&, int, int) const {}
    __device__ __forceinline__ void operator()(const f32x4 (&acc)[2][2][4][2], const Unit& u, int wr, int wc, int fr, int fq) const {
        const int rowb = u.pm * BM + wr * 64 + fr; const int pn = u.pn;
        const float* gains = (const float*)(ws + WS_GAIN);
        if (MEM) {
            head_rows(acc, rowb, fq, fr, ssq, rope, outp + O_PS, pn == 0, false, true, false, false, 1.f, (bf16_t*)(ws + (pn == 0 ? WS_MKB : WS_MVB)), 256, outp + (pn == 0 ? O_MK : O_MV), 256, gains + 3 * 64, 64 * wc, ksum);
        } else {
            const bool isq = (pn == 1 || pn == 2), isk = (pn == 3 || pn == 4), isv = (pn == 5 || pn == 6), ism = (pn == 7);
            const size_t boff = pn == 0 ? WS_U : (isq ? WS_Q : (isk ? WS_K : (isv ? WS_V : WS_QM)));
            head_rows(acc, rowb, fq, fr, ssq, rope, outp + O_PS, isq || isk || ism, isq || isk, isk || isv, isk, pn == 0, (isq || ism) ? c2 : 1.f, (bf16_t*)(ws + boff), (pn == 0 || ism) ? 256 : 512,
                      outp + (isk ? O_KP : O_VP), 512, gains + (isq ? 0 : (isk ? 64 : 128)), ((pn == 0 || ism) ? 0 : 256 * ((pn - 1) & 1)) + 64 * wc, ksum + (size_t)u.pm * 512 + (4 * ((pn - 1) & 1) + wc) * 64);
        }
    }
};

struct NoStream { static constexpr int NX = 0; __device__ __forceinline__ void wait() { asm volatile("s_waitcnt vmcnt(8)" ::: "memory"); } __device__ __forceinline__ void start_a() {} __device__ __forceinline__ void start() {} __device__ __forceinline__ void begin_unit(int) {} template <int SEL> __device__ __forceinline__ void sp(int, int) {} __device__ __forceinline__ void finish() {} };
template <class Epi, class Sched, bool ALIGN_EPI = false, bool SP2 = false, class Strm = NoStream>
__device__ __forceinline__ void gemm_phase(PG8_LAS unsigned char* lds, const Gemm g, const Sched& S, const Epi& E, Strm& X) {
    const int tid = threadIdx.x, wid = __builtin_amdgcn_readfirstlane(tid >> 6), lane = tid & 63, wr = wid >> 2, wc = wid & 3, fr = lane & 15, fq = lane >> 4;
    const int K = g.K, nt = K / BK;
    unsigned voffA[2], voffB[2];
#pragma unroll
    for (int i = 0; i < 2; ++i) { int R, C; stage_rc(tid * 16 + i * 8192, R, C); const int Rb = Epi::PERM ? ((R & ~31) + perm32(R & 31)) : R;
        voffA[i] = (unsigned)(R * K + C) * 2u; voffB[i] = (unsigned)(Rb * K + C) * 2u; }
    const size_t kstep = (size_t)(BK * 2);
    const size_t hstep = (size_t)HALF * K * 2;
    const size_t tstep = 2 * hstep;
    const unsigned ldsw = (unsigned)wid * 1024u;
    const int aoff = lds_byte(wr * 64 + fr, fq * 8), boff = lds_byte(wc * 32 + fr, fq * 8);
#define PG8_SA(b, h) (((b) * 2 + (h)) * HTB)
#define PG8_SB(b, h) ((4 + (b) * 2 + (h)) * HTB)
#define PG8_STAGE(bufoff, gbase, voff) do { _Pragma("unroll") for (int _i = 0; _i < 2; ++_i) \
        __builtin_amdgcn_global_load_lds((const unsigned*)((const char*)(gbase) + (voff)[_i]), (PG8_LAS unsigned*)(lds + (bufoff) + ldsw + _i * 8192), 16, 0, 0); } while (0)
#define PG8_LDA(dst, b, h) do { _Pragma("unroll") for (int m = 0; m < 4; ++m) _Pragma("unroll") for (int k = 0; k < 2; ++k) dst[m][k] = *(const PG8_LAS bf16x8*)(lds + PG8_SA(b, h) + aoff + m * 2048 + k * 1024); } while (0)
#define PG8_LDB(dst, b, h) do { _Pragma("unroll") for (int n = 0; n < 2; ++n) _Pragma("unroll") for (int k = 0; k < 2; ++k) dst[n][k] = *(const PG8_LAS bf16x8*)(lds + PG8_SB(b, h) + boff + n * 2048 + k * 1024); } while (0)
#define PG8_MMA(ai, bj, At, Bt) do { __builtin_amdgcn_s_setprio(1); _Pragma("unroll") for (int m = 0; m < 4; ++m) _Pragma("unroll") for (int n = 0; n < 2; ++n) _Pragma("unroll") for (int k = 0; k < 2; ++k) \
        acc[ai][bj][m][n] = __builtin_amdgcn_mfma_f32_16x16x32_bf16(Bt[n][k], At[m][k], acc[ai][bj][m][n], 0, 0, 0); __builtin_amdgcn_s_setprio(0); } while (0)
#define PG8_WAIT_V(n) asm volatile("s_waitcnt vmcnt(" #n ")" ::: "memory")
#define PG8_WAIT_L(n) asm volatile("s_waitcnt lgkmcnt(" #n ")" ::: "memory")
#define PG8_WAIT_VX X.wait()
#define PG8_BAR __builtin_amdgcn_s_barrier()
#define PG8_SCHED __builtin_amdgcn_sched_barrier(0)
    Unit cur, nxt; int ui = 0;
    if (!S.next(0, cur)) return;
    f32x4 acc[2][2][4][2];
#pragma unroll
    for (int a = 0; a < 2; ++a)
#pragma unroll
        for (int b = 0; b < 2; ++b)
#pragma unroll
            for (int m = 0; m < 4; ++m)
#pragma unroll
                for (int n = 0; n < 2; ++n) acc[a][b][m][n] = (f32x4){0.f, 0.f, 0.f, 0.f};
    bf16x8 At[4][2], B0[2][2], B1[2][2];
    const char* cA = (const char*)g.A + (size_t)cur.pm * tstep; const char* cB = (const char*)g.Bt + (size_t)cur.pn * tstep;
    S.a_ready(cur);
    if constexpr (SP2) {
        PG8_STAGE(PG8_SB(0, 0), cB, voffB); PG8_STAGE(PG8_SB(0, 1), cB + hstep, voffB); PG8_STAGE(PG8_SA(0, 0), cA, voffA); PG8_STAGE(PG8_SA(0, 1), cA + hstep, voffA);
        if (wr == 1) PG8_BAR;
        PG8_WAIT_V(2); PG8_BAR;
        X.start_a();
        PG8_STAGE(PG8_SB(1, 0), cB + kstep, voffB); PG8_STAGE(PG8_SA(1, 0), cA + kstep, voffA); PG8_STAGE(PG8_SB(1, 1), cB + hstep + kstep, voffB);
        PG8_WAIT_V(6); PG8_BAR;
        X.start(); X.begin_unit(0);
    } else {
        PG8_STAGE(PG8_SB(0, 0), cB, voffB); PG8_STAGE(PG8_SA(0, 0), cA, voffA); PG8_STAGE(PG8_SB(0, 1), cB + hstep, voffB); PG8_STAGE(PG8_SA(0, 1), cA + hstep, voffA);
        if (wr == 1) PG8_BAR;
        PG8_WAIT_V(4); PG8_BAR;
        PG8_STAGE(PG8_SB(1, 0), cB + kstep, voffB); PG8_STAGE(PG8_SA(1, 0), cA + kstep, voffA); PG8_STAGE(PG8_SB(1, 1), cB + hstep + kstep, voffB);
        PG8_WAIT_V(6); PG8_BAR;
    }
    for (;;) {
        const bool has_next = S.next(ui + 1, nxt);
        const char* nA = has_next ? (const char*)g.A + (size_t)nxt.pm * tstep : cA; const char* nB = has_next ? (const char*)g.Bt + (size_t)nxt.pn * tstep : cB;
        for (int t = 0; t < nt; t += 2) {
            const bool last = (t == nt - 2);
            const char* a1 = cA + (size_t)(t + 1) * kstep;
            const char* a2 = last ? nA : cA + (size_t)(t + 2) * kstep; const char* b2 = last ? nB : cB + (size_t)(t + 2) * kstep;
            const char* a3 = a2 + kstep; const char* b3 = b2 + kstep;
            if (last && has_next) S.a_ready(nxt);
            if (last) E.prefetch(cur, wr, fr);
            if constexpr (SP2) {
            PG8_LDB(B0, 0, 0); PG8_LDB(B1, 0, 1); PG8_SCHED; PG8_LDA(At, 0, 0); PG8_STAGE(PG8_SA(1, 1), a1 + hstep, voffA);
            PG8_WAIT_VX; X.template sp<0>(2 * t, ui); PG8_WAIT_L(0); PG8_BAR; PG8_MMA(0, 0, At, B0); PG8_MMA(0, 1, At, B1); PG8_BAR; PG8_SCHED;
            PG8_LDA(At, 0, 1); PG8_STAGE(PG8_SB(0, 0), b2, voffB); PG8_STAGE(PG8_SB(0, 1), b2 + hstep, voffB); PG8_STAGE(PG8_SA(0, 0), a2, voffA);
            PG8_WAIT_VX; X.template sp<1>(2 * t + 1, ui); PG8_WAIT_L(0); PG8_BAR; PG8_MMA(1, 0, At, B0); PG8_MMA(1, 1, At, B1); PG8_BAR; PG8_SCHED;
            PG8_LDB(B0, 1, 0); PG8_LDB(B1, 1, 1); PG8_SCHED; PG8_LDA(At, 1, 0); PG8_STAGE(PG8_SA(0, 1), a2 + hstep, voffA);
            PG8_WAIT_VX; X.template sp<2>(2 * t + 2, ui); PG8_WAIT_L(0); PG8_BAR; PG8_MMA(0, 0, At, B0); PG8_MMA(0, 1, At, B1); PG8_BAR; PG8_SCHED;
            PG8_LDA(At, 1, 1); PG8_STAGE(PG8_SB(1, 0), b3, voffB); PG8_STAGE(PG8_SB(1, 1), b3 + hstep, voffB); PG8_STAGE(PG8_SA(1, 0), a3, voffA);
            PG8_WAIT_VX; X.template sp<3>(2 * t + 3, ui); PG8_WAIT_L(0); PG8_BAR; PG8_MMA(1, 0, At, B0); PG8_MMA(1, 1, At, B1); PG8_BAR; PG8_SCHED;
            } else {
            PG8_LDB(B0, 0, 0); PG8_SCHED; PG8_LDA(At, 0, 0); PG8_STAGE(PG8_SA(1, 1), a1 + hstep, voffA);
            PG8_WAIT_L(8); PG8_BAR; PG8_WAIT_L(0); PG8_MMA(0, 0, At, B0); PG8_BAR; PG8_SCHED;
            PG8_LDB(B1, 0, 1); PG8_STAGE(PG8_SB(0, 0), b2, voffB);
            PG8_BAR; PG8_WAIT_L(0); PG8_MMA(0, 1, At, B1); PG8_BAR;
            PG8_LDA(At, 0, 1); PG8_STAGE(PG8_SA(0, 0), a2, voffA);
            PG8_BAR; PG8_WAIT_L(0); PG8_MMA(1, 0, At, B0); PG8_BAR; PG8_SCHED;
            PG8_STAGE(PG8_SB(0, 1), b2 + hstep, voffB);
            PG8_WAIT_V(6); PG8_BAR; PG8_MMA(1, 1, At, B1); PG8_BAR;
            PG8_LDB(B0, 1, 0); PG8_SCHED; PG8_LDA(At, 1, 0); PG8_STAGE(PG8_SA(0, 1), a2 + hstep, voffA);
            PG8_WAIT_L(8); PG8_BAR; PG8_WAIT_L(0); PG8_MMA(0, 0, At, B0); PG8_BAR; PG8_SCHED;
            PG8_LDB(B1, 1, 1); PG8_STAGE(PG8_SB(1, 0), b3, voffB);
            PG8_BAR; PG8_WAIT_L(0); PG8_MMA(0, 1, At, B1); PG8_BAR;
            PG8_LDA(At, 1, 1); PG8_STAGE(PG8_SA(1, 0), a3, voffA);
            PG8_BAR; PG8_WAIT_L(0); PG8_MMA(1, 0, At, B0); PG8_BAR; PG8_SCHED;
            PG8_STAGE(PG8_SB(1, 1), b3 + hstep, voffB);
            PG8_WAIT_V(6); PG8_BAR; PG8_MMA(1, 1, At, B1); PG8_BAR;
            }
        }
        if constexpr (ALIGN_EPI) { if (wr == 0) PG8_BAR; }
        if constexpr (!Epi::AFTER_DRAIN) { E(acc, cur, wr, wc, fr, fq); S.done(cur); }
        if (!has_next) break;
#pragma unroll
        for (int a = 0; a < 2; ++a)
#pragma unroll
            for (int b = 0; b < 2; ++b)
#pragma unroll
                for (int m = 0; m < 4; ++m)
#pragma unroll
                    for (int n = 0; n < 2; ++n) acc[a][b][m][n] = (f32x4){0.f, 0.f, 0.f, 0.f};
        cur = nxt; cA = nA; cB = nB; ++ui;
        X.begin_unit(ui);
        if constexpr (ALIGN_EPI) { if (wr == 1) PG8_BAR; }
    }
    PG8_WAIT_V(0);
    X.finish();
    if constexpr (!ALIGN_EPI) { if (wr == 0) PG8_BAR; }
    PG8_BAR;
    if constexpr (Epi::AFTER_DRAIN) { E.fused(acc, cur, wr, wc, fr, fq, lds, wid, lane); S.done(cur); }
#undef PG8_SA
#undef PG8_SB
#undef PG8_STAGE
#undef PG8_LDA
#undef PG8_LDB
#undef PG8_MMA
#undef PG8_WAIT_V
#undef PG8_WAIT_L
#undef PG8_WAIT_VX
#undef PG8_BAR
#undef PG8_SCHED
}
}

namespace attn_body {
using bf16=__hip_bfloat16;
using bf16x8=__attribute__((ext_vector_type(8)))short;
using s16x4=__attribute__((ext_vector_type(4)))short;
using f32x16=__attribute__((ext_vector_type(16)))float;
using u32x4=__attribute__((ext_vector_type(4)))unsigned;
using f32x4_t=__attribute__((ext_vector_type(4)))float;
__device__ __forceinline__ float bf2f(short s){return __uint_as_float(((unsigned)(unsigned short)s)<<16);}
constexpr int D=64;
constexpr int NW=8,QBLK=32,QB=QBLK*NW,KVBLK=64;
constexpr int ATTN_UNIT_ROWS=QB;
__device__ __forceinline__ int crow(int r,int hi){return (r&3)+8*(r>>2)+4*hi;}
#define SBAR() __builtin_amdgcn_sched_barrier(0)
__device__ __forceinline__ void cmask(f32x16&p0,f32x16&p1,int jb,int qrel,int hi){
  const float NEG=-INFINITY; int kb=64*jb+4*hi;
  #pragma unroll
  for(int r=0;r<16;++r){int kv=kb+(r&3)+8*(r>>2); if(kv>qrel)p0[r]=NEG; if(kv+32>qrel)p1[r]=NEG;}
}

constexpr int NSLOT=3, SLOTB=8192;
constexpr int LDS_K=0, LDS_V=NSLOT*SLOTB, LDS_WS=2*NSLOT*SLOTB, LDS_OST=LDS_WS+NW*64*4, LDS_BYTES=LDS_OST+NW*4096;
constexpr float C2=0.125f*1.4426950408889634f;
__device__ __forceinline__ void glds16(const void*gsrc,unsigned lds_dst){unsigned keep;
  asm volatile("s_mov_b32 %0, m0\n\ts_mov_b32 m0, %2\n\ts_nop 0\n\tglobal_load_lds_dwordx4 %1, off\n\ts_mov_b32 m0, %0":"=&s"(keep):"v"(gsrc),"s"(lds_dst):"memory");}
__device__ __forceinline__ float max3f(float a,float b,float c){float r;asm("v_max3_f32 %0, %1, %2, %3":"=v"(r):"v"(a),"v"(b),"v"(c));return r;}
__device__ __forceinline__ float max2f(float a,float b){float r;asm("v_max_f32_e32 %0, %1, %2":"=v"(r):"v"(a),"v"(b));return r;}
__device__ __forceinline__ float fadd_s(float a,float b){float r;asm("v_add_f32_e32 %0, %1, %2":"=v"(r):"v"(a),"v"(b));return r;}
__device__ __forceinline__ float fsub_s(float a,float b){float r;asm("v_sub_f32_e32 %0, %1, %2":"=v"(r):"v"(a),"v"(b));return r;}
typedef float f32x2_t __attribute__((ext_vector_type(2))); typedef __bf16 bf16x2_t __attribute__((ext_vector_type(2)));
__device__ __forceinline__ unsigned cvtpk_s(float lo,float hi){f32x2_t v={lo,hi};bf16x2_t b=__builtin_convertvector(v,bf16x2_t);return __builtin_bit_cast(unsigned,b);}
#define WAIT_BAR(N) asm volatile("s_waitcnt vmcnt(" #N ") lgkmcnt(0)\n\ts_barrier":::"memory")

__device__ __forceinline__ void qkt(f32x16&p0,f32x16&p1,const char*Kslot,const bf16x8*qr,const f32x16&negm,int r32,int hi){
  const char*kb=Kslot+hi*1024+r32*16;
  #pragma unroll
  for(int d0=0;d0<4;++d0){
    const bf16x8 b0=*reinterpret_cast<const bf16x8*>(kb+d0*2048);
    const bf16x8 b1=*reinterpret_cast<const bf16x8*>(kb+d0*2048+512);
    if(d0==0){p0=__builtin_amdgcn_mfma_f32_32x32x16_bf16(b0,qr[0],negm,0,0,0);p1=__builtin_amdgcn_mfma_f32_32x32x16_bf16(b1,qr[0],negm,0,0,0);}
    else{p0=__builtin_amdgcn_mfma_f32_32x32x16_bf16(b0,qr[d0],p0,0,0,0);p1=__builtin_amdgcn_mfma_f32_32x32x16_bf16(b1,qr[d0],p1,0,0,0);}}
}
typedef __attribute__((address_space(3))) const char* lds_cptr;
typedef short v4i16_t __attribute__((ext_vector_type(4)));
__device__ __forceinline__ void kload8(bf16x8*kf,lds_cptr kp){
  kf[0]=*(const __attribute__((address_space(3))) bf16x8*)(kp);      kf[1]=*(const __attribute__((address_space(3))) bf16x8*)(kp+512);
  kf[2]=*(const __attribute__((address_space(3))) bf16x8*)(kp+2048); kf[3]=*(const __attribute__((address_space(3))) bf16x8*)(kp+2560);
  kf[4]=*(const __attribute__((address_space(3))) bf16x8*)(kp+4096); kf[5]=*(const __attribute__((address_space(3))) bf16x8*)(kp+4608);
  kf[6]=*(const __attribute__((address_space(3))) bf16x8*)(kp+6144); kf[7]=*(const __attribute__((address_space(3))) bf16x8*)(kp+6656);
}
__device__ __forceinline__ void kload2(bf16x8*kf,lds_cptr kp,int j){ kf[2*j]=*(const __attribute__((address_space(3))) bf16x8*)(kp+j*2048); kf[2*j+1]=*(const __attribute__((address_space(3))) bf16x8*)(kp+j*2048+512); }
__device__ __forceinline__ s16x4 vtr(lds_cptr p){ return __builtin_bit_cast(s16x4,__builtin_amdgcn_ds_read_tr16_b64_v4i16((__attribute__((address_space(3))) v4i16_t*)p)); }
__device__ __forceinline__ float rowmax(const f32x16&p0,const f32x16&p1){
  float a=max3f(p0[0],p0[1],p1[0]),b=max3f(p0[2],p0[3],p1[1]);a=max3f(a,p1[2],p1[3]);
  #pragma unroll
  for(int r=4;r<16;r+=4){a=max3f(a,p0[r],p0[r+1]);b=max3f(b,p0[r+2],p0[r+3]);a=max3f(a,p1[r],p1[r+1]);b=max3f(b,p1[r+2],p1[r+3]);}
  const float m=max2f(a,b);
  auto rr=__builtin_amdgcn_permlane32_swap(__float_as_uint(m),__float_as_uint(m),false,false);
  return max2f(__uint_as_float(rr[0]),__uint_as_float(rr[1]));
}
__device__ __forceinline__ void pv(f32x16*o,int vb,bf16x8 pa0,bf16x8 pa1,bf16x8 pa2,bf16x8 pa3){
  #pragma unroll
  for(int d0=0;d0<2;++d0){s16x4 lo[4],hi[4];
    #pragma unroll
    for(int ks=0;ks<4;++ks){
      asm volatile("ds_read_b64_tr_b16 %0,%1 offset:%c2":"=&v"(lo[ks]):"v"(vb),"i"(d0*4096+ks*1024):"memory");
      asm volatile("ds_read_b64_tr_b16 %0,%1 offset:%c2":"=&v"(hi[ks]):"v"(vb),"i"(d0*4096+ks*1024+512):"memory");}
    asm volatile("s_waitcnt lgkmcnt(0)":::"memory");SBAR();
    #define PK(k) (bf16x8){lo[k][0],lo[k][1],lo[k][2],lo[k][3],hi[k][0],hi[k][1],hi[k][2],hi[k][3]}
    o[d0]=__builtin_amdgcn_mfma_f32_32x32x16_bf16(pa0,PK(0),o[d0],0,0,0);
    o[d0]=__builtin_amdgcn_mfma_f32_32x32x16_bf16(pa1,PK(1),o[d0],0,0,0);
    o[d0]=__builtin_amdgcn_mfma_f32_32x32x16_bf16(pa2,PK(2),o[d0],0,0,0);
    o[d0]=__builtin_amdgcn_mfma_f32_32x32x16_bf16(pa3,PK(3),o[d0],0,0,0);
    #undef PK
  }
}

#ifndef ATTN_STORE16
#define ATTN_STORE16(p,v) (*(u32x4*)(p)=(v))
#endif
template<int THRL,int MODE,int QP,int KP,int OP> __device__ __forceinline__ void attn_unit(const bf16*Qu,const bf16*__restrict__ Kh,const bf16*__restrict__ Vh,bf16*Ou,const int NT,const __attribute__((address_space(3))) unsigned char*seltab,char*shm){
  const int tid=threadIdx.x,lane=tid&63,r32=lane&31,hi=lane>>5; const int wid=__builtin_amdgcn_readfirstlane(tid>>6);
  const bf16*Qw=Qu+(long)(wid*QBLK)*QP;
  const unsigned lds0=(unsigned)(uintptr_t)shm;
  float*wsf=(float*)(shm+LDS_WS)+wid*64;
  const bf16*ksrc=Kh+(long)lane*KP+wid*8;
  const bf16*vsrc=Vh+(long)(16*(wid&3)+(lane>>2))*KP+(wid>>2)*32+(lane&3)*8;
  const unsigned kdst=lds0+LDS_K+wid*1024, vdst=lds0+LDS_V+wid*1024;
  #define PHYS(t) (MODE==1?(((t)<4)?((t)+NT-4):((t)-4)):(t))
  #define DMA_K(t,slot) glds16(ksrc+(long)PHYS(t)*KVBLK*KP,(unsigned)__builtin_amdgcn_readfirstlane(kdst+(slot)))
  #define DMA_V(t,slot) glds16(vsrc+(long)PHYS(t)*KVBLK*KP,(unsigned)__builtin_amdgcn_readfirstlane(vdst+(slot)))
  const char*Kbase=shm+LDS_K; bf16x8 kf[8];
  const lds_cptr shm3=(lds_cptr)shm; const lds_cptr kp0=shm3+LDS_K+hi*1024+r32*16; const lds_cptr vp0=shm3+LDS_V+((lane>>4)&1)*32+(lane&3)*8+(4*hi+((lane&15)>>2))*64;
  DMA_K(0,0);DMA_V(0,0);DMA_K(1,SLOTB);
  bf16x8 qr[4];
  #pragma unroll
  for(int d0=0;d0<4;++d0)qr[d0]=*reinterpret_cast<const bf16x8*>(&Qw[(long)r32*QP+d0*16+hi*8]);
  unsigned sel=0x7fu; if(MODE==1) sel=(unsigned)seltab[wid*QBLK+r32];
  float mhat=0.f,l_reg=0.f;f32x16 o[2];o[0]=f32x16{};o[1]=f32x16{};const f32x16 negm=f32x16{};
  const int qrel=wid*QBLK+r32;
  #define CMASK(P0,P1,t) do{ if(MODE==1){ if((t)<4) cmask(P0,P1,(t),qrel,hi); else if(!((sel>>(((t)-4)>>2))&1u)){ _Pragma("unroll") for(int r_=0;r_<16;++r_){P0[r_]=-INFINITY;P1[r_]=-INFINITY;} } } }while(0)
  bool resc=false;
  #define START(P0,P1) do{ const float rm=rowmax(P0,P1); resc=false; \
    { const float dl=rm; mhat=fadd_s(mhat,dl); \
      _Pragma("unroll") for(int r=0;r<16;++r){P0[r]=fsub_s(P0[r],dl);P1[r]=fsub_s(P1[r],dl);} \
      } \
    _Pragma("unroll") for(int r=0;r<16;++r)P0[r]=__builtin_amdgcn_exp2f(P0[r]); }while(0)
  #define RESC() do{ if(resc){ asm volatile("s_waitcnt lgkmcnt(0)":::"memory"); \
      _Pragma("unroll") for(int d_=0;d_<2;++d_) _Pragma("unroll") for(int r=0;r<16;++r)o[d_][r]*=wsf[crow(r,hi)]; } }while(0)
  f32x16 pA0,pA1,pB0,pB1;
  int sl_prev=0,sl_cur=0,sl_next=SLOTB;
  #define ROT() do{sl_prev=sl_cur;sl_cur=sl_next;sl_next=(sl_next==(NSLOT-1)*SLOTB)?0:sl_next+SLOTB;}while(0)
  DMA_K(2,2*SLOTB);
  WAIT_BAR(3);
  qkt(pA0,pA1,Kbase,qr,negm,r32,hi);asm volatile("s_nop 15\n\ts_nop 7":"+v"(pA0),"+v"(pA1));if(MODE==1){ const int lim_=qrel-4*hi; _Pragma("unroll") for(int r_=0;r_<16;++r_){ const int c_=(r_&3)+8*(r_>>2); pA0[r_]=(c_>lim_)?-INFINITY:pA0[r_]; pA1[r_]=(c_+32>lim_)?-INFINITY:pA1[r_]; } }
  START(pA0,pA1);
  _Pragma("unroll") for(int r=0;r<16;++r)pA1[r]=__builtin_amdgcn_exp2f(pA1[r]);
  WAIT_BAR(0);
  DMA_K(3,0);DMA_V(1,SLOTB);
  ROT();
  kload8(kf,kp0+sl_cur);
  WAIT_BAR(2);
  s16x4 vlo[8],vhi[8]; u32x4 pw0,pw1,pw2,pw3;
  #define PKW(P,B) cvtpk_s(P[B],P[B+1])
  #define PAF(k) __builtin_bit_cast(bf16x8,pw##k)
  #define VFR(i) (bf16x8){vlo[i][0],vlo[i][1],vlo[i][2],vlo[i][3],vhi[i][0],vhi[i][1],vhi[i][2],vhi[i][3]}
  #define PIN(x) asm volatile("":"+v"(x))
  #define MX3(a,b,c) __builtin_fmaxf(__builtin_fmaxf((a),(b)),(c))
  #define GAPA(MF,A0,A1,A2,A3,W0,W1,PW) do{ MF; sacc+=A0; sacc+=A1; sacc+=A2; sacc+=A3; PIN(sacc); W0; W1; PIN(PW); SBAR(); }while(0)
  #define EX(v) __builtin_amdgcn_exp2f(v)
  #define GAPB(MF,X,B) do{ MF; X[B]=EX(X[B]); X[B+1]=EX(X[B+1]); X[B+2]=EX(X[B+2]); X[B+3]=EX(X[B+3]); PIN(X); SBAR(); }while(0)
  #define VRD(i) do{ vlo[i]=vtr(vp_+(((i)>>2)*4096+((i)&3)*1024)); vhi[i]=vtr(vp_+(((i)>>2)*4096+((i)&3)*1024+512)); }while(0)
  #define KRD(G,j) do{ if(G){ kload2(kf,kp0+sl_next,j); SBAR(); } }while(0)
  #define STEP(C0,C1,P0,P1,t,GK,GV,GL,PAST) do{ SBAR(); \
    const lds_cptr vp_=vp0+sl_prev; \
    VRD(0); SBAR(); float sacc=(P0[0]+P0[1]); \
    GAPA(C0=__builtin_amdgcn_mfma_f32_32x32x16_bf16(kf[0],qr[0],negm,0,0,0), P0[2],P0[3],P0[4],P0[5],     pw0[0]=PKW(P0,0), pw0[1]=PKW(P0,2), pw0); \
    VRD(4); SBAR(); GAPA(C1=__builtin_amdgcn_mfma_f32_32x32x16_bf16(kf[1],qr[0],negm,0,0,0), P0[6],P0[7],P0[8],P0[9],     pw0[2]=PKW(P0,4), pw0[3]=PKW(P0,6), pw0); \
    VRD(1); SBAR(); GAPA(C0=__builtin_amdgcn_mfma_f32_32x32x16_bf16(kf[2],qr[1],C0,0,0,0),   P0[10],P0[11],P0[12],P0[13], pw1[0]=PKW(P0,8), pw1[1]=PKW(P0,10), pw1); \
    VRD(5); SBAR(); GAPA(C1=__builtin_amdgcn_mfma_f32_32x32x16_bf16(kf[3],qr[1],C1,0,0,0),   P0[14],P0[15],P1[0],P1[1],   pw1[2]=PKW(P0,12),pw1[3]=PKW(P0,14), pw1); \
    VRD(2); SBAR(); GAPA(C0=__builtin_amdgcn_mfma_f32_32x32x16_bf16(kf[4],qr[2],C0,0,0,0),   P1[2],P1[3],P1[4],P1[5],     pw2[0]=PKW(P1,0), pw2[1]=PKW(P1,2), pw2); \
    VRD(6); SBAR(); GAPA(C1=__builtin_amdgcn_mfma_f32_32x32x16_bf16(kf[5],qr[2],C1,0,0,0),   P1[6],P1[7],P1[8],P1[9],     pw2[2]=PKW(P1,4), pw2[3]=PKW(P1,6), pw2); \
    VRD(3); SBAR(); GAPA(C0=__builtin_amdgcn_mfma_f32_32x32x16_bf16(kf[6],qr[3],C0,0,0,0),   P1[10],P1[11],P1[12],P1[13], pw3[0]=PKW(P1,8), pw3[1]=PKW(P1,10), pw3); \
    VRD(7); SBAR(); GAPA(C1=__builtin_amdgcn_mfma_f32_32x32x16_bf16(kf[7],qr[3],C1,0,0,0),   P1[14],P1[15],0.f,0.f,       pw3[2]=PKW(P1,12),pw3[3]=PKW(P1,14), pw3); \
    l_reg+=sacc; \
    if(GK){DMA_K((t)+3,sl_cur);} if(GV){DMA_V((t)+1,sl_next);} \
    if(MODE==1 && (PAST)){ const float mh_=(((sel>>(((t)-4)>>2))&1u)!=0u)?mhat:INFINITY; _Pragma("unroll") for(int r_=0;r_<16;++r_){ C0[r_]-=mh_; C1[r_]-=mh_; } }   \
    else if(MODE==1){ const int lim_=LIM(t); _Pragma("unroll") for(int r_=0;r_<16;++r_){ const int c_=(r_&3)+8*(r_>>2); C0[r_]=(c_>lim_)?-INFINITY:(C0[r_]-mhat); C1[r_]=(c_+32>lim_)?-INFINITY:(C1[r_]-mhat); } } \
    else { _Pragma("unroll") for(int r_=0;r_<16;++r_){ C0[r_]-=mhat; C1[r_]-=mhat; } } \
    { float a=MX3(C0[0],C0[1],C1[0]),b=MX3(C0[2],C0[3],C1[1]); a=MX3(a,C1[2],C1[3]); \
      _Pragma("unroll") for(int r=4;r<16;r+=4){a=MX3(a,C0[r],C0[r+1]);b=MX3(b,C0[r+2],C0[r+3]);a=MX3(a,C1[r],C1[r+1]);b=MX3(b,C1[r+2],C1[r+3]);} \
      float rm=__builtin_fmaxf(a,b); { auto rr=__builtin_amdgcn_permlane32_swap(__float_as_uint(rm),__float_as_uint(rm),false,false); rm=__builtin_fmaxf(__uint_as_float(rr[0]),__uint_as_float(rr[1])); } \
      resc=false; \
      if(__builtin_expect(__any(rm>(float)THRL),0)){ const float dl=__builtin_fmaxf(rm,0.f); mhat+=dl; \
        _Pragma("unroll") for(int r=0;r<16;++r){C0[r]-=dl;C1[r]-=dl;} \
        const float f=__builtin_amdgcn_exp2f(-dl); l_reg*=f; if(hi==0)wsf[r32]=f; resc=true; } } \
    SBAR(); \
    GAPB(o[0]=__builtin_amdgcn_mfma_f32_32x32x16_bf16(PAF(0),VFR(0),o[0],0,0,0), C0,0); \
    GAPB(o[1]=__builtin_amdgcn_mfma_f32_32x32x16_bf16(PAF(0),VFR(4),o[1],0,0,0), C0,4); \
    KRD(GL,0); GAPB(o[0]=__builtin_amdgcn_mfma_f32_32x32x16_bf16(PAF(1),VFR(1),o[0],0,0,0), C0,8); \
    KRD(GL,1); GAPB(o[1]=__builtin_amdgcn_mfma_f32_32x32x16_bf16(PAF(1),VFR(5),o[1],0,0,0), C0,12); \
    KRD(GL,2); GAPB(o[0]=__builtin_amdgcn_mfma_f32_32x32x16_bf16(PAF(2),VFR(2),o[0],0,0,0), C1,0); \
    KRD(GL,3); GAPB(o[1]=__builtin_amdgcn_mfma_f32_32x32x16_bf16(PAF(2),VFR(6),o[1],0,0,0), C1,4); \
    GAPB(o[0]=__builtin_amdgcn_mfma_f32_32x32x16_bf16(PAF(3),VFR(3),o[0],0,0,0), C1,8); \
    GAPB(o[1]=__builtin_amdgcn_mfma_f32_32x32x16_bf16(PAF(3),VFR(7),o[1],0,0,0), C1,12); \
    }while(0)
  #define LIM(t) (((t)<4)?(qrel-64*(t)-4*hi):((((sel>>(((t)-4)>>2))&1u)!=0u)?1000:-1000))
  int t=1;
  for(;t<5&&t+5<NT;t+=2){
    STEP(pB0,pB1,pA0,pA1,t,true,true,true,false);     WAIT_BAR(2); RESC(); ROT();
    STEP(pA0,pA1,pB0,pB1,t+1,true,true,true,false);   WAIT_BAR(2); RESC(); ROT();
  }
  for(;t+5<NT;t+=2){
    STEP(pB0,pB1,pA0,pA1,t,true,true,true,true);      WAIT_BAR(2); RESC(); ROT();
    STEP(pA0,pA1,pB0,pB1,t+1,true,true,true,true);    WAIT_BAR(2); RESC(); ROT();
  }
  #define ENDW(tt) do{ if((tt)+3<NT){WAIT_BAR(2);} else if((tt)+2<NT){WAIT_BAR(1);} else {WAIT_BAR(0);} }while(0)
  for(;t+1<NT;t+=2){
    STEP(pB0,pB1,pA0,pA1,t,(t+3<NT),(t+1<NT),(t+1<NT),false);       ENDW(t);   RESC(); ROT();
    STEP(pA0,pA1,pB0,pB1,t+1,(t+4<NT),(t+2<NT),(t+2<NT),false);     ENDW(t+1); RESC(); ROT();
  }
  STEP(pB0,pB1,pA0,pA1,NT-1,false,false,false,false); RESC();
  { float sacc=pB0[0]+pB0[1]; _Pragma("unroll") for(int r=2;r<16;++r)sacc+=pB0[r]; _Pragma("unroll") for(int r=0;r<16;++r)sacc+=pB1[r]; l_reg+=sacc;
    pw0=(u32x4){PKW(pB0,0),PKW(pB0,2),PKW(pB0,4),PKW(pB0,6)};pw1=(u32x4){PKW(pB0,8),PKW(pB0,10),PKW(pB0,12),PKW(pB0,14)};pw2=(u32x4){PKW(pB1,0),PKW(pB1,2),PKW(pB1,4),PKW(pB1,6)};pw3=(u32x4){PKW(pB1,8),PKW(pB1,10),PKW(pB1,12),PKW(pB1,14)};
    int ln_=threadIdx.x&63; asm volatile("":"+v"(ln_)); const int vb0_=(int)(lds0+LDS_V)+((ln_>>4)&1)*32+(ln_&3)*8+(4*(ln_>>5)+((ln_&15)>>2))*64;
    SBAR(); pv(o,vb0_+sl_cur,PAF(0),PAF(1),PAF(2),PAF(3)); }
  #undef PKW
  #undef PAF
  #undef VFR
  #undef PIN
  #undef MX3
  #undef GAPA
  #undef GAPB
  #undef EX
  #undef VRD
  #undef KRD
  #undef STEP
  #undef ENDW
  #undef LIM
  {auto rr=__builtin_amdgcn_permlane32_swap(__float_as_uint(l_reg),__float_as_uint(l_reg),false,false);l_reg=__uint_as_float(rr[0])+__uint_as_float(rr[1]);}
  if(hi==0)wsf[32+r32]=l_reg;asm volatile("s_waitcnt lgkmcnt(0)":::"memory");
  float rli[16];
  #pragma unroll
  for(int r=0;r<16;++r)rli[r]=__builtin_amdgcn_rcpf(wsf[32+crow(r,hi)]);
  bf16*Ow=Ou+(long)(wid*QBLK)*OP;
  { bf16*stg=(bf16*)(shm+LDS_OST)+wid*2048;
    #pragma unroll
    for(int r=0;r<16;++r){const int orow=crow(r,hi);
      #pragma unroll
      for(int d0=0;d0<2;++d0)stg[orow*64+d0*32+r32]=__float2bfloat16(o[d0][r]*rli[r]);}
    asm volatile("s_waitcnt lgkmcnt(0)":::"memory");
    #pragma unroll
    for(int i=0;i<4;++i){const int row=i*8+(lane>>3),ch=lane&7; const u32x4 v=*(const u32x4*)(stg+row*64+ch*8); ATTN_STORE16(Ow+(long)row*OP+ch*8,v);} }
  asm volatile("s_waitcnt lgkmcnt(0)\n\ts_barrier":::"memory");
  #undef DMA_K
  #undef PHYS
  #undef DMA_V
  #undef CMASK
  #undef START
  #undef RESC
  #undef ROT
}
constexpr int ATTN_LDS_BYTES=LDS_BYTES;
#undef SBAR
#undef WAIT_BAR
}

#define GAS __attribute__((address_space(1)))
#define LAS __attribute__((address_space(3)))
typedef unsigned short bf16;
typedef unsigned v4u __attribute__((ext_vector_type(4)));
typedef float f32x4 __attribute__((ext_vector_type(4)));
typedef short bf16x8 __attribute__((ext_vector_type(8)));
typedef GAS unsigned gu32;
typedef GAS unsigned long long gu64;
#define RLX_AGENT __ATOMIC_RELAXED, __HIP_MEMORY_SCOPE_AGENT
#define LDS_WAIT() asm volatile("s_waitcnt lgkmcnt(0)" ::: "memory")
#define VM_WAIT() asm volatile("s_waitcnt vmcnt(0)" ::: "memory")
__device__ __forceinline__ unsigned long long rt() { return __builtin_amdgcn_s_memrealtime(); }
__device__ __forceinline__ unsigned f2bf(float f) { unsigned u = __builtin_bit_cast(unsigned, f); return (u + 0x7fffu + ((u >> 16) & 1u)) >> 16; }
__device__ __forceinline__ unsigned pk2(float lo, float hi) { return f2bf(lo) | (f2bf(hi) << 16); }

#define XB_TMO      128
#define XB_XCNT(j)  (256  + 64 * (j))
#define XB_XSUB(j)  (1280 + 64 * (j))
#define XB_XGEN(j)  (2304 + 64 * (j))
#define XB_TOP      3328
#define XB_TOPGEN   3392
#define XCD_BAR_WORDS 3456
#define XB_SPIN_CAP (1u << 18)

__device__ __forceinline__ unsigned xb_ld(unsigned* p)              { return __hip_atomic_load(p, __ATOMIC_RELAXED, __HIP_MEMORY_SCOPE_AGENT); }
__device__ __forceinline__ unsigned xb_add(unsigned* p, unsigned v) { return __hip_atomic_fetch_add(p, v, __ATOMIC_RELAXED, __HIP_MEMORY_SCOPE_AGENT); }
__device__ __forceinline__ unsigned xb_xcc_id() { return (unsigned)__builtin_amdgcn_s_getreg((3 << 11) | 20) & 0xFu; }
#define XB_SPIN(cond, bar) do { unsigned _sp = 0; while (cond) { __builtin_amdgcn_s_sleep(1); \
    if ((++_sp & 255u) == 0u) { if (xb_ld(&(bar)[XB_TMO])) break; if (_sp > XB_SPIN_CAP) { atomicAdd(&(bar)[XB_TMO], 1u); break; } } } } while (0)

struct XcdBarrier {
    unsigned* bar; unsigned x;
    volatile LAS unsigned* st;
};

__device__ __forceinline__ XcdBarrier xcd_barrier_post(unsigned* bar, volatile LAS unsigned* st) {
    XcdBarrier b; b.bar = bar; b.x = xb_xcc_id(); b.st = st;
    if (threadIdx.x == 0) (void)xb_add(&bar[XB_XCNT(b.x)], 1u);
    return b;
}
__device__ __forceinline__ void xcd_barrier_complete(unsigned* bar, unsigned x, unsigned& nloc, unsigned& nx) {
    const unsigned G = gridDim.x * gridDim.y * gridDim.z;
    unsigned sum, cnt, mine, sp = 0u;
    for (;;) {
        sum = 0u; cnt = 0u; mine = 0u;
#pragma unroll
        for (unsigned j = 0; j < 16; ++j) { const unsigned c = xb_ld(&bar[XB_XCNT(j)]); sum += c; cnt += (c > 0u) ? 1u : 0u; mine = (j == x) ? c : mine; }
        if (sum == G) break;
        __builtin_amdgcn_s_sleep(1);
        if ((++sp & 255u) == 0u) { if (xb_ld(&bar[XB_TMO])) break; if (sp > XB_SPIN_CAP) { atomicAdd(&bar[XB_TMO], 1u); break; } }
    }
    nloc = mine > 0u ? mine : 1u; nx = cnt > 0u ? cnt : 1u;
}

__device__ __forceinline__ void xcd_barrier(const XcdBarrier& b) {
    asm volatile("s_waitcnt vmcnt(0)" ::: "memory");
    __syncthreads();
    if (threadIdx.x == 0) {
        unsigned* bar = b.bar;
        __builtin_amdgcn_s_waitcnt(0);
        unsigned nloc = b.st[0], nx = b.st[1];
        if (nloc == 0u) { xcd_barrier_complete(bar, b.x, nloc, nx); b.st[0] = nloc; b.st[1] = nx; }
        const unsigned old = xb_add(&bar[XB_XSUB(b.x)], 1u);
        const unsigned gen = old / nloc;
        if (old + 1u == (gen + 1u) * nloc) {
            __builtin_amdgcn_fence(__ATOMIC_RELEASE, "agent");
            asm volatile("s_waitcnt vmcnt(0)" ::: "memory");
            const unsigned og = xb_add(&bar[XB_TOP], 1u);
            const unsigned tg = og / nx;
            if (og + 1u == (tg + 1u) * nx) xb_add(&bar[XB_TOPGEN], 1u);
            else XB_SPIN(xb_ld(&bar[XB_TOPGEN]) == tg, bar);
            __builtin_amdgcn_fence(__ATOMIC_ACQUIRE, "agent");
            xb_add(&bar[XB_XGEN(b.x)], 1u);
            asm volatile("s_waitcnt vmcnt(0)" ::: "memory");
        } else {
            XB_SPIN(xb_ld(&bar[XB_XGEN(b.x)]) == gen, bar);
            __builtin_amdgcn_fence(__ATOMIC_ACQUIRE, "agent");
            asm volatile("s_waitcnt vmcnt(0)" ::: "memory");
        }
    }
    __syncthreads();
}

typedef float f32x16 __attribute__((ext_vector_type(16)));
template <int I> __device__ __forceinline__ const float* karg() {
    const float* p;
    asm volatile("s_load_dwordx2 %0, %1, %2\n\ts_waitcnt lgkmcnt(0)" : "=s"(p) : "s"(__builtin_amdgcn_kernarg_segment_ptr()), "n"(I * 8) : "memory");
    return p;
}
struct Args { const float* in[26]; float* out; unsigned char* ws; int ph_lo, ph_hi; };
struct Frame {
    LAS unsigned char* lds;
    volatile LAS unsigned* MISC;
    gu32* ctl;
    unsigned char* ws;
    int tid, lane, wave, c, G;
    float* out;
};
#define WSP(T, off) ((T*)(F.ws + (off)))
__device__ __forceinline__ float wave_sum(float v) {
#pragma unroll
    for (int o = 1; o < 64; o <<= 1) v += __shfl_xor(v, o);
    return v;
}
__device__ __forceinline__ float bfbits2f(unsigned short s) { return __uint_as_float(((unsigned)s) << 16); }

__device__ __forceinline__ int frag_off(int r, int k) { return (k >> 4) * 512 + ((k >> 3) & 1) * 256 + r * 8 + (k & 7); }
__device__ __forceinline__ int map_swiglu(int c) { return c < FF ? 256 * (c >> 7) + (c & 127) : 256 * ((c - FF) >> 7) + 128 + ((c - FF) & 127); }
__device__ __forceinline__ int map_head(int c) { return (c & ~255) + 128 * ((c >> 5) & 1) + 32 * ((c >> 6) & 3) + (c & 31); }


template <int NPP, int BASE> struct KStream {
    static constexpr int NX = 1;
    unsigned char* ws; int c; bool on;
    int voff, voffe;
    f32x4 b0, b1, b2, b3, acc;
    const float* cur; const float* curB; int stride; float* dst;
    __device__ __forceinline__ void init(unsigned char* ws_, int c_, bool on_, int wave, int lane) {
        ws = ws_; c = c_; on = on_; voff = (wave >> 1) * 32 * 512 + (wave & 1) * 256 + 4 * lane; voffe = voff & 255;
        b0 = (f32x4){0.f, 0.f, 0.f, 0.f}; b1 = b0; b2 = b0; b3 = b0; acc = b0; cur = (const float*)(ws_ + WS_CTL) + CW_ZERO; curB = cur; stride = 0; dst = nullptr; }
    __device__ __forceinline__ void flush() {
        float* d = dst + ((voff >> 8) & 1) * 256 + ((voff & 255) >> 2);
        atomicAdd(d, acc[0]); atomicAdd(d + 64, acc[1]); atomicAdd(d + 128, acc[2]); atomicAdd(d + 192, acc[3]); }
    __device__ __forceinline__ f32x4 xload() const { f32x4 r; asm volatile("s_nop 4\n\tglobal_load_dwordx4 %0, %1, %2 nt" : "=v"(r) : "v"(voffe * 4), "s"(cur) : "memory"); return r; }
    __device__ __forceinline__ void wait() { asm volatile("s_waitcnt vmcnt(10)" : "+v"(b0), "+v"(b1), "+v"(b2), "+v"(b3) :: "memory"); }
    __device__ __forceinline__ void start_a() { b2 = xload(); }
    __device__ __forceinline__ void start() { b3 = xload(); }
    __device__ __forceinline__ void begin_unit(const int ui) {
        if (ui == 0) asm volatile("s_waitcnt vmcnt(0)" : "+v"(b0), "+v"(b1), "+v"(b2), "+v"(b3) :: "memory"); else asm volatile("" : "+v"(b0), "+v"(b1), "+v"(b2), "+v"(b3) :: "memory");
        acc += b0; acc += b1; acc += b2; acc += b3; b0 = (f32x4){0.f, 0.f, 0.f, 0.f}; b1 = b0; b2 = b0; b3 = b0;
        if (dst) flush();
        acc = (f32x4){0.f, 0.f, 0.f, 0.f};
        const int idx = BASE + (ui * 256 + c) * NPP; const float* zero = (const float*)(ws + WS_CTL) + CW_ZERO;
        if (on && idx + NPP <= 2048) { const int* pt = (const int*)karg<8>(); const float* ck = karg<3>();
            const int pa = __builtin_amdgcn_readfirstlane(pt[idx]), pb = __builtin_amdgcn_readfirstlane(pt[idx + NPP - 1]);
            cur = ck + (size_t)pa * (PAGE * 512); curB = ck + (size_t)pb * (PAGE * 512); stride = 512; voffe = voff;
            dst = (float*)(ws + WS_SKSUM) + (size_t)((idx >> 6) * 32 + ((idx & 63) >> 1)) * 512; }
        else { cur = zero; curB = zero; stride = 0; voffe = voff & 255; dst = nullptr; }
    }
    template <int SEL> __device__ __forceinline__ void sp(const int s, const int) {
        acc += SEL == 0 ? b0 : (SEL == 1 ? b1 : (SEL == 2 ? b2 : b3));
        if (NPP == 2) { if (s == 32) cur = curB; }
        if (s == NPP * 32) { cur = (const float*)(ws + WS_CTL) + CW_ZERO; stride = 0; voffe = voff & 255; }
        const f32x4 v = xload(); cur += stride;
        if (SEL == 0) b0 = v; else if (SEL == 1) b1 = v; else if (SEL == 2) b2 = v; else b3 = v;
    }
    __device__ __forceinline__ void finish() { asm volatile("s_waitcnt vmcnt(0)" : "+v"(b0), "+v"(b1), "+v"(b2), "+v"(b3) :: "memory"); acc += b0; acc += b1; acc += b2; acc += b3; if (dst) flush(); dst = nullptr; }
};

__device__ __forceinline__ void p0_transpose_item(const float* W, int K, int N, bf16* WT, int prow0, const float* gain, LAS float* scr, int k0, int n0, int lane) {
    const int r8 = lane >> 3, c4 = lane & 7;
    f32x4 w[8]; float gk[8];
#pragma unroll
    for (int i = 0; i < 8; ++i) { const int kk = 8 * i + r8; w[i] = __builtin_nontemporal_load((const f32x4*)(W + (size_t)(k0 + kk) * N + n0 + 4 * c4)); gk[i] = gain ? gain[k0 + kk] : 1.0f; }
#pragma unroll
    for (int i = 0; i < 8; ++i) { const int kk = 8 * i + r8; LAS float* d = scr + kk * 33 + 4 * c4; d[0] = w[i][0] * gk[i]; d[1] = w[i][1] * gk[i]; d[2] = w[i][2] * gk[i]; d[3] = w[i][3] * gk[i]; }
    LDS_WAIT(); asm volatile("" ::: "memory");
    const int c = lane & 7;
#pragma unroll
    for (int j = 0; j < 4; ++j) { const int n = (lane >> 3) + 8 * j; const LAS float* s = scr + (8 * c) * 33 + n;
        v4u o; o.x = pk2(s[0 * 33], s[1 * 33]); o.y = pk2(s[2 * 33], s[3 * 33]); o.z = pk2(s[4 * 33], s[5 * 33]); o.w = pk2(s[6 * 33], s[7 * 33]);
        *(GAS v4u*)(WT + (size_t)(prow0 + n) * K + k0 + 8 * c) = o; }
    LDS_WAIT(); asm volatile("" ::: "memory");
}
template <int NR> __device__ __forceinline__ void rows_to_bf16(Frame& F, const float* x, bf16* o, float* ssq, const int m0, const int step) {
    f32x4 v[NR][4];
#pragma unroll
    for (int r = 0; r < NR; ++r)
#pragma unroll
        for (int j = 0; j < 4; ++j) v[r][j] = __builtin_nontemporal_load((const f32x4*)(x + (size_t)(m0 + r * step) * DM) + F.lane + 64 * j);
#pragma unroll
    for (int r = 0; r < NR; ++r) { float s = 0.f;
#pragma unroll
        for (int j = 0; j < 4; ++j) s += (v[r][j].x * v[r][j].x + v[r][j].y * v[r][j].y) + (v[r][j].z * v[r][j].z + v[r][j].w * v[r][j].w);
        s = wave_sum(s);
        GAS unsigned long long* o8 = (GAS unsigned long long*)(o + (size_t)(m0 + r * step) * DM) + F.lane;
#pragma unroll
        for (int j = 0; j < 4; ++j) o8[64 * j] = (unsigned long long)pk2(v[r][j].x, v[r][j].y) | ((unsigned long long)pk2(v[r][j].z, v[r][j].w) << 32);
        if (F.lane == 0) ssq[m0 + r * step] = s; }
}
constexpr int CV_A = (DM / 64) * (FF2 / 32), CV_B = (FF / 64) * (DM / 32), CV_IN = (DM / 64) * (INC / 32), CV_OUT = (DM / 64) * (DM / 32), CV_MEM = (DM / 64) * (512 / 32);
constexpr int CV_EARLY = CV_A + CV_MEM, CV_MID = CV_EARLY + CV_A + CV_B + CV_IN + CV_OUT, CV_ALL = CV_MID + CV_B;
__device__ __forceinline__ void convert_items(Frame& F, const int first, const int last, const int w, const int nw) {
    LAS float* scr = (LAS float*)(F.lds + RING_OFF + F.wave * 16384);
    for (int it = first + w; it < last; it += nw) {
        int r = it;
        if (r < CV_A) { const int nblk = FF2 / 32, kb = r / nblk, nb = r % nblk; p0_transpose_item(karg<10>(), DM, FF2, WSP(bf16, WS_W1A), map_swiglu(32 * nb), karg<9>(), scr, 64 * kb, 32 * nb, F.lane); continue; }
        r -= CV_A;
        if (r < CV_MEM) { const int nblk = 512 / 32, kb = r / nblk, nb = r % nblk; p0_transpose_item(karg<19>(), DM, 512, WSP(bf16, WS_WMEM), map_head(32 * nb), karg<18>(), scr, 64 * kb, 32 * nb, F.lane); continue; }
        r -= CV_MEM;
        if (r < CV_A) { const int nblk = FF2 / 32, kb = r / nblk, nb = r % nblk; p0_transpose_item(karg<24>(), DM, FF2, WSP(bf16, WS_W2A), map_swiglu(32 * nb), karg<23>(), scr, 64 * kb, 32 * nb, F.lane); continue; }
        r -= CV_A;
        if (r < CV_B) { const int nblk = DM / 32, kb = r / nblk, nb = r % nblk; p0_transpose_item(karg<11>(), FF, DM, WSP(bf16, WS_W1B), 32 * nb, nullptr, scr, 64 * kb, 32 * nb, F.lane); continue; }
        r -= CV_B;
        if (r < CV_IN) { const int nblk = INC / 32, kb = r / nblk, nb = r % nblk; p0_transpose_item(karg<13>(), DM, INC, WSP(bf16, WS_WIN), map_head(32 * nb), karg<12>(), scr, 64 * kb, 32 * nb, F.lane); continue; }
        r -= CV_IN;
        if (r < CV_OUT) { const int nblk = DM / 32, kb = r / nblk, nb = r % nblk; p0_transpose_item(karg<22>(), DM, DM, WSP(bf16, WS_WOUT), 32 * nb, nullptr, scr, 64 * kb, 32 * nb, F.lane); continue; }
        r -= CV_OUT;
        { const int nblk = DM / 32, kb = r / nblk, nb = r % nblk; p0_transpose_item(karg<25>(), FF, DM, WSP(bf16, WS_W2B), 32 * nb, nullptr, scr, 64 * kb, 32 * nb, F.lane); }
    }
}
__device__ __forceinline__ void p0_prologue(Frame& F) {
    const int gw = F.c * NWAVES + F.wave, NGW = F.G * NWAVES;
    if (F.c < 128) {
        const int* pt = (const int*)karg<8>(); const float* ck = karg<3>(); float* sks = WSP(float, WS_SKSUM);
        const int idx = 1920 + F.c, phys = pt[idx]; const int voff = (F.wave >> 1) * 32 * 512 + (F.wave & 1) * 256 + 4 * F.lane;
        const float* base = ck + (size_t)phys * (PAGE * 512) + voff; f32x4 a = {0.f, 0.f, 0.f, 0.f};
#pragma unroll 16
        for (int r = 0; r < 32; ++r) a += __builtin_nontemporal_load((const f32x4*)(base + (size_t)r * 512));
        float* d = sks + (size_t)((idx >> 6) * 32 + ((idx & 63) >> 1)) * 512 + (F.wave & 1) * 256 + F.lane;
        atomicAdd(d, a[0]); atomicAdd(d + 64, a[1]); atomicAdd(d + 128, a[2]); atomicAdd(d + 192, a[3]);
    }
    convert_items(F, 0, CV_EARLY, gw, NGW);
    { const float* xin_ = karg<0>(); const float* min_ = karg<2>();
    for (int m = gw; m + 3 * NGW < MP; m += 4 * NGW) rows_to_bf16<4>(F, xin_, WSP(bf16, WS_XB), WSP(float, WS_SSQ0), m, NGW);
    for (int m = gw; m < MM; m += NGW) rows_to_bf16<1>(F, min_, WSP(bf16, WS_MNB), WSP(float, WS_SSQ0) + MP, m, NGW); }
    if (F.c == 0 && F.tid < 256) { const int w = F.tid >> 6, d = F.tid & 63; const float* src = w == 0 ? karg<16>() : (w == 1 ? karg<17>() : (w == 2 ? karg<20>() : karg<21>())); WSP(float, WS_GAIN)[F.tid] = src[d]; }
    if (F.c == 255) { const float* xs = karg<1>(); bf16* img = WSP(bf16, S_IMGX); float* sq = (float*)(F.ws + WS_CTL) + CW_SSQS;
#pragma unroll
        for (int i = 0; i < 4; ++i) { const int r = F.wave * 4 + i; float ss = 0.f;
#pragma unroll
            for (int j = 0; j < 4; ++j) { const int k = j * 256 + 4 * F.lane; const f32x4 v = *(const f32x4*)(xs + r * DM + k); ss += (v.x * v.x + v.y * v.y) + (v.z * v.z + v.w * v.w);
                *(unsigned long long*)(img + frag_off(r, k)) = (unsigned long long)pk2(v.x, v.y) | ((unsigned long long)pk2(v.z, v.w) << 32); }
            ss = wave_sum(ss); if (F.lane == 0) sq[r] = ss; } }
    for (int i = F.c * 512 + F.tid; i < (SEQ + 1) * 8; i += F.G * 512) { const int p = i >> 3, f = i & 7; const float pos = (p == SEQ) ? (float)PAST : (float)p;
        const float inv = powf(500000.0f, -(float)f * 0.125f); const float ang = pos * inv;
        const double kk = rint((double)ang * 0.15915494309189535); const float rr = (float)((double)ang - kk * 6.283185307179586);
        float* rp = WSP(float, WS_ROPE) + (size_t)i * 2; rp[0] = cosf(rr); rp[1] = sinf(rr); }
}

template <int UNR, class AL, class BR, class EP>
__device__ __forceinline__ void sgemm_unit(Frame& F, const AL& al, const BR& br, const bf16* Bt, const int K, const EP& ep) {
    LAS float* red = (LAS float*)(F.lds + RING_OFF);
    LAS unsigned char* bbuf = F.lds + RING_OFF + F.wave * 8192;
    const int r32 = F.lane & 31, hi = F.lane >> 5, nch = K >> 6, c0 = (nch * F.wave) >> 3, c1 = (nch * (F.wave + 1)) >> 3;
    f32x16 acc0 = {}, acc1 = {};
    const int srow = F.lane >> 3, spc = F.lane & 7;
    const bf16* gsrc[8];
#pragma unroll
    for (int i = 0; i < 8; ++i) { const int row = 8 * i + srow; gsrc[i] = Bt + (size_t)br(row >> 5, row & 31) * K + spc * 8; }
    v4u stg[8];
#pragma unroll
    for (int i = 0; i < 8; ++i) stg[i] = *(const v4u*)(gsrc[i] + c0 * 64);
    for (int c = c0; c < c1; ++c) {
        bf16x8 a[4];
#pragma unroll
        for (int st = 0; st < 4; ++st) a[st] = al(r32, c * 64 + st * 16 + 8 * hi);
#pragma unroll
        for (int i = 0; i < 8; ++i) *(LAS v4u*)(bbuf + (8 * i + srow) * 128 + spc * 16) = stg[i];
        if (c + 1 < c1) {
#pragma unroll
            for (int i = 0; i < 8; ++i) stg[i] = *(const v4u*)(gsrc[i] + (c + 1) * 64); }
#pragma unroll
        for (int st = 0; st < 4; ++st) { const bf16x8 b0 = *(const LAS bf16x8*)(bbuf + r32 * 128 + st * 32 + hi * 16), b1 = *(const LAS bf16x8*)(bbuf + (32 + r32) * 128 + st * 32 + hi * 16);
            acc0 = __builtin_amdgcn_mfma_f32_32x32x16_bf16(a[st], b0, acc0, 0, 0, 0); acc1 = __builtin_amdgcn_mfma_f32_32x32x16_bf16(a[st], b1, acc1, 0, 0, 0); }
    }
#pragma unroll
    for (int r = 0; r < 16; ++r) { const int row = (r & 3) + 8 * (r >> 2) + 4 * hi; red[(F.wave * 32 + row) * 64 + r32] = acc0[r]; red[(F.wave * 32 + row) * 64 + 32 + r32] = acc1[r]; }
    __syncthreads();
    const int row = F.tid >> 4, c4 = (F.tid & 15) * 4; f32x4 s = {0.f, 0.f, 0.f, 0.f};
#pragma unroll
    for (int w = 0; w < 8; ++w) s += *(const LAS f32x4*)(red + (w * 32 + row) * 64 + c4);
    ep(row, c4, s);
    __syncthreads();
}
__device__ __forceinline__ bf16x8 pack_bf16x8(const f32x4 a, const f32x4 b) { v4u w; w.x = pk2(a[0], a[1]); w.y = pk2(a[2], a[3]); w.z = pk2(b[0], b[1]); w.w = pk2(b[2], b[3]); return __builtin_bit_cast(bf16x8, w); }
struct ALLds { const LAS bf16* img;
    __device__ __forceinline__ bf16x8 operator()(int r, int k) const { return *(const LAS bf16x8*)(img + frag_off(r, k)); } };
struct ALFrag { const bf16* img;
    __device__ __forceinline__ bf16x8 operator()(int r, int k) const { return *(const bf16x8*)(img + frag_off(r, k)); } };
__device__ __forceinline__ void stage_a_lds(Frame& F, const float* x, const int ld, const LAS float* rs, LAS bf16* img) {
    f32x4 v[16];
#pragma unroll
    for (int j = 0; j < 16; ++j) { const int idx = F.tid + 512 * j, r = idx >> 8, k4 = (idx & 255) * 4; v[j] = *(const f32x4*)(x + r * ld + k4); }
#pragma unroll
    for (int j = 0; j < 16; ++j) { const int idx = F.tid + 512 * j, r = idx >> 8, k4 = (idx & 255) * 4; const float sc = rs ? rs[r] : 1.0f;
        *(LAS unsigned long long*)(img + frag_off(r, k4)) = (unsigned long long)pk2(v[j].x * sc, v[j].y * sc) | ((unsigned long long)pk2(v[j].z * sc, v[j].w * sc) << 32); }
    __syncthreads();
}
__device__ __forceinline__ void sample_rs(Frame& F, const float* x, LAS float* rs) {
#pragma unroll
    for (int i = 0; i < 4; ++i) { const int r = F.wave * 4 + i; float s = 0.f;
#pragma unroll
        for (int j = 0; j < 4; ++j) { const f32x4 v = *(const f32x4*)(x + r * DM + j * 256 + 4 * F.lane); s += (v.x * v.x + v.y * v.y) + (v.z * v.z + v.w * v.w); }
        s = wave_sum(s); if (F.lane == 0) rs[r] = 1.0f / sqrtf(s * (1.0f / DM) + RMS_EPS); }
    __syncthreads();
}
struct BRSwiglu { int v; __device__ __forceinline__ int operator()(int cb, int c) const { return 256 * (v >> 2) + 32 * (v & 3) + 128 * cb + c; } };
struct BRPlain { int v; __device__ __forceinline__ int operator()(int cb, int c) const { return 64 * v + 32 * cb + c; } };
struct BRHead { int v; __device__ __forceinline__ int operator()(int cb, int c) const { return 256 * (v >> 2) + 128 * cb + 32 * (v & 3) + c; } };
struct EPSwigluFrag { bf16* img; int v; const float* ssq;
    __device__ __forceinline__ void operator()(int row, int c4, f32x4 s) const {
        s = s * (1.0f / sqrtf(ssq[row] * (1.0f / DM) + RMS_EPS));
        f32x4 u; u.x = __shfl_xor(s.x, 8); u.y = __shfl_xor(s.y, 8); u.z = __shfl_xor(s.z, 8); u.w = __shfl_xor(s.w, 8);
        if (c4 < 32) { const int k = 32 * v + c4;
            *(unsigned long long*)(img + frag_off(row, k)) = (unsigned long long)pk2(pg8::silu_f(s.x) * u.x, pg8::silu_f(s.y) * u.y) | ((unsigned long long)pk2(pg8::silu_f(s.z) * u.z, pg8::silu_f(s.w) * u.w) << 32); } } };
template <int KIND> struct EPResid { unsigned char* ws; float* outp; const float* xs; int v;
    __device__ __forceinline__ void operator()(int row, int c4, f32x4 s) const { const int o = row * DM + 64 * v + c4;
        const float* base = KIND == 2 ? xs : (const float*)(ws + (KIND == 5 ? S_X1 : S_X2)); float* out = KIND == 2 ? (float*)(ws + S_X1) : (KIND == 5 ? (float*)(ws + S_X2) : outp + O_YS);
        const float alpha = KIND == 5 ? 1.0f : 0.5f;
        const f32x4 r = *(const f32x4*)(base + o) + alpha * s; *(f32x4*)(out + o) = r;
        if (KIND != 7) { bf16* img = (bf16*)(ws + (KIND == 2 ? S_IMGX1 : S_IMGX2)); float* ssq = (float*)(ws + WS_CTL) + CW_SSQS + (KIND == 2 ? 32 : 64);
            *(unsigned long long*)(img + frag_off(row, 64 * v + c4)) = (unsigned long long)pk2(r.x, r.y) | ((unsigned long long)pk2(r.z, r.w) << 32);
            float ss = (r.x * r.x + r.y * r.y) + (r.z * r.z + r.w * r.w); ss += __shfl_xor(ss, 1); ss += __shfl_xor(ss, 2); ss += __shfl_xor(ss, 4); ss += __shfl_xor(ss, 8);
            if ((c4 >> 2) == 0) atomicAdd(ssq + row, ss); } } };
struct EPProjS { int v; unsigned char* ws; float* outp; const float* ssq;
    __device__ __forceinline__ void operator()(int row, int c4, f32x4 s) const {
        s = s * (1.0f / sqrtf(ssq[row] * (1.0f / DM) + RMS_EPS));
        if (v < 4) { *(f32x4*)((float*)(ws + S_U) + row * 256 + 64 * v + c4) = s; return; }
        if (v >= 20 && v < 28) { *(f32x4*)(outp + O_VS + row * 512 + 64 * (v - 20) + c4) = s; return; }
        float ss = (s.x * s.x + s.y * s.y) + (s.z * s.z + s.w * s.w);
        ss += __shfl_xor(ss, 1); ss += __shfl_xor(ss, 2); ss += __shfl_xor(ss, 4); ss += __shfl_xor(ss, 8);
        const float hn = 1.0f / sqrtf(ss * (1.0f / 64.0f) + RMS_EPS);
        const float* g = (const float*)(ws + WS_GAIN) + ((v < 12) ? 0 : (v < 20 ? 64 : 128));
        const f32x4 gv = *(const f32x4*)(g + c4); s = s * hn * gv;
        if (v < 20) {
            const float* rope8192 = (const float*)(ws + WS_ROPE) + SEQ * 16;
            f32x4 y; y.x = __shfl_xor(s.x, 2); y.y = __shfl_xor(s.y, 2); y.z = __shfl_xor(s.z, 2); y.w = __shfl_xor(s.w, 2);
            if (c4 < 16) { const int f0 = c4 & 7; const float sg = (c4 < 8) ? -1.f : 1.f; f32x4 r_;
#pragma unroll
                for (int i = 0; i < 4; ++i) { const float cs_ = rope8192[2 * (f0 + i)], sn = rope8192[2 * (f0 + i) + 1]; r_[i] = s[i] * cs_ + sg * y[i] * sn; }
                s = r_; }
        }
        if (v < 12) *(f32x4*)((float*)(ws + S_Q) + row * 512 + 64 * (v - 4) + c4) = s;
        else if (v < 20) *(f32x4*)(outp + O_KS + row * 512 + 64 * (v - 12) + c4) = s;
        else *(f32x4*)((float*)(ws + S_QM) + row * 256 + 64 * (v - 28) + c4) = s;
    } };

__device__ __forceinline__ void pool_unit(Frame& F, const int pm, const int g) {
    const bf16* U = WSP(bf16, WS_U); bf16* MIX = WSP(bf16, WS_MIX); const float* pw = karg<14>() + g * 4096; const float* psc = karg<15>() + 64 * g;
    const int r32 = F.lane & 31, hi = F.lane >> 5, row = pm * 256 + F.wave * 32 + r32, t = row & (SEQ - 1), W = 2 << g;
    const int cnt = (t + 1 < W) ? t + 1 : W; const float rc = 1.0f / (float)cnt;
    bf16x8 bfr[4][2];
#pragma unroll
    for (int s = 0; s < 4; ++s)
#pragma unroll
        for (int cb = 0; cb < 2; ++cb) { float w[8];
#pragma unroll
            for (int j = 0; j < 8; ++j) w[j] = pw[(16 * s + 8 * hi + j) * 64 + 32 * cb + r32];
            v4u p; p.x = pk2(w[0], w[1]); p.y = pk2(w[2], w[3]); p.z = pk2(w[4], w[5]); p.w = pk2(w[6], w[7]); bfr[s][cb] = __builtin_bit_cast(bf16x8, p); }
    f32x16 acc0 = {}, acc1 = {};
#pragma unroll
    for (int s = 0; s < 4; ++s) { const bf16* up = U + (size_t)row * 256 + 64 * g + 16 * s + 8 * hi;
        bf16x8 xw[16];
#pragma unroll
        for (int i = 0; i < 16; ++i) if (i < W) xw[i] = *(const bf16x8*)(up - (size_t)((i < cnt) ? i : 0) * 256);
        float sum[8], self[8];
#pragma unroll
        for (int j = 0; j < 8; ++j) { self[j] = bfbits2f((unsigned short)xw[0][j]); sum[j] = self[j]; }
#pragma unroll
        for (int i = 1; i < 16; ++i) if (i < W) { const float wgt = (i < cnt) ? 1.f : 0.f;
#pragma unroll
            for (int j = 0; j < 8; ++j) sum[j] += wgt * bfbits2f((unsigned short)xw[i][j]); }
        v4u p;
        p.x = pk2(sum[0] * rc - self[0], sum[1] * rc - self[1]); p.y = pk2(sum[2] * rc - self[2], sum[3] * rc - self[3]); p.z = pk2(sum[4] * rc - self[4], sum[5] * rc - self[5]); p.w = pk2(sum[6] * rc - self[6], sum[7] * rc - self[7]);
        const bf16x8 a = __builtin_bit_cast(bf16x8, p);
        acc0 = __builtin_amdgcn_mfma_f32_32x32x16_bf16(a, bfr[s][0], acc0, 0, 0, 0); acc1 = __builtin_amdgcn_mfma_f32_32x32x16_bf16(a, bfr[s][1], acc1, 0, 0, 0); }
    const float sc0 = psc[r32], sc1 = psc[32 + r32];
    bf16* ob = MIX + (size_t)(pm * 256 + F.wave * 32) * DM + 64 * g;
#pragma unroll
    for (int r = 0; r < 16; ++r) { const int orow = (r & 3) + 8 * (r >> 2) + 4 * hi; ob[(size_t)orow * DM + r32] = (bf16)f2bf(acc0[r] * sc0); ob[(size_t)orow * DM + 32 + r32] = (bf16)f2bf(acc1[r] * sc1); }
}

template <int PER, int CH, class KPF, class VPF>
__device__ __forceinline__ void dec_attn(Frame& F, const float* q, const KPF& KP, const VPF& VP, const float* xk, const float* xv, float* outp, bf16* imgp, const int irow, const int icol) {
    LAS float* st = (LAS float*)(F.lds + RING_OFF);
    const int l16 = F.lane & 15, grp = F.wave * 4 + (F.lane >> 4);
    f32x4 q4 = *(const f32x4*)(q + 4 * l16); q4 = q4 * C2;
    float m = -INFINITY, l = 0.f; f32x4 o = {0.f, 0.f, 0.f, 0.f};
#pragma unroll
    for (int c0 = 0; c0 < PER; c0 += CH) {
        f32x4 kv[CH], vv[CH]; float d[CH];
#pragma unroll
        for (int it = 0; it < CH; ++it) { const int i = grp * PER + c0 + it; kv[it] = *(const f32x4*)(KP(i) + 4 * l16); vv[it] = *(const f32x4*)(VP(i) + 4 * l16); }
        float mc = -INFINITY;
#pragma unroll
        for (int it = 0; it < CH; ++it) { float x = (q4.x * kv[it].x + q4.y * kv[it].y) + (q4.z * kv[it].z + q4.w * kv[it].w);
            x += __shfl_xor(x, 1); x += __shfl_xor(x, 2); x += __shfl_xor(x, 4); x += __shfl_xor(x, 8); d[it] = x; mc = fmaxf(mc, x); }
        const float mn = fmaxf(m, mc), f = __builtin_amdgcn_exp2f(m - mn); l *= f; o = o * f; m = mn;
#pragma unroll
        for (int it = 0; it < CH; ++it) { const float p = __builtin_amdgcn_exp2f(d[it] - mn); l += p; o = o + p * vv[it]; }
    }
    if (l16 == 0) { st[grp * 68] = m; st[grp * 68 + 1] = l; }
    *(LAS f32x4*)(st + grp * 68 + 4 + 4 * l16) = o;
    if (F.wave == 0 && F.lane < 16) {
        if (xk) { const f32x4 kx = *(const f32x4*)(xk + 4 * l16); float x = (q4.x * kx.x + q4.y * kx.y) + (q4.z * kx.z + q4.w * kx.w);
            x += __shfl_xor(x, 1); x += __shfl_xor(x, 2); x += __shfl_xor(x, 4); x += __shfl_xor(x, 8);
            if (l16 == 0) { st[32 * 68] = x; st[32 * 68 + 1] = 1.f; } *(LAS f32x4*)(st + 32 * 68 + 4 + 4 * l16) = *(const f32x4*)(xv + 4 * l16); }
        else { if (l16 == 0) { st[32 * 68] = -INFINITY; st[32 * 68 + 1] = 0.f; } *(LAS f32x4*)(st + 32 * 68 + 4 + 4 * l16) = (f32x4){0.f, 0.f, 0.f, 0.f}; }
    }
    __syncthreads();
    if (F.tid < 64) { float M = -INFINITY;
#pragma unroll
        for (int i = 0; i < 33; ++i) M = fmaxf(M, st[i * 68]);
        float L = 0.f, O = 0.f;
#pragma unroll
        for (int i = 0; i < 33; ++i) { const float e = __builtin_amdgcn_exp2f(st[i * 68] - M); L += st[i * 68 + 1] * e; O += st[i * 68 + 4 + F.tid] * e; }
        outp[F.tid] = O / L; if (imgp) imgp[frag_off(irow, icol + F.tid)] = (bf16)f2bf(O / L); }
    __syncthreads();
}
struct KPaged { const float* base; unsigned long long pa; unsigned pb; int hoff;
    __device__ __forceinline__ const float* operator()(int i) const { const int sl = i >> 7; const unsigned long long w = sl < 4 ? pa : (unsigned long long)pb; const unsigned page = (unsigned)(w >> (16 * (sl & 3))) & 0xffffu; return base + ((size_t)page * PAGE + (i & 127)) * 512 + hoff; } };
struct KLin { const float* base; int ld; __device__ __forceinline__ const float* operator()(int i) const { return base + (size_t)i * ld; } };

__device__ __forceinline__ void sample_item(Frame& F, const int item) {
    float* smix = WSP(float, S_MIX);
    if (item < 256) {
        const int b = item >> 3, h = item & 7; const float* q = WSP(float, S_Q) + b * 512 + h * 64;
        const int myp = ((const int*)karg<8>())[b * NPG + F.lane];
        const int j = F.lane & 31, hh = F.lane >> 5; float sc = 0.f;
        { const float* sj = WSP(float, WS_SKSUM) + ((size_t)b * 32 + j) * 512 + (h >> 2) * 256 + ((h & 3) * 64 + 32 * hh) / 4;
#pragma unroll
          for (int jj = 0; jj < 4; ++jj) { const f32x4 k0 = *(const f32x4*)(sj + 64 * jj), k1 = *(const f32x4*)(sj + 64 * jj + 4);
            sc += (q[32 * hh + jj] * k0[0] + q[32 * hh + jj + 4] * k0[1]) + (q[32 * hh + jj + 8] * k0[2] + q[32 * hh + jj + 12] * k0[3]) + (q[32 * hh + jj + 16] * k1[0] + q[32 * hh + jj + 20] * k1[1]) + (q[32 * hh + jj + 24] * k1[2] + q[32 * hh + jj + 28] * k1[3]); } }
        sc += __shfl_xor(sc, 32);
        int cntb = 0;
        for (int i = 0; i < 32; ++i) { const float o = __shfl(sc, i); cntb += ((o > sc) || (o == sc && i < j)) ? 1 : 0; }
        const unsigned long long bal = __ballot(cntb < 3 && F.lane < 32);
        const unsigned msk = (unsigned)bal; const int b0 = __builtin_ctz(msk), b1 = __builtin_ctz(msk & (msk - 1)), b2 = __builtin_ctz(msk & (msk - 1) & ((msk & (msk - 1)) - 1));
        const unsigned g0 = (unsigned)__shfl(myp, 2 * b0), g1 = (unsigned)__shfl(myp, 2 * b0 + 1), g2 = (unsigned)__shfl(myp, 2 * b1), g3 = (unsigned)__shfl(myp, 2 * b1 + 1), g4 = (unsigned)__shfl(myp, 2 * b2), g5 = (unsigned)__shfl(myp, 2 * b2 + 1);
        const unsigned long long pa_ = (unsigned long long)g0 | ((unsigned long long)g1 << 16) | ((unsigned long long)g2 << 32) | ((unsigned long long)g3 << 48); const unsigned pb_ = g4 | (g5 << 16);
        const KPaged KPf{karg<3>(), pa_, pb_, h * 64}, VPf{karg<4>(), pa_, pb_, h * 64};
        dec_attn<24, 24>(F, q, KPf, VPf, F.out + O_KS + b * 512 + h * 64, F.out + O_VS + b * 512 + h * 64, smix + b * DM + 256 + h * 64, WSP(bf16, S_IMGMIX), b, 256 + h * 64);
    } else if (item < 384) {
        const int b = (item - 256) >> 2, h = (item - 256) & 3; const float* q = WSP(float, S_QM) + b * 256 + h * 64;
        const KLin KPf{karg<5>() + (size_t)b * MEML * 256 + h * 64, 256}, VPf{karg<6>() + (size_t)b * MEML * 256 + h * 64, 256};
        dec_attn<8, 8>(F, q, KPf, VPf, nullptr, nullptr, smix + b * DM + 768 + h * 64, WSP(bf16, S_IMGMIX), b, 768 + h * 64);
    } else if (item < 416) {
        const int b = item - 384; LAS float* pl = (LAS float*)(F.lds + RING_OFF);
        const float* stp = karg<7>() + (size_t)b * 15 * 256; const float* su = WSP(float, S_U) + b * 256; float* pso = F.out + O_PSS + (size_t)b * 15 * 256;
        if (F.tid < 256) { const int c = F.tid, g = c >> 6, W = 2 << g; const float u = su[c]; float s = u;
            float wv[15];
#pragma unroll
            for (int i = 1; i < 16; ++i) wv[i - 1] = stp[(15 - i) * 256 + c];
#pragma unroll
            for (int i = 1; i < 16; ++i) s += (i < W) ? wv[i - 1] : 0.f;
            pl[c] = s / (float)W - u;
            for (int i = 0; i < 14; ++i) pso[i * 256 + c] = stp[(i + 1) * 256 + c];
            pso[14 * 256 + c] = u; }
        __syncthreads();
        if (F.tid < 256) { const int c = F.tid, g = c >> 6, d = c & 63; const float* pw = karg<14>() + g * 4096; float a = 0.f;
#pragma unroll
            for (int cc = 0; cc < 64; ++cc) a += pl[64 * g + cc] * pw[cc * 64 + d];
            const float y_ = a * karg<15>()[c]; smix[b * DM + c] = y_; WSP(bf16, S_IMGMIX)[frag_off(b, c)] = (bf16)f2bf(y_); }
        __syncthreads();
    }
}

__global__ void __launch_bounds__(NWAVES * 64, 2) hymba_fwd(Args args) {
    extern __shared__ __attribute__((aligned(16))) unsigned char lds[];
    Frame F;
    F.lds = (LAS unsigned char*)lds;
    F.MISC = (volatile LAS unsigned*)(F.lds + MISC_OFF);
    F.tid = threadIdx.x; F.lane = F.tid & 63; F.wave = __builtin_amdgcn_readfirstlane(F.tid >> 6);
    F.G = gridDim.x; F.c = blockIdx.x;
    F.ws = args.ws; F.ctl = (gu32*)(args.ws + WS_CTL); F.out = args.out;
    for (int u = F.tid; u < (LDS_BYTES - LDSCTL_OFF) / 4; u += NWAVES * 64) ((LAS unsigned*)(F.lds + LDSCTL_OFF))[u] = 0u;
    __syncthreads();
    XcdBarrier bar; bar.bar = (unsigned*)(F.ctl + CW_BAR); bar.x = 0; bar.st = nullptr;
    if (N_LAUNCHES == 1) bar = xcd_barrier_post((unsigned*)(F.ctl + CW_BAR), F.MISC + 8);
#define GRID_BAR() do { if (N_LAUNCHES == 1) xcd_barrier(bar); } while (0)
    const int lo = args.ph_lo, hi = args.ph_hi;
    pg8::NoStream nostream;
#ifdef DBG_ONLY
#define IN(k) ((k) == DBG_ONLY && lo <= (k) && (k) < hi)
#else
#define IN(k) (lo <= (k) && (k) < hi)
#endif
#define rs ((LAS float*)(F.lds + SM_OFF))
#define ssq1 ((float*)(F.ws + WS_CTL) + CW_SSQ1)
#define ssq2 ((float*)(F.ws + WS_CTL) + CW_SSQ2)
#define ksum ((float*)(F.ws + WS_CTL) + CW_KSUM)
#define ssq0 WSP(float, WS_SSQ0)

#define FRESH() do { int t2_ = threadIdx.x, c2_ = blockIdx.x; asm volatile("" : "+v"(t2_)); asm volatile("" : "+s"(c2_)); F.tid = t2_; F.lane = t2_ & 63; F.wave = __builtin_amdgcn_readfirstlane(t2_ >> 6); F.c = c2_; \
        unsigned char* w2_ = args.ws; float* o2_ = args.out; asm volatile("" : "+s"(w2_)); asm volatile("" : "+s"(o2_)); F.ws = w2_; F.out = o2_; F.ctl = (gu32*)(w2_ + WS_CTL); } while (0)
    if (IN(0)) for (int rep_ = 0; rep_ < REP0; ++rep_) { FRESH(); p0_prologue(F); GRID_BAR(); }

    if (IN(1)) for (int rep_ = 0; rep_ < REP1; ++rep_) { FRESH();
        { pg8::Gemm g{WSP(bf16, WS_XB), WSP(bf16, WS_W1A), MP, FF2, DM}; pg8::StaticOrder S; S.init(MP, FF2, F.G, F.c);
          pg8::EpiSwiglu<false> E{WSP(bf16, WS_H), ssq0, FF, {}};
          KStream<1, 0> X; X.init(F.ws, F.c, !(rep_ + 1 < REP1), F.wave, F.lane);
          pg8::gemm_phase<pg8::EpiSwiglu<false>, pg8::StaticOrder, true, true, KStream<1, 0>>(F.lds + RING_OFF, g, S, E, X); }
        if (F.c >= 128 && F.c < 144) { pg8::Gemm g{WSP(bf16, WS_MNB), WSP(bf16, WS_WMEM), MM, 512, DM}; pg8::ListOrder S; S.init(MM / 256, 2, 128, F.c);
          pg8::EpiHead<true> E{ssq0 + MP, nullptr, F.out, nullptr, F.ws, C2};
          pg8::gemm_phase<pg8::EpiHead<true>, pg8::ListOrder, true, true>(F.lds + RING_OFF, g, S, E, nostream); }
        FRESH();
        if (F.c >= 144 && rep_ + 1 == REP1) { convert_items(F, CV_EARLY, CV_MID, (F.c - 144) * NWAVES + F.wave, (256 - 144) * NWAVES); __syncthreads(); }
        if (F.c >= 144 && F.c < 144 + 88) { const int v = F.c - 144;
          sgemm_unit<8>(F, ALFrag{WSP(bf16, S_IMGX)}, BRSwiglu{v}, WSP(bf16, WS_W1A), DM, EPSwigluFrag{WSP(bf16, S_H), v, (const float*)(F.ws + WS_CTL) + CW_SSQS}); }
        GRID_BAR();
    }
    if (IN(2)) for (int rep_ = 0; rep_ < REP2; ++rep_) { FRESH();
        { pg8::Gemm g{WSP(bf16, WS_H), WSP(bf16, WS_W1B), MP, DM, FF}; pg8::StaticOrder S; S.init(MP, DM, F.G, F.c);
          const bool dm_ = (rep_ + 1 < REP2); pg8::EpiResid<1, 2> E{WSP(bf16, WS_XB), dm_ ? WSP(bf16, WS_DUMMY + 64 * MiB) : WSP(bf16, WS_XB), nullptr, dm_ ? WSP(float, WS_DUMMY + 96 * MiB) : ssq1, 0.5f};
          KStream<2, 1408> X; X.init(F.ws, F.c, !(rep_ + 1 < REP2), F.wave, F.lane);
          pg8::gemm_phase<pg8::EpiResid<1, 2>, pg8::StaticOrder, true, true, KStream<2, 1408>>(F.lds + RING_OFF, g, S, E, X); }
        if (F.c >= 240) { const int v = F.c - 240; sgemm_unit<11>(F, ALFrag{WSP(bf16, S_H)}, BRPlain{v}, WSP(bf16, WS_W1B), FF, EPResid<2>{F.ws, F.out, karg<1>(), v}); }
        GRID_BAR();
    }
    if (IN(3)) for (int rep_ = 0; rep_ < REP3; ++rep_) { FRESH();
        { pg8::Gemm g{WSP(bf16, WS_XB), WSP(bf16, WS_WIN), MP, INC, DM}; pg8::StaticOrder S; S.init(MP, INC, F.G, F.c);
          pg8::EpiHead<false> E{ssq1, WSP(float, WS_ROPE), F.out, (rep_ + 1 < REP3) ? WSP(float, WS_DUMMY + 96 * MiB) : ksum, F.ws, C2};
          pg8::gemm_phase<pg8::EpiHead<false>, pg8::StaticOrder, true, true>(F.lds + RING_OFF, g, S, E, nostream); }
        if (F.c >= 224) { const int v = F.c - 224;
          sgemm_unit<8>(F, ALFrag{WSP(bf16, S_IMGX1)}, BRHead{v}, WSP(bf16, WS_WIN), DM,
                     EPProjS{v, F.ws, F.out, (const float*)(F.ws + WS_CTL) + CW_SSQS + 32}); }
        GRID_BAR();
    }
#ifndef DBG_P4
#define DBG_P4 15
#endif
    if (IN(4)) for (int rep_ = 0; rep_ < REP4; ++rep_) { FRESH();
        if ((DBG_P4 & 8) && ((F.c >> 3) & 3) == 0) { sample_item(F, F.c); if (F.c + 256 < 416) sample_item(F, F.c + 256); }
        FRESH();
        using attn_body::bf16; char* shm = (char*)lds + RING_OFF;
        if (DBG_P4 & 1) { const int bh = F.c >> 2, s = F.c & 3, b = bh >> 3, h = bh & 7;
          const bf16* Qb = (const bf16*)WSP(unsigned short, WS_Q) + (size_t)b * SEQ * 512 + h * 64; const bf16* Kb = (const bf16*)WSP(unsigned short, WS_K) + (size_t)b * SEQ * 512 + h * 64;
          const bf16* Vb = (const bf16*)WSP(unsigned short, WS_V) + (size_t)b * SEQ * 512 + h * 64; bf16* Ob = (bf16*)WSP(unsigned short, WS_MIX) + (size_t)b * SEQ * DM + 256 + h * 64;
          const float* ks = ksum + (size_t)b * 8 * 512 + h * 64;
          LAS unsigned char* selt = (LAS unsigned char*)(F.lds + SM_OFF + 512);
          { const int which = F.tid >> 8, qi = F.tid & 255, qb = which == 0 ? 7 - s : s; unsigned sel = 0x7fu;
            LAS float* ksl = (LAS float*)(F.lds + RING_OFF);
            if (F.tid < 448) ksl[F.tid] = ks[(F.tid >> 6) * 512 + (F.tid & 63)];
            __syncthreads();
            if (qb >= 4) { float sc[7]; float qf[64];
              { const unsigned short* qp = WSP(unsigned short, WS_Q) + ((size_t)b * SEQ + qb * 256 + qi) * 512 + h * 64;
#pragma unroll
                for (int d8 = 0; d8 < 8; ++d8) { const bf16x8 x = *(const bf16x8*)(qp + 8 * d8);
#pragma unroll
                  for (int e = 0; e < 8; ++e) qf[8 * d8 + e] = bfbits2f((unsigned short)x[e]); } }
#pragma unroll
              for (int j = 0; j < 7; ++j) { float a = 0.f; if (j < qb) {
#pragma unroll
                  for (int d4 = 0; d4 < 16; ++d4) { const f32x4 kv = *(const LAS f32x4*)(ksl + j * 64 + 4 * d4); a += (qf[4 * d4] * kv[0] + qf[4 * d4 + 1] * kv[1]) + (qf[4 * d4 + 2] * kv[2] + qf[4 * d4 + 3] * kv[3]); } } else a = -INFINITY;
                sc[j] = a; asm volatile("" : "+v"(a) :: "memory"); }
              sel = 0u;
#pragma unroll
              for (int j = 0; j < 7; ++j) { int cnt = 0;
#pragma unroll
                for (int i = 0; i < 7; ++i) { if (i != j) cnt += ((sc[i] > sc[j]) || (sc[i] == sc[j] && i < j)) ? 1 : 0; }
                if (j < qb && cnt < 3) sel |= (1u << j); } }
            selt[F.tid] = (unsigned char)sel; }
          __syncthreads();
          { const int qb = 7 - s; attn_body::attn_unit<8, 1, 512, 512, DM>(Qb + (size_t)qb * 256 * 512, Kb, Vb, Ob + (size_t)qb * 256 * DM, 4 * qb + 4, selt, shm); }
          { const int qb = s;     attn_body::attn_unit<8, 1, 512, 512, DM>(Qb + (size_t)qb * 256 * 512, Kb, Vb, Ob + (size_t)qb * 256 * DM, 4 * qb + 4, selt + 256, shm); } }
        FRESH();
        if ((DBG_P4 & 8) && ((F.c >> 3) & 3) == 1) { sample_item(F, F.c); if (F.c + 256 < 416) sample_item(F, F.c + 256); }
        FRESH();
        if (DBG_P4 & 2) { const int b = F.c >> 5, hm = (F.c >> 3) & 3, qb = F.c & 7;
          const bf16* Qb = (const bf16*)WSP(unsigned short, WS_QM) + ((size_t)b * SEQ + qb * 256) * 256 + hm * 64; const bf16* Kb = (const bf16*)WSP(unsigned short, WS_MKB) + (size_t)b * MEML * 256 + hm * 64;
          const bf16* Vb = (const bf16*)WSP(unsigned short, WS_MVB) + (size_t)b * MEML * 256 + hm * 64; bf16* Ob = (bf16*)WSP(unsigned short, WS_MIX) + ((size_t)b * SEQ + qb * 256) * DM + 768 + hm * 64;
          attn_body::attn_unit<8, 0, 256, 256, DM>(Qb, Kb, Vb, Ob, 4, nullptr, shm); }
        if ((DBG_P4 & 8) && ((F.c >> 3) & 3) == 2) { sample_item(F, F.c); if (F.c + 256 < 416) sample_item(F, F.c + 256); }
        FRESH();
        if (DBG_P4 & 4) pool_unit(F, F.c >> 2, F.c & 3);
        __syncthreads();
        const int sgrp_ = (F.c >> 3) & 3;
        if ((DBG_P4 & 8) && sgrp_ == 3) { sample_item(F, F.c); if (F.c + 256 < 416) sample_item(F, F.c + 256); }
        GRID_BAR();
    }
    if (IN(5)) for (int rep_ = 0; rep_ < REP5; ++rep_) { FRESH();
        { pg8::Gemm g{WSP(bf16, WS_MIX), WSP(bf16, WS_WOUT), MP, DM, DM}; pg8::StaticOrder S; S.init(MP, DM, F.G, F.c);
          const bool dm_ = (rep_ + 1 < REP5); pg8::EpiResid<1> E{WSP(bf16, WS_XB), dm_ ? WSP(bf16, WS_DUMMY + 64 * MiB) : WSP(bf16, WS_XB), nullptr, dm_ ? WSP(float, WS_DUMMY + 96 * MiB) : ssq2, 1.0f};
          pg8::gemm_phase<pg8::EpiResid<1>, pg8::StaticOrder, true, true>(F.lds + RING_OFF, g, S, E, nostream); }
        if (F.c >= 240) { const int v = F.c - 240; sgemm_unit<8>(F, ALFrag{WSP(bf16, S_IMGMIX)}, BRPlain{v}, WSP(bf16, WS_WOUT), DM, EPResid<5>{F.ws, F.out, nullptr, v}); }
        GRID_BAR();
    }
    if (IN(6)) for (int rep_ = 0; rep_ < REP6; ++rep_) { FRESH();
        if (F.c >= 128 && rep_ + 1 == REP6) { convert_items(F, CV_MID, CV_ALL, (F.c - 128) * NWAVES + F.wave, 128 * NWAVES); __syncthreads(); }
        FRESH();
        { pg8::Gemm g{WSP(bf16, WS_XB), WSP(bf16, WS_W2A), MP, FF2, DM}; pg8::StaticOrder S; S.init(MP, FF2, F.G, F.c);
          pg8::EpiSwiglu<true> E{WSP(bf16, WS_H), ssq2, FF, {}};
          pg8::gemm_phase<pg8::EpiSwiglu<true>, pg8::StaticOrder, true, true>(F.lds + RING_OFF, g, S, E, nostream); }
        if (F.c >= 144 && F.c < 144 + 88) { const int v = F.c - 144;
          sgemm_unit<8>(F, ALFrag{WSP(bf16, S_IMGX2)}, BRSwiglu{v}, WSP(bf16, WS_W2A), DM, EPSwigluFrag{WSP(bf16, S_H), v, (const float*)(F.ws + WS_CTL) + CW_SSQS + 64}); }
        GRID_BAR();
    }
    if (IN(7)) for (int rep_ = 0; rep_ < REP7; ++rep_) { FRESH();
        { pg8::Gemm g{WSP(bf16, WS_H), WSP(bf16, WS_W2B), MP, DM, FF}; pg8::StaticOrder S; S.init(MP, DM, F.G, F.c);
          pg8::EpiResid<0> E{WSP(bf16, WS_XB), nullptr, F.out + O_Y, nullptr, 0.5f};
          pg8::gemm_phase<pg8::EpiResid<0>, pg8::StaticOrder, true, true>(F.lds + RING_OFF, g, S, E, nostream); }
        if (F.c >= 240) { const int v = F.c - 240; sgemm_unit<11>(F, ALFrag{WSP(bf16, S_H)}, BRPlain{v}, WSP(bf16, WS_W2B), FF, EPResid<7>{F.ws, F.out, nullptr, v}); }
    }
#undef IN
#undef GRID_BAR
#undef FRESH
#undef rs
#undef ssq1
#undef ssq2
#undef ksum
#undef ssq0
}

extern "C" void kernel_launch(void* const* d_in, const int* in_sizes, int n_in, void* d_out, int out_size, void* d_ws, size_t ws_size, hipStream_t stream) {
    static int grid = 0;
    if (grid == 0) {
        if (n_in != 26 || (size_t)out_size != O_END || ws_size < WS_END + 128 * MiB) { fprintf(stderr, "kernel_launch: shape mismatch (n_in %d, out %d, ws %zu): nothing launched\n", n_in, out_size, ws_size); grid = -1; return; }
        int dev = 0, cus = 0, per_cu = 0;
        if (hipGetDevice(&dev) != hipSuccess || hipDeviceGetAttribute(&cus, hipDeviceAttributeMultiprocessorCount, dev) != hipSuccess) { grid = -1; return; }
        if (hipFuncSetAttribute((const void*)hymba_fwd, hipFuncAttributeMaxDynamicSharedMemorySize, LDS_BYTES) != hipSuccess) { fprintf(stderr, "kernel_launch: hipFuncSetAttribute failed\n"); grid = -1; return; }
        if (hipOccupancyMaxActiveBlocksPerMultiprocessor(&per_cu, (const void*)hymba_fwd, NWAVES * 64, LDS_BYTES) != hipSuccess || per_cu < 1)
            fprintf(stderr, "kernel_launch: note: occupancy query reports %d workgroups per CU\n", per_cu);
        (void)hipGetLastError();
        grid = cus < 256 ? cus : 256;
    }
    if (grid < 0) return;
    if (hipMemsetAsync((char*)d_ws + WS_CTL, 0, CTL_ZERO_BYTES, stream) != hipSuccess) return;
    Args a{};
    for (int i = 0; i < 26; ++i) a.in[i] = (const float*)d_in[i];
    a.out = (float*)d_out; a.ws = (unsigned char*)d_ws;
    for (int li = 0; li < N_LAUNCHES; ++li) {
        a.ph_lo = (N_LAUNCHES == 1) ? 0 : li; a.ph_hi = (N_LAUNCHES == 1) ? PER_PHASE : li + 1;
        hipLaunchKernelGGL(hymba_fwd, dim3(grid), dim3(NWAVES * 64), LDS_BYTES, stream, a);
        const hipError_t le = hipPeekAtLastError();
        if (le != hipSuccess) { fprintf(stderr, "kernel_launch: launch %d failed: %s\n", li, hipGetErrorName(le)); break; }
    }
}
```

```cpp
#include <hip/hip_runtime.h>
#include <hip/hip_bf16.h>
#include <cstdio>
#include <cstdint>
#include <cmath>
constexpr int NWAVES = 8;
#ifndef MK_N_LAUNCHES
#define MK_N_LAUNCHES 1
#endif
constexpr int PER_PHASE = 8;
constexpr int N_LAUNCHES = MK_N_LAUNCHES;
static_assert(N_LAUNCHES == 1 || N_LAUNCHES == PER_PHASE, "MK_N_LAUNCHES is 1 or 8");

constexpr int DM = 1024, NB = 8, SEQ = 2048, MP = NB * SEQ;
constexpr int NS = 32, PAST = 8192, PAGE = 128, NPG = PAST / PAGE;
constexpr int FF = 2816, FF2 = 2 * FF, INC = 2048, MEML = 256, MM = NB * MEML;
constexpr float RMS_EPS = 1e-6f;
constexpr float C2 = 0.125f * 1.4426950408889634f;
constexpr size_t O_Y = 0, O_YS = O_Y + (size_t)MP * DM, O_KP = O_YS + (size_t)NS * DM, O_VP = O_KP + (size_t)MP * 512, O_MK = O_VP + (size_t)MP * 512, O_MV = O_MK + (size_t)MM * 256,
                 O_PS = O_MV + (size_t)MM * 256, O_KS = O_PS + (size_t)NB * 15 * 256, O_VS = O_KS + (size_t)NS * 512, O_PSS = O_VS + (size_t)NS * 512, O_END = O_PSS + (size_t)NS * 15 * 256;

constexpr size_t MiB = 1u << 20;
constexpr size_t WS_CTL = 0, CTL_ZERO_BYTES = 4 * MiB;
constexpr int CW_TMO = 0, CW_CODE = 1, CW_BAR = 4096;
constexpr int CW_SSQ1 = 16384, CW_SSQ2 = CW_SSQ1 + MP, CW_KSUM = CW_SSQ2 + MP, CW_ZERO = CW_KSUM + NB * 8 * 8 * 64, CW_SKSUM = CW_ZERO + 1024, CW_SSQS = CW_SKSUM + NS * 32 * 512, CW_END = CW_SSQS + 128;
static_assert((size_t)CW_END * 4 <= CTL_ZERO_BYTES, "CTL words inside the memset region");
constexpr size_t WS_W1A = 4 * MiB, WS_W1B = WS_W1A + 11 * MiB, WS_W2A = WS_W1B + 6 * MiB, WS_W2B = WS_W2A + 11 * MiB, WS_WIN = WS_W2B + 6 * MiB, WS_WOUT = WS_WIN + 4 * MiB, WS_WMEM = WS_WOUT + 2 * MiB;
constexpr size_t WS_XB = WS_WMEM + 1 * MiB;
constexpr size_t WS_H = WS_XB + 32 * MiB;
constexpr size_t WS_X1 = WS_H + 88 * MiB;
constexpr size_t WS_U = WS_X1 + 64 * MiB, WS_Q = WS_U + 8 * MiB, WS_K = WS_Q + 16 * MiB, WS_V = WS_K + 16 * MiB, WS_QM = WS_V + 16 * MiB;
constexpr size_t WS_MNB = WS_QM + 8 * MiB, WS_MKB = WS_MNB + 4 * MiB, WS_MVB = WS_MKB + 1 * MiB, WS_MIX = WS_MVB + 1 * MiB;
constexpr size_t WS_ROPE = WS_MIX + 32 * MiB;
constexpr size_t WS_SKSUM = WS_CTL + (size_t)CW_SKSUM * 4;
constexpr size_t WS_SSQ0 = WS_ROPE + 1 * MiB;
constexpr size_t WS_GAIN = WS_SSQ0 + 512 * 1024;
constexpr size_t WS_S = WS_SSQ0 + 1 * MiB;
constexpr size_t S_H = WS_S, S_X1 = S_H + 1 * MiB, S_X2 = S_X1 + 128 * 1024, S_U = S_X2 + 128 * 1024, S_Q = S_U + 32 * 1024, S_QM = S_Q + 64 * 1024, S_MIX = S_QM + 32 * 1024;
constexpr size_t S_IMGX = S_MIX + 128 * 1024, S_IMGX1 = S_IMGX + 64 * 1024, S_IMGX2 = S_IMGX1 + 64 * 1024, S_IMGMIX = S_IMGX2 + 64 * 1024;
constexpr size_t WS_END = S_IMGMIX + 64 * 1024;
static_assert(WS_W1B - WS_W1A >= (size_t)FF2 * DM * 2 && WS_W2A - WS_W1B >= (size_t)DM * FF * 2, "weight copies fit");

#ifndef REP0
#define REP0 1
#endif
#ifndef REP1
#define REP1 1
#endif
#ifndef REP2
#define REP2 1
#endif
#ifndef REP3
#define REP3 1
#endif
#ifndef REP4
#define REP4 1
#endif
#ifndef REP5
#define REP5 1
#endif
#ifndef REP6
#define REP6 1
#endif
#ifndef REP7
#define REP7 1
#endif
constexpr size_t WS_DUMMY = WS_END;
constexpr int RING_OFF = 0, RING_BYTES = 131072;
constexpr int LDSCTL_OFF = RING_BYTES, MISC_OFF = LDSCTL_OFF + 320;
constexpr int SM_OFF = RING_BYTES + 1024;
constexpr int LDS_BYTES = 147456;
static_assert(MISC_OFF + 128 <= SM_OFF && SM_OFF + 8192 <= LDS_BYTES, "LDS map");


namespace pg8 {
#define PG8_LAS __attribute__((address_space(3)))
typedef unsigned short bf16_t;
typedef short bf16x8 __attribute__((ext_vector_type(8)));
typedef float f32x4 __attribute__((ext_vector_type(4)));
typedef unsigned u32x4 __attribute__((ext_vector_type(4)));
constexpr int BM = 256, BK = 64, HALF = 128, HTB = HALF * BK * 2  , STAGE_BYTES = 8 * HTB, NXCD = 8, WGM = 8;

__host__ __device__ __forceinline__ int lds_byte(int r, int c) { const int st = (r >> 4) * 2 + (c >> 5), rr = r & 15, cc = c & 31, ob = rr * 64 + cc * 2; return st * 1024 + (ob ^ (((ob >> 9) & 1) << 5)); }
__host__ __device__ __forceinline__ void stage_rc(int b, int& R, int& C) { const int st = b / 1024, sb = b % 1024, swz = sb ^ (((sb >> 9) & 1) << 5); R = (st >> 1) * 16 + swz / 64; C = (st & 1) * 32 + (swz % 64) / 2; }
__host__ __device__ __forceinline__ int perm32(int rho) { const int n = rho >> 4, i = rho & 15; return 8 * (i >> 2) + 4 * n + (i & 3); }

struct Unit { int pm, pn; };
struct Gemm { const bf16_t* A; const bf16_t* Bt; int M, N, K; };

struct StaticOrder {
    int nM, nN, nwg, G, c;
    __host__ __device__ void init(int M, int N, int G_, int c_) { nM = M / BM; nN = N / BM; nwg = nM * nN; G = G_; c = c_; }
    __host__ __device__ bool next(int i, Unit& u) const {
        const long L = (long)i * G + c; if (L >= nwg) return false;
        int wgid = (int)L; { const int q = nwg / NXCD, r = nwg % NXCD, xcd = wgid % NXCD, off = wgid / NXCD; wgid = (xcd < r ? xcd * (q + 1) : r * (q + 1) + (xcd - r) * q) + off; }
        const int nig = WGM * nN, gid = wgid / nig, fm = gid * WGM, gsz = (nM - fm) < WGM ? (nM - fm) : WGM;
        u.pm = fm + ((wgid % nig) % gsz); u.pn = (wgid % nig) / gsz; return true;
    }
    __device__ __forceinline__ void a_ready(const Unit&) const {}
    __device__ __forceinline__ void done(const Unit&) const {}
};

__device__ __forceinline__ unsigned cvt_pk_bf16(float lo, float hi) { unsigned r; asm volatile("v_cvt_pk_bf16_f32 %0, %1, %2" : "=v"(r) : "v"(lo), "v"(hi)); return r; }
typedef float f32x2 __attribute__((ext_vector_type(2)));
__device__ __forceinline__ f32x2 gelu_pk(f32x2 v) {
    const f32x2 av = __builtin_elementwise_abs(v), d = av * 0.2316418882f + 1.0f;
    f32x2 t; t.x = __builtin_amdgcn_rcpf(d.x); t.y = __builtin_amdgcn_rcpf(d.y);
    f32x2 q = t * 0.5307027145f + (-0.7265760135f); q = q * t + 0.7107068705f; q = q * t + (-0.142248368f); q = q * t + 0.127414796f; q = q * t;
    const f32x2 s = (v * v) * (-0.72134752044f);
    f32x2 e; e.x = __builtin_amdgcn_exp2f(s.x); e.y = __builtin_amdgcn_exp2f(s.y);
    const f32x2 m = v * (q * e), r = v - m;
    f32x2 o; o.x = v.x < 0.f ? m.x : r.x; o.y = v.y < 0.f ? m.y : r.y; return o;
}

constexpr float RMS_EPS_ = 1e-6f;
__device__ __forceinline__ float silu_f(float x) { return x * __builtin_amdgcn_rcpf(1.0f + __builtin_amdgcn_exp2f(-1.4426950408889634f * x)); }
__device__ __forceinline__ u32x4 pack8(const f32x4 a, const f32x4 b) { u32x4 w; w.x = cvt_pk_bf16(a[0], a[1]); w.y = cvt_pk_bf16(a[2], a[3]); w.z = cvt_pk_bf16(b[0], b[1]); w.w = cvt_pk_bf16(b[2], b[3]); return w; }

struct ListOrder {
    int nM, cnt, idx;
    __device__ __forceinline__ void init(int nM_, int nN_, int first, int c) { nM = nM_; cnt = nM_ * nN_; idx = c - first; }
    __device__ __forceinline__ bool next(int i, Unit& u) const { if (i > 0 || idx < 0 || idx >= cnt) return false; u.pm = idx % nM; u.pn = idx / nM; return true; }
    __device__ __forceinline__ void a_ready(const Unit&) const {}
    __device__ __forceinline__ void done(const Unit&) const {}
};

template <bool PF> struct EpiSwiglu {
    static constexpr bool PERM = true, AFTER_DRAIN = false;
    bf16_t* H; const float* ssq; int ldh;
    mutable float rq[8];
    __device__ __forceinline__ void prefetch(const Unit& u, int wr, int fr) const {
        if (!PF) return;
        const float* p = ssq + u.pm * BM + wr * 64 + fr;
#pragma unroll
        for (int q = 0; q < 8; ++q) asm volatile("global_load_dword %0, %1, off offset:%c2" : "=v"(rq[q]) : "v"(p + (q >> 2) * HALF), "n"((q & 3) * 64) : "memory");
    }
    __device__ __forceinline__ void operator()(const f32x4 (&acc)[2][2][4][2], const Unit& u, int wr, int wc, int fr, int fq) const {
        const int row0 = u.pm * BM + wr * 64 + fr, col0 = u.pn * HALF + wc * 32 + 8 * fq;
        if (PF) asm volatile("" : "+v"(rq[0]), "+v"(rq[1]), "+v"(rq[2]), "+v"(rq[3]), "+v"(rq[4]), "+v"(rq[5]), "+v"(rq[6]), "+v"(rq[7]) :: "memory");
        else {
#pragma unroll
            for (int q = 0; q < 8; ++q) rq[q] = ssq[row0 + (q >> 2) * HALF + (q & 3) * 16]; }
#pragma unroll
        for (int ai = 0; ai < 2; ++ai)
#pragma unroll
            for (int m = 0; m < 4; ++m) { const int row = row0 + ai * HALF + m * 16; const float rr = __builtin_amdgcn_rsqf(rq[ai * 4 + m] * (1.0f / 1024.0f) + RMS_EPS_);
                const float s1 = -1.4426950408889634f * rr, rr2 = rr * rr;
                const f32x4 g0 = acc[ai][0][m][0], g1 = acc[ai][0][m][1], u0 = acc[ai][1][m][0], u1 = acc[ai][1][m][1];
                f32x4 e0 = g0 * s1, e1 = g1 * s1;
#pragma unroll
                for (int i = 0; i < 4; ++i) { e0[i] = __builtin_amdgcn_rcpf(1.0f + __builtin_amdgcn_exp2f(e0[i])); e1[i] = __builtin_amdgcn_rcpf(1.0f + __builtin_amdgcn_exp2f(e1[i])); }
                const f32x4 h0 = (g0 * u0) * (e0 * rr2), h1 = (g1 * u1) * (e1 * rr2);
                *(u32x4*)(H + (size_t)row * ldh + col0) = pack8(h0, h1); }
    }
};

__device__ __forceinline__ f32x4 bf_lo4(const u32x4 w) { return (f32x4){__uint_as_float(w.x << 16), __uint_as_float(w.x & 0xffff0000u), __uint_as_float(w.y << 16), __uint_as_float(w.y & 0xffff0000u)}; }
__device__ __forceinline__ f32x4 bf_hi4(const u32x4 w) { return (f32x4){__uint_as_float(w.z << 16), __uint_as_float(w.z & 0xffff0000u), __uint_as_float(w.w << 16), __uint_as_float(w.w & 0xffff0000u)}; }
template <int MODE, int NBATCH = 1> struct EpiResid {
    static constexpr bool PERM = true, AFTER_DRAIN = false;
    const bf16_t* xin; bf16_t* xout; float* out; float* ssq; float alpha;
    __device__ __forceinline__ void prefetch(const Unit&, int, int) const {}
    __device__ __forceinline__ void operator()(const f32x4 (&acc)[2][2][4][2], const Unit& u, int wr, int wc, int fr, int fq) const {
        const int row0 = u.pm * BM + wr * 64 + fr, col0 = u.pn * BM + wc * 32 + 8 * fq;
        constexpr int AIB = 2 / NBATCH;
#pragma unroll
        for (int a0 = 0; a0 < 2; a0 += AIB) {
            u32x4 b[AIB][4][2];
#pragma unroll
            for (int ai = 0; ai < AIB; ++ai)
#pragma unroll
                for (int m = 0; m < 4; ++m)
#pragma unroll
                    for (int bj = 0; bj < 2; ++bj) b[ai][m][bj] = *(const u32x4*)(xin + (size_t)(row0 + (a0 + ai) * HALF + m * 16) * 1024 + col0 + bj * HALF);
#pragma unroll
            for (int ai = 0; ai < AIB; ++ai)
#pragma unroll
                for (int m = 0; m < 4; ++m) { const int row = row0 + (a0 + ai) * HALF + m * 16; const size_t off = (size_t)row * 1024 + col0; float ss = 0.f;
#pragma unroll
                    for (int bj = 0; bj < 2; ++bj) { const f32x4 o0 = bf_lo4(b[ai][m][bj]) + alpha * acc[a0 + ai][bj][m][0], o1 = bf_hi4(b[ai][m][bj]) + alpha * acc[a0 + ai][bj][m][1];
                        if (MODE == 0) { *(f32x4*)(out + off + bj * HALF) = o0; *(f32x4*)(out + off + bj * HALF + 4) = o1; }
                        else { *(u32x4*)(xout + off + bj * HALF) = pack8(o0, o1);
                            ss += (o0[0] * o0[0] + o0[1] * o0[1]) + (o0[2] * o0[2] + o0[3] * o0[3]) + (o1[0] * o1[0] + o1[1] * o1[1]) + (o1[2] * o1[2] + o1[3] * o1[3]); } }
                    if (MODE == 1) { ss += __shfl_xor(ss, 16); ss += __shfl_xor(ss, 32); if (fq == 0) atomicAdd(ssq + row, ss); } }
            if (NBATCH > 1) asm volatile("" ::: "memory");
        }
    }
};

__device__ __forceinline__ void head_rows(const f32x4 (&acc)[2][2][4][2], const int rowb, const int fq, const int fr, const float* ssq, const float* rope, float* pstate,
        const bool o_norm, const bool o_rot, const bool o_f32o, const bool o_ks, const bool o_pst, const float o_sc, bf16_t* o_ob, const int o_ldb, float* o_of, const int o_ldf, const float* o_gain, const int o_hcol, float* o_ksum) {
    f32x4 g[2][2];
#pragma unroll
    for (int bj = 0; bj < 2; ++bj)
#pragma unroll
        for (int n = 0; n < 2; ++n) g[bj][n] = o_norm ? *(const f32x4*)(o_gain + 32 * bj + 8 * fq + 4 * n) : (f32x4){1.f, 1.f, 1.f, 1.f};
    float rr8[8];
#pragma unroll
    for (int q = 0; q < 8; ++q) rr8[q] = __builtin_amdgcn_rsqf(ssq[rowb + (q >> 2) * HALF + (q & 3) * 16] * (1.0f / 1024.0f) + RMS_EPS_);
    f32x4 cs[2][2];
#pragma unroll
    for (int bj = 0; bj < 2; ++bj)
#pragma unroll
        for (int n = 0; n < 2; ++n) cs[bj][n] = (f32x4){0.f, 0.f, 0.f, 0.f};
#pragma unroll
    for (int ai = 0; ai < 2; ++ai)
#pragma unroll
        for (int m = 0; m < 4; ++m) { const int row = rowb + ai * HALF + m * 16; const float rr = rr8[ai * 4 + m];
            f32x4 v[2][2];
#pragma unroll
            for (int bj = 0; bj < 2; ++bj)
#pragma unroll
                for (int n = 0; n < 2; ++n) v[bj][n] = acc[ai][bj][m][n] * rr;
            { float ss = 0.f;
#pragma unroll
                for (int bj = 0; bj < 2; ++bj)
#pragma unroll
                    for (int n = 0; n < 2; ++n) ss += (v[bj][n][0] * v[bj][n][0] + v[bj][n][1] * v[bj][n][1]) + (v[bj][n][2] * v[bj][n][2] + v[bj][n][3] * v[bj][n][3]);
                ss += __shfl_xor(ss, 16); ss += __shfl_xor(ss, 32);
                const float hn = o_norm ? __builtin_amdgcn_rsqf(ss * (1.0f / 64.0f) + RMS_EPS_) : 1.0f;
#pragma unroll
                for (int bj = 0; bj < 2; ++bj)
#pragma unroll
                    for (int n = 0; n < 2; ++n) v[bj][n] = v[bj][n] * hn * g[bj][n];
            }
            if (o_rot) { const int pos = row & 2047; const float* rp = rope + pos * 16;
#pragma unroll
                for (int n = 0; n < 2; ++n) { const f32x4 t0 = *(const f32x4*)(rp + 8 * n), t1 = *(const f32x4*)(rp + 8 * n + 4);
                    const f32x4 x = v[0][n]; f32x4 y;
#pragma unroll
                    for (int i = 0; i < 4; ++i) y[i] = __shfl_xor(x[i], 16);
                    const float sg = (fq == 0) ? -1.f : 1.f;
                    f32x4 r_;
                    r_[0] = x[0] * t0[0] + sg * y[0] * t0[1]; r_[1] = x[1] * t0[2] + sg * y[1] * t0[3]; r_[2] = x[2] * t1[0] + sg * y[2] * t1[1]; r_[3] = x[3] * t1[2] + sg * y[3] * t1[3];
                    if (fq < 2) v[0][n] = r_; }
            }
#pragma unroll
            for (int bj = 0; bj < 2; ++bj)
#pragma unroll
                for (int n = 0; n < 2; ++n) cs[bj][n] += v[bj][n];
#pragma unroll
            for (int bj = 0; bj < 2; ++bj) { const int col = o_hcol + 32 * bj + 8 * fq;
                if (o_f32o) { *(f32x4*)(o_of + (size_t)row * o_ldf + col) = v[bj][0]; *(f32x4*)(o_of + (size_t)row * o_ldf + col + 4) = v[bj][1]; }
                if (o_pst) { const int t = row & 2047; if (t >= 2033) { float* pp = pstate + ((size_t)(row >> 11) * 15 + (t - 2033)) * 256 + col; *(f32x4*)pp = v[bj][0]; *(f32x4*)(pp + 4) = v[bj][1]; } }
                *(u32x4*)(o_ob + (size_t)row * o_ldb + col) = pack8(v[bj][0] * o_sc, v[bj][1] * o_sc); }
            if (m & 1) asm volatile("" ::: "memory"); }
    if (o_ks) {
#pragma unroll
        for (int bj = 0; bj < 2; ++bj)
#pragma unroll
            for (int n = 0; n < 2; ++n)
#pragma unroll
                for (int i = 0; i < 4; ++i) { float s = cs[bj][n][i]; s += __shfl_xor(s, 1); s += __shfl_xor(s, 2); s += __shfl_xor(s, 4); s += __shfl_xor(s, 8);
                    if (fr == 0) atomicAdd(o_ksum + 32 * bj + 8 * fq + 4 * n + i, s); }
    }
}
template <bool MEM> struct EpiHead {
    static constexpr bool PERM = true, AFTER_DRAIN = false;
    const float* ssq; const float* rope; float* outp; float* ksum; unsigned char* ws; float c2;
    __device__ __forceinline__ void prefetch(const Unit&, int, int) const {}
    __device__ __forceinline__ void operator()(const f32x4 (&acc)[2][2][4][2], const Unit& u, int wr, int wc, int fr, int fq) const {
        const int rowb = u.pm * BM + wr * 64 + fr; const int pn = u.pn;
        const float* gains = (const float*)(ws + WS_GAIN);
        if (MEM) {
            head_rows(acc, rowb, fq, fr, ssq, rope, outp + O_PS, pn == 0, false, true, false, false, 1.f, (bf16_t*)(ws + (pn == 0 ? WS_MKB : WS_MVB)), 256, outp + (pn == 0 ? O_MK : O_MV), 256, gains + 3 * 64, 64 * wc, ksum);
        } else {
            const bool isq = (pn == 1 || pn == 2), isk = (pn == 3 || pn == 4), isv = (pn == 5 || pn == 6), ism = (pn == 7);
            const size_t boff = pn == 0 ? WS_U : (isq ? WS_Q : (isk ? WS_K : (isv ? WS_V : WS_QM)));
            head_rows(acc, rowb, fq, fr, ssq, rope, outp + O_PS, isq || isk || ism, isq || isk, isk || isv, isk, pn == 0, (isq || ism) ? c2 : 1.f, (bf16_t*)(ws + boff), (pn == 0 || ism) ? 256 : 512,
                      outp + (isk ? O_KP : O_VP), 512, gains + (isq ? 0 : (isk ? 64 : 128)), ((pn == 0 || ism) ? 0 : 256 * ((pn - 1) & 1)) + 64 * wc, ksum + (size_t)u.pm * 512 + (4 * ((pn - 1) & 1) + wc) * 64);
        }
    }
};

struct NoStream { static constexpr int NX = 0; __device__ __forceinline__ void wait() { asm volatile("s_waitcnt vmcnt(8)" ::: "memory"); } __device__ __forceinline__ void start_a() {} __device__ __forceinline__ void start() {} __device__ __forceinline__ void begin_unit(int) {} template <int SEL> __device__ __forceinline__ void sp(int, int) {} __device__ __forceinline__ void finish() {} };
template <class Epi, class Sched, bool ALIGN_EPI = false, bool SP2 = false, class Strm = NoStream>
__device__ __forceinline__ void gemm_phase(PG8_LAS unsigned char* lds, const Gemm g, const Sched& S, const Epi& E, Strm& X) {
    const int tid = threadIdx.x, wid = __builtin_amdgcn_readfirstlane(tid >> 6), lane = tid & 63, wr = wid >> 2, wc = wid & 3, fr = lane & 15, fq = lane >> 4;
    const int K = g.K, nt = K / BK;
    unsigned voffA[2], voffB[2];
#pragma unroll
    for (int i = 0; i < 2; ++i) { int R, C; stage_rc(tid * 16 + i * 8192, R, C); const int Rb = Epi::PERM ? ((R & ~31) + perm32(R & 31)) : R;
        voffA[i] = (unsigned)(R * K + C) * 2u; voffB[i] = (unsigned)(Rb * K + C) * 2u; }
    const size_t kstep = (size_t)(BK * 2);
    const size_t hstep = (size_t)HALF * K * 2;
    const size_t tstep = 2 * hstep;
    const unsigned ldsw = (unsigned)wid * 1024u;
    const int aoff = lds_byte(wr * 64 + fr, fq * 8), boff = lds_byte(wc * 32 + fr, fq * 8);
#define PG8_SA(b, h) (((b) * 2 + (h)) * HTB)
#define PG8_SB(b, h) ((4 + (b) * 2 + (h)) * HTB)
#define PG8_STAGE(bufoff, gbase, voff) do { _Pragma("unroll") for (int _i = 0; _i < 2; ++_i) \
        __builtin_amdgcn_global_load_lds((const unsigned*)((const char*)(gbase) + (voff)[_i]), (PG8_LAS unsigned*)(lds + (bufoff) + ldsw + _i * 8192), 16, 0, 0); } while (0)
#define PG8_LDA(dst, b, h) do { _Pragma("unroll") for (int m = 0; m < 4; ++m) _Pragma("unroll") for (int k = 0; k < 2; ++k) dst[m][k] = *(const PG8_LAS bf16x8*)(lds + PG8_SA(b, h) + aoff + m * 2048 + k * 1024); } while (0)
#define PG8_LDB(dst, b, h) do { _Pragma("unroll") for (int n = 0; n < 2; ++n) _Pragma("unroll") for (int k = 0; k < 2; ++k) dst[n][k] = *(const PG8_LAS bf16x8*)(lds + PG8_SB(b, h) + boff + n * 2048 + k * 1024); } while (0)
#define PG8_MMA(ai, bj, At, Bt) do { __builtin_amdgcn_s_setprio(1); _Pragma("unroll") for (int m = 0; m < 4; ++m) _Pragma("unroll") for (int n = 0; n < 2; ++n) _Pragma("unroll") for (int k = 0; k < 2; ++k) \
        acc[ai][bj][m][n] = __builtin_amdgcn_mfma_f32_16x16x32_bf16(Bt[n][k], At[m][k], acc[ai][bj][m][n], 0, 0, 0); __builtin_amdgcn_s_setprio(0); } while (0)
#define PG8_WAIT_V(n) asm volatile("s_waitcnt vmcnt(" #n ")" ::: "memory")
#define PG8_WAIT_L(n) asm volatile("s_waitcnt lgkmcnt(" #n ")" ::: "memory")
#define PG8_WAIT_VX X.wait()
#define PG8_BAR __builtin_amdgcn_s_barrier()
#define PG8_SCHED __builtin_amdgcn_sched_barrier(0)
    Unit cur, nxt; int ui = 0;
    if (!S.next(0, cur)) return;
    f32x4 acc[2][2][4][2];
#pragma unroll
    for (int a = 0; a < 2; ++a)
#pragma unroll
        for (int b = 0; b < 2; ++b)
#pragma unroll
            for (int m = 0; m < 4; ++m)
#pragma unroll
                for (int n = 0; n < 2; ++n) acc[a][b][m][n] = (f32x4){0.f, 0.f, 0.f, 0.f};
    bf16x8 At[4][2], B0[2][2], B1[2][2];
    const char* cA = (const char*)g.A + (size_t)cur.pm * tstep; const char* cB = (const char*)g.Bt + (size_t)cur.pn * tstep;
    S.a_ready(cur);
    if constexpr (SP2) {
        PG8_STAGE(PG8_SB(0, 0), cB, voffB); PG8_STAGE(PG8_SB(0, 1), cB + hstep, voffB); PG8_STAGE(PG8_SA(0, 0), cA, voffA); PG8_STAGE(PG8_SA(0, 1), cA + hstep, voffA);
        if (wr == 1) PG8_BAR;
        PG8_WAIT_V(2); PG8_BAR;
        X.start_a();
        PG8_STAGE(PG8_SB(1, 0), cB + kstep, voffB); PG8_STAGE(PG8_SA(1, 0), cA + kstep, voffA); PG8_STAGE(PG8_SB(1, 1), cB + hstep + kstep, voffB);
        PG8_WAIT_V(6); PG8_BAR;
        X.start(); X.begin_unit(0);
    } else {
        PG8_STAGE(PG8_SB(0, 0), cB, voffB); PG8_STAGE(PG8_SA(0, 0), cA, voffA); PG8_STAGE(PG8_SB(0, 1), cB + hstep, voffB); PG8_STAGE(PG8_SA(0, 1), cA + hstep, voffA);
        if (wr == 1) PG8_BAR;
        PG8_WAIT_V(4); PG8_BAR;
        PG8_STAGE(PG8_SB(1, 0), cB + kstep, voffB); PG8_STAGE(PG8_SA(1, 0), cA + kstep, voffA); PG8_STAGE(PG8_SB(1, 1), cB + hstep + kstep, voffB);
        PG8_WAIT_V(6); PG8_BAR;
    }
    for (;;) {
        const bool has_next = S.next(ui + 1, nxt);
        const char* nA = has_next ? (const char*)g.A + (size_t)nxt.pm * tstep : cA; const char* nB = has_next ? (const char*)g.Bt + (size_t)nxt.pn * tstep : cB;
        for (int t = 0; t < nt; t += 2) {
            const bool last = (t == nt - 2);
            const char* a1 = cA + (size_t)(t + 1) * kstep;
            const char* a2 = last ? nA : cA + (size_t)(t + 2) * kstep; const char* b2 = last ? nB : cB + (size_t)(t + 2) * kstep;
            const char* a3 = a2 + kstep; const char* b3 = b2 + kstep;
            if (last && has_next) S.a_ready(nxt);
            if (last) E.prefetch(cur, wr, fr);
            if constexpr (SP2) {
            PG8_LDB(B0, 0, 0); PG8_LDB(B1, 0, 1); PG8_SCHED; PG8_LDA(At, 0, 0); PG8_STAGE(PG8_SA(1, 1), a1 + hstep, voffA);
            PG8_WAIT_VX; X.template sp<0>(2 * t, ui); PG8_WAIT_L(0); PG8_BAR; PG8_MMA(0, 0, At, B0); PG8_MMA(0, 1, At, B1); PG8_BAR; PG8_SCHED;
            PG8_LDA(At, 0, 1); PG8_STAGE(PG8_SB(0, 0), b2, voffB); PG8_STAGE(PG8_SB(0, 1), b2 + hstep, voffB); PG8_STAGE(PG8_SA(0, 0), a2, voffA);
            PG8_WAIT_VX; X.template sp<1>(2 * t + 1, ui); PG8_WAIT_L(0); PG8_BAR; PG8_MMA(1, 0, At, B0); PG8_MMA(1, 1, At, B1); PG8_BAR; PG8_SCHED;
            PG8_LDB(B0, 1, 0); PG8_LDB(B1, 1, 1); PG8_SCHED; PG8_LDA(At, 1, 0); PG8_STAGE(PG8_SA(0, 1), a2 + hstep, voffA);
            PG8_WAIT_VX; X.template sp<2>(2 * t + 2, ui); PG8_WAIT_L(0); PG8_BAR; PG8_MMA(0, 0, At, B0); PG8_MMA(0, 1, At, B1); PG8_BAR; PG8_SCHED;
            PG8_LDA(At, 1, 1); PG8_STAGE(PG8_SB(1, 0), b3, voffB); PG8_STAGE(PG8_SB(1, 1), b3 + hstep, voffB); PG8_STAGE(PG8_SA(1, 0), a3, voffA);
            PG8_WAIT_VX; X.template sp<3>(2 * t + 3, ui); PG8_WAIT_L(0); PG8_BAR; PG8_MMA(1, 0, At, B0); PG8_MMA(1, 1, At, B1); PG8_BAR; PG8_SCHED;
            } else {
            PG8_LDB(B0, 0, 0); PG8_SCHED; PG8_LDA(At, 0, 0); PG8_STAGE(PG8_SA(1, 1), a1 + hstep, voffA);
            PG8_WAIT_L(8); PG8_BAR; PG8_WAIT_L(0); PG8_MMA(0, 0, At, B0); PG8_BAR; PG8_SCHED;
            PG8_LDB(B1, 0, 1); PG8_STAGE(PG8_SB(0, 0), b2, voffB);
            PG8_BAR; PG8_WAIT_L(0); PG8_MMA(0, 1, At, B1); PG8_BAR;
            PG8_LDA(At, 0, 1); PG8_STAGE(PG8_SA(0, 0), a2, voffA);
            PG8_BAR; PG8_WAIT_L(0); PG8_MMA(1, 0, At, B0); PG8_BAR; PG8_SCHED;
            PG8_STAGE(PG8_SB(0, 1), b2 + hstep, voffB);
            PG8_WAIT_V(6); PG8_BAR; PG8_MMA(1, 1, At, B1); PG8_BAR;
            PG8_LDB(B0, 1, 0); PG8_SCHED; PG8_LDA(At, 1, 0); PG8_STAGE(PG8_SA(0, 1), a2 + hstep, voffA);
            PG8_WAIT_L(8); PG8_BAR; PG8_WAIT_L(0); PG8_MMA(0, 0, At, B0); PG8_BAR; PG8_SCHED;
            PG8_LDB(B1, 1, 1); PG8_STAGE(PG8_SB(1, 0), b3, voffB);
            PG8_BAR; PG8_WAIT_L(0); PG8_MMA(0, 1, At, B1); PG8_BAR;
            PG8_LDA(At, 1, 1); PG8_STAGE(PG8_SA(1, 0), a3, voffA);
            PG8_BAR; PG8_WAIT_L(0); PG8_MMA(1, 0, At, B0); PG8_BAR; PG8_SCHED;
            PG8_STAGE(PG8_SB(1, 1), b3 + hstep, voffB);
            PG8_WAIT_V(6); PG8_BAR; PG8_MMA(1, 1, At, B1); PG8_BAR;
            }
        }
        if constexpr (ALIGN_EPI) { if (wr == 0) PG8_BAR; }
        if constexpr (!Epi::AFTER_DRAIN) { E(acc, cur, wr, wc, fr, fq); S.done(cur); }
        if (!has_next) break;
#pragma unroll
        for (int a = 0; a < 2; ++a)
#pragma unroll
            for (int b = 0; b < 2; ++b)
#pragma unroll
                for (int m = 0; m < 4; ++m)
#pragma unroll
                    for (int n = 0; n < 2; ++n) acc[a][b][m][n] = (f32x4){0.f, 0.f, 0.f, 0.f};
        cur = nxt; cA = nA; cB = nB; ++ui;
        X.begin_unit(ui);
        if constexpr (ALIGN_EPI) { if (wr == 1) PG8_BAR; }
    }
    PG8_WAIT_V(0);
    X.finish();
    if constexpr (!ALIGN_EPI) { if (wr == 0) PG8_BAR; }
    PG8_BAR;
    if constexpr (Epi::AFTER_DRAIN) { E.fused(acc, cur, wr, wc, fr, fq, lds, wid, lane); S.done(cur); }
#undef PG8_SA
#undef PG8_SB
#undef PG8_STAGE
#undef PG8_LDA
#undef PG8_LDB
#undef PG8_MMA
#undef PG8_WAIT_V
#undef PG8_WAIT_L
#undef PG8_WAIT_VX
#undef PG8_BAR
#undef PG8_SCHED
}
}

namespace attn_body {
using bf16=__hip_bfloat16;
using bf16x8=__attribute__((ext_vector_type(8)))short;
using s16x4=__attribute__((ext_vector_type(4)))short;
using f32x16=__attribute__((ext_vector_type(16)))float;
using u32x4=__attribute__((ext_vector_type(4)))unsigned;
using f32x4_t=__attribute__((ext_vector_type(4)))float;
__device__ __forceinline__ float bf2f(short s){return __uint_as_float(((unsigned)(unsigned short)s)<<16);}
constexpr int D=64;
constexpr int NW=8,QBLK=32,QB=QBLK*NW,KVBLK=64;
constexpr int ATTN_UNIT_ROWS=QB;
__device__ __forceinline__ int crow(int r,int hi){return (r&3)+8*(r>>2)+4*hi;}
#define SBAR() __builtin_amdgcn_sched_barrier(0)
__device__ __forceinline__ void cmask(f32x16&p0,f32x16&p1,int jb,int qrel,int hi){
  const float NEG=-INFINITY; int kb=64*jb+4*hi;
  #pragma unroll
  for(int r=0;r<16;++r){int kv=kb+(r&3)+8*(r>>2); if(kv>qrel)p0[r]=NEG; if(kv+32>qrel)p1[r]=NEG;}
}

constexpr int NSLOT=3, SLOTB=8192;
constexpr int LDS_K=0, LDS_V=NSLOT*SLOTB, LDS_WS=2*NSLOT*SLOTB, LDS_OST=LDS_WS+NW*64*4, LDS_BYTES=LDS_OST+NW*4096;
constexpr float C2=0.125f*1.4426950408889634f;
__device__ __forceinline__ void glds16(const void*gsrc,unsigned lds_dst){unsigned keep;
  asm volatile("s_mov_b32 %0, m0\n\ts_mov_b32 m0, %2\n\ts_nop 0\n\tglobal_load_lds_dwordx4 %1, off\n\ts_mov_b32 m0, %0":"=&s"(keep):"v"(gsrc),"s"(lds_dst):"memory");}
__device__ __forceinline__ float max3f(float a,float b,float c){float r;asm("v_max3_f32 %0, %1, %2, %3":"=v"(r):"v"(a),"v"(b),"v"(c));return r;}
__device__ __forceinline__ float max2f(float a,float b){float r;asm("v_max_f32_e32 %0, %1, %2":"=v"(r):"v"(a),"v"(b));return r;}
__device__ __forceinline__ float fadd_s(float a,float b){float r;asm("v_add_f32_e32 %0, %1, %2":"=v"(r):"v"(a),"v"(b));return r;}
__device__ __forceinline__ float fsub_s(float a,float b){float r;asm("v_sub_f32_e32 %0, %1, %2":"=v"(r):"v"(a),"v"(b));return r;}
typedef float f32x2_t __attribute__((ext_vector_type(2))); typedef __bf16 bf16x2_t __attribute__((ext_vector_type(2)));
__device__ __forceinline__ unsigned cvtpk_s(float lo,float hi){f32x2_t v={lo,hi};bf16x2_t b=__builtin_convertvector(v,bf16x2_t);return __builtin_bit_cast(unsigned,b);}
#define WAIT_BAR(N) asm volatile("s_waitcnt vmcnt(" #N ") lgkmcnt(0)\n\ts_barrier":::"memory")

__device__ __forceinline__ void qkt(f32x16&p0,f32x16&p1,const char*Kslot,const bf16x8*qr,const f32x16&negm,int r32,int hi){
  const char*kb=Kslot+hi*1024+r32*16;
  #pragma unroll
  for(int d0=0;d0<4;++d0){
    const bf16x8 b0=*reinterpret_cast<const bf16x8*>(kb+d0*2048);
    const bf16x8 b1=*reinterpret_cast<const bf16x8*>(kb+d0*2048+512);
    if(d0==0){p0=__builtin_amdgcn_mfma_f32_32x32x16_bf16(b0,qr[0],negm,0,0,0);p1=__builtin_amdgcn_mfma_f32_32x32x16_bf16(b1,qr[0],negm,0,0,0);}
    else{p0=__builtin_amdgcn_mfma_f32_32x32x16_bf16(b0,qr[d0],p0,0,0,0);p1=__builtin_amdgcn_mfma_f32_32x32x16_bf16(b1,qr[d0],p1,0,0,0);}}
}
typedef __attribute__((address_space(3))) const char* lds_cptr;
typedef short v4i16_t __attribute__((ext_vector_type(4)));
__device__ __forceinline__ void kload8(bf16x8*kf,lds_cptr kp){
  kf[0]=*(const __attribute__((address_space(3))) bf16x8*)(kp);      kf[1]=*(const __attribute__((address_space(3))) bf16x8*)(kp+512);
  kf[2]=*(const __attribute__((address_space(3))) bf16x8*)(kp+2048); kf[3]=*(const __attribute__((address_space(3))) bf16x8*)(kp+2560);
  kf[4]=*(const __attribute__((address_space(3))) bf16x8*)(kp+4096); kf[5]=*(const __attribute__((address_space(3))) bf16x8*)(kp+4608);
  kf[6]=*(const __attribute__((address_space(3))) bf16x8*)(kp+6144); kf[7]=*(const __attribute__((address_space(3))) bf16x8*)(kp+6656);
}
__device__ __forceinline__ void kload2(bf16x8*kf,lds_cptr kp,int j){ kf[2*j]=*(const __attribute__((address_space(3))) bf16x8*)(kp+j*2048); kf[2*j+1]=*(const __attribute__((address_space(3))) bf16x8*)(kp+j*2048+512); }
__device__ __forceinline__ s16x4 vtr(lds_cptr p){ return __builtin_bit_cast(s16x4,__builtin_amdgcn_ds_read_tr16_b64_v4i16((__attribute__((address_space(3))) v4i16_t*)p)); }
__device__ __forceinline__ float rowmax(const f32x16&p0,const f32x16&p1){
  float a=max3f(p0[0],p0[1],p1[0]),b=max3f(p0[2],p0[3],p1[1]);a=max3f(a,p1[2],p1[3]);
  #pragma unroll
  for(int r=4;r<16;r+=4){a=max3f(a,p0[r],p0[r+1]);b=max3f(b,p0[r+2],p0[r+3]);a=max3f(a,p1[r],p1[r+1]);b=max3f(b,p1[r+2],p1[r+3]);}
  const float m=max2f(a,b);
  auto rr=__builtin_amdgcn_permlane32_swap(__float_as_uint(m),__float_as_uint(m),false,false);
  return max2f(__uint_as_float(rr[0]),__uint_as_float(rr[1]));
}
__device__ __forceinline__ void pv(f32x16*o,int vb,bf16x8 pa0,bf16x8 pa1,bf16x8 pa2,bf16x8 pa3){
  #pragma unroll
  for(int d0=0;d0<2;++d0){s16x4 lo[4],hi[4];
    #pragma unroll
    for(int ks=0;ks<4;++ks){
      asm volatile("ds_read_b64_tr_b16 %0,%1 offset:%c2":"=&v"(lo[ks]):"v"(vb),"i"(d0*4096+ks*1024):"memory");
      asm volatile("ds_read_b64_tr_b16 %0,%1 offset:%c2":"=&v"(hi[ks]):"v"(vb),"i"(d0*4096+ks*1024+512):"memory");}
    asm volatile("s_waitcnt lgkmcnt(0)":::"memory");SBAR();
    #define PK(k) (bf16x8){lo[k][0],lo[k][1],lo[k][2],lo[k][3],hi[k][0],hi[k][1],hi[k][2],hi[k][3]}
    o[d0]=__builtin_amdgcn_mfma_f32_32x32x16_bf16(pa0,PK(0),o[d0],0,0,0);
    o[d0]=__builtin_amdgcn_mfma_f32_32x32x16_bf16(pa1,PK(1),o[d0],0,0,0);
    o[d0]=__builtin_amdgcn_mfma_f32_32x32x16_bf16(pa2,PK(2),o[d0],0,0,0);
    o[d0]=__builtin_amdgcn_mfma_f32_32x32x16_bf16(pa3,PK(3),o[d0],0,0,0);
    #undef PK
  }
}

#ifndef ATTN_STORE16
#define ATTN_STORE16(p,v) (*(u32x4*)(p)=(v))
#endif
template<int THRL,int MODE,int QP,int KP,int OP> __device__ __forceinline__ void attn_unit(const bf16*Qu,const bf16*__restrict__ Kh,const bf16*__restrict__ Vh,bf16*Ou,const int NT,const __attribute__((address_space(3))) unsigned char*seltab,char*shm){
  const int tid=threadIdx.x,lane=tid&63,r32=lane&31,hi=lane>>5; const int wid=__builtin_amdgcn_readfirstlane(tid>>6);
  const bf16*Qw=Qu+(long)(wid*QBLK)*QP;
  const unsigned lds0=(unsigned)(uintptr_t)shm;
  float*wsf=(float*)(shm+LDS_WS)+wid*64;
  const bf16*ksrc=Kh+(long)lane*KP+wid*8;
  const bf16*vsrc=Vh+(long)(16*(wid&3)+(lane>>2))*KP+(wid>>2)*32+(lane&3)*8;
  const unsigned kdst=lds0+LDS_K+wid*1024, vdst=lds0+LDS_V+wid*1024;
  #define PHYS(t) (MODE==1?(((t)<4)?((t)+NT-4):((t)-4)):(t))
  #define DMA_K(t,slot) glds16(ksrc+(long)PHYS(t)*KVBLK*KP,(unsigned)__builtin_amdgcn_readfirstlane(kdst+(slot)))
  #define DMA_V(t,slot) glds16(vsrc+(long)PHYS(t)*KVBLK*KP,(unsigned)__builtin_amdgcn_readfirstlane(vdst+(slot)))
  const char*Kbase=shm+LDS_K; bf16x8 kf[8];
  const lds_cptr shm3=(lds_cptr)shm; const lds_cptr kp0=shm3+LDS_K+hi*1024+r32*16; const lds_cptr vp0=shm3+LDS_V+((lane>>4)&1)*32+(lane&3)*8+(4*hi+((lane&15)>>2))*64;
  DMA_K(0,0);DMA_V(0,0);DMA_K(1,SLOTB);
  bf16x8 qr[4];
  #pragma unroll
  for(int d0=0;d0<4;++d0)qr[d0]=*reinterpret_cast<const bf16x8*>(&Qw[(long)r32*QP+d0*16+hi*8]);
  unsigned sel=0x7fu; if(MODE==1) sel=(unsigned)seltab[wid*QBLK+r32];
  float mhat=0.f,l_reg=0.f;f32x16 o[2];o[0]=f32x16{};o[1]=f32x16{};const f32x16 negm=f32x16{};
  const int qrel=wid*QBLK+r32;
  #define CMASK(P0,P1,t) do{ if(MODE==1){ if((t)<4) cmask(P0,P1,(t),qrel,hi); else if(!((sel>>(((t)-4)>>2))&1u)){ _Pragma("unroll") for(int r_=0;r_<16;++r_){P0[r_]=-INFINITY;P1[r_]=-INFINITY;} } } }while(0)
  bool resc=false;
  #define START(P0,P1) do{ const float rm=rowmax(P0,P1); resc=false; \
    { const float dl=rm; mhat=fadd_s(mhat,dl); \
      _Pragma("unroll") for(int r=0;r<16;++r){P0[r]=fsub_s(P0[r],dl);P1[r]=fsub_s(P1[r],dl);} \
      } \
    _Pragma("unroll") for(int r=0;r<16;++r)P0[r]=__builtin_amdgcn_exp2f(P0[r]); }while(0)
  #define RESC() do{ if(resc){ asm volatile("s_waitcnt lgkmcnt(0)":::"memory"); \
      _Pragma("unroll") for(int d_=0;d_<2;++d_) _Pragma("unroll") for(int r=0;r<16;++r)o[d_][r]*=wsf[crow(r,hi)]; } }while(0)
  f32x16 pA0,pA1,pB0,pB1;
  int sl_prev=0,sl_cur=0,sl_next=SLOTB;
  #define ROT() do{sl_prev=sl_cur;sl_cur=sl_next;sl_next=(sl_next==(NSLOT-1)*SLOTB)?0:sl_next+SLOTB;}while(0)
  DMA_K(2,2*SLOTB);
  WAIT_BAR(3);
  qkt(pA0,pA1,Kbase,qr,negm,r32,hi);asm volatile("s_nop 15\n\ts_nop 7":"+v"(pA0),"+v"(pA1));if(MODE==1){ const int lim_=qrel-4*hi; _Pragma("unroll") for(int r_=0;r_<16;++r_){ const int c_=(r_&3)+8*(r_>>2); pA0[r_]=(c_>lim_)?-INFINITY:pA0[r_]; pA1[r_]=(c_+32>lim_)?-INFINITY:pA1[r_]; } }
  START(pA0,pA1);
  _Pragma("unroll") for(int r=0;r<16;++r)pA1[r]=__builtin_amdgcn_exp2f(pA1[r]);
  WAIT_BAR(0);
  DMA_K(3,0);DMA_V(1,SLOTB);
  ROT();
  kload8(kf,kp0+sl_cur);
  WAIT_BAR(2);
  s16x4 vlo[8],vhi[8]; u32x4 pw0,pw1,pw2,pw3;
  #define PKW(P,B) cvtpk_s(P[B],P[B+1])
  #define PAF(k) __builtin_bit_cast(bf16x8,pw##k)
  #define VFR(i) (bf16x8){vlo[i][0],vlo[i][1],vlo[i][2],vlo[i][3],vhi[i][0],vhi[i][1],vhi[i][2],vhi[i][3]}
  #define PIN(x) asm volatile("":"+v"(x))
  #define MX3(a,b,c) __builtin_fmaxf(__builtin_fmaxf((a),(b)),(c))
  #define GAPA(MF,A0,A1,A2,A3,W0,W1,PW) do{ MF; sacc+=A0; sacc+=A1; sacc+=A2; sacc+=A3; PIN(sacc); W0; W1; PIN(PW); SBAR(); }while(0)
  #define EX(v) __builtin_amdgcn_exp2f(v)
  #define GAPB(MF,X,B) do{ MF; X[B]=EX(X[B]); X[B+1]=EX(X[B+1]); X[B+2]=EX(X[B+2]); X[B+3]=EX(X[B+3]); PIN(X); SBAR(); }while(0)
  #define VRD(i) do{ vlo[i]=vtr(vp_+(((i)>>2)*4096+((i)&3)*1024)); vhi[i]=vtr(vp_+(((i)>>2)*4096+((i)&3)*1024+512)); }while(0)
  #define KRD(G,j) do{ if(G){ kload2(kf,kp0+sl_next,j); SBAR(); } }while(0)
  #define STEP(C0,C1,P0,P1,t,GK,GV,GL,PAST) do{ SBAR(); \
    const lds_cptr vp_=vp0+sl_prev; \
    VRD(0); SBAR(); float sacc=(P0[0]+P0[1]); \
    GAPA(C0=__builtin_amdgcn_mfma_f32_32x32x16_bf16(kf[0],qr[0],negm,0,0,0), P0[2],P0[3],P0[4],P0[5],     pw0[0]=PKW(P0,0), pw0[1]=PKW(P0,2), pw0); \
    VRD(4); SBAR(); GAPA(C1=__builtin_amdgcn_mfma_f32_32x32x16_bf16(kf[1],qr[0],negm,0,0,0), P0[6],P0[7],P0[8],P0[9],     pw0[2]=PKW(P0,4), pw0[3]=PKW(P0,6), pw0); \
    VRD(1); SBAR(); GAPA(C0=__builtin_amdgcn_mfma_f32_32x32x16_bf16(kf[2],qr[1],C0,0,0,0),   P0[10],P0[11],P0[12],P0[13], pw1[0]=PKW(P0,8), pw1[1]=PKW(P0,10), pw1); \
    VRD(5); SBAR(); GAPA(C1=__builtin_amdgcn_mfma_f32_32x32x16_bf16(kf[3],qr[1],C1,0,0,0),   P0[14],P0[15],P1[0],P1[1],   pw1[2]=PKW(P0,12),pw1[3]=PKW(P0,14), pw1); \
    VRD(2); SBAR(); GAPA(C0=__builtin_amdgcn_mfma_f32_32x32x16_bf16(kf[4],qr[2],C0,0,0,0),   P1[2],P1[3],P1[4],P1[5],     pw2[0]=PKW(P1,0), pw2[1]=PKW(P1,2), pw2); \
    VRD(6); SBAR(); GAPA(C1=__builtin_amdgcn_mfma_f32_32x32x16_bf16(kf[5],qr[2],C1,0,0,0),   P1[6],P1[7],P1[8],P1[9],     pw2[2]=PKW(P1,4), pw2[3]=PKW(P1,6), pw2); \
    VRD(3); SBAR(); GAPA(C0=__builtin_amdgcn_mfma_f32_32x32x16_bf16(kf[6],qr[3],C0,0,0,0),   P1[10],P1[11],P1[12],P1[13], pw3[0]=PKW(P1,8), pw3[1]=PKW(P1,10), pw3); \
    VRD(7); SBAR(); GAPA(C1=__builtin_amdgcn_mfma_f32_32x32x16_bf16(kf[7],qr[3],C1,0,0,0),   P1[14],P1[15],0.f,0.f,       pw3[2]=PKW(P1,12),pw3[3]=PKW(P1,14), pw3); \
    l_reg+=sacc; \
    if(GK){DMA_K((t)+3,sl_cur);} if(GV){DMA_V((t)+1,sl_next);} \
    if(MODE==1 && (PAST)){ const float mh_=(((sel>>(((t)-4)>>2))&1u)!=0u)?mhat:INFINITY; _Pragma("unroll") for(int r_=0;r_<16;++r_){ C0[r_]-=mh_; C1[r_]-=mh_; } }   \
    else if(MODE==1){ const int lim_=LIM(t); _Pragma("unroll") for(int r_=0;r_<16;++r_){ const int c_=(r_&3)+8*(r_>>2); C0[r_]=(c_>lim_)?-INFINITY:(C0[r_]-mhat); C1[r_]=(c_+32>lim_)?-INFINITY:(C1[r_]-mhat); } } \
    else { _Pragma("unroll") for(int r_=0;r_<16;++r_){ C0[r_]-=mhat; C1[r_]-=mhat; } } \
    { float a=MX3(C0[0],C0[1],C1[0]),b=MX3(C0[2],C0[3],C1[1]); a=MX3(a,C1[2],C1[3]); \
      _Pragma("unroll") for(int r=4;r<16;r+=4){a=MX3(a,C0[r],C0[r+1]);b=MX3(b,C0[r+2],C0[r+3]);a=MX3(a,C1[r],C1[r+1]);b=MX3(b,C1[r+2],C1[r+3]);} \
      float rm=__builtin_fmaxf(a,b); { auto rr=__builtin_amdgcn_permlane32_swap(__float_as_uint(rm),__float_as_uint(rm),false,false); rm=__builtin_fmaxf(__uint_as_float(rr[0]),__uint_as_float(rr[1])); } \
      resc=false; \
      if(__builtin_expect(__any(rm>(float)THRL),0)){ const float dl=__builtin_fmaxf(rm,0.f); mhat+=dl; \
        _Pragma("unroll") for(int r=0;r<16;++r){C0[r]-=dl;C1[r]-=dl;} \
        const float f=__builtin_amdgcn_exp2f(-dl); l_reg*=f; if(hi==0)wsf[r32]=f; resc=true; } } \
    SBAR(); \
    GAPB(o[0]=__builtin_amdgcn_mfma_f32_32x32x16_bf16(PAF(0),VFR(0),o[0],0,0,0), C0,0); \
    GAPB(o[1]=__builtin_amdgcn_mfma_f32_32x32x16_bf16(PAF(0),VFR(4),o[1],0,0,0), C0,4); \
    KRD(GL,0); GAPB(o[0]=__builtin_amdgcn_mfma_f32_32x32x16_bf16(PAF(1),VFR(1),o[0],0,0,0), C0,8); \
    KRD(GL,1); GAPB(o[1]=__builtin_amdgcn_mfma_f32_32x32x16_bf16(PAF(1),VFR(5),o[1],0,0,0), C0,12); \
    KRD(GL,2); GAPB(o[0]=__builtin_amdgcn_mfma_f32_32x32x16_bf16(PAF(2),VFR(2),o[0],0,0,0), C1,0); \
    KRD(GL,3); GAPB(o[1]=__builtin_amdgcn_mfma_f32_32x32x16_bf16(PAF(2),VFR(6),o[1],0,0,0), C1,4); \
    GAPB(o[0]=__builtin_amdgcn_mfma_f32_32x32x16_bf16(PAF(3),VFR(3),o[0],0,0,0), C1,8); \
    GAPB(o[1]=__builtin_amdgcn_mfma_f32_32x32x16_bf16(PAF(3),VFR(7),o[1],0,0,0), C1,12); \
    }while(0)
  #define LIM(t) (((t)<4)?(qrel-64*(t)-4*hi):((((sel>>(((t)-4)>>2))&1u)!=0u)?1000:-1000))
  int t=1;
  for(;t<5&&t+5<NT;t+=2){
    STEP(pB0,pB1,pA0,pA1,t,true,true,true,false);     WAIT_BAR(2); RESC(); ROT();
    STEP(pA0,pA1,pB0,pB1,t+1,true,true,true,false);   WAIT_BAR(2); RESC(); ROT();
  }
  for(;t+5<NT;t+=2){
    STEP(pB0,pB1,pA0,pA1,t,true,true,true,true);      WAIT_BAR(2); RESC(); ROT();
    STEP(pA0,pA1,pB0,pB1,t+1,true,true,true,true);    WAIT_BAR(2); RESC(); ROT();
  }
  #define ENDW(tt) do{ if((tt)+3<NT){WAIT_BAR(2);} else if((tt)+2<NT){WAIT_BAR(1);} else {WAIT_BAR(0);} }while(0)
  for(;t+1<NT;t+=2){
    STEP(pB0,pB1,pA0,pA1,t,(t+3<NT),(t+1<NT),(t+1<NT),false);       ENDW(t);   RESC(); ROT();
    STEP(pA0,pA1,pB0,pB1,t+1,(t+4<NT),(t+2<NT),(t+2<NT),false);     ENDW(t+1); RESC(); ROT();
  }
  STEP(pB0,pB1,pA0,pA1,NT-1,false,false,false,false); RESC();
  { float sacc=pB0[0]+pB0[1]; _Pragma("unroll") for(int r=2;r<16;++r)sacc+=pB0[r]; _Pragma("unroll") for(int r=0;r<16;++r)sacc+=pB1[r]; l_reg+=sacc;
    pw0=(u32x4){PKW(pB0,0),PKW(pB0,2),PKW(pB0,4),PKW(pB0,6)};pw1=(u32x4){PKW(pB0,8),PKW(pB0,10),PKW(pB0,12),PKW(pB0,14)};pw2=(u32x4){PKW(pB1,0),PKW(pB1,2),PKW(pB1,4),PKW(pB1,6)};pw3=(u32x4){PKW(pB1,8),PKW(pB1,10),PKW(pB1,12),PKW(pB1,14)};
    int ln_=threadIdx.x&63; asm volatile("":"+v"(ln_)); const int vb0_=(int)(lds0+LDS_V)+((ln_>>4)&1)*32+(ln_&3)*8+(4*(ln_>>5)+((ln_&15)>>2))*64;
    SBAR(); pv(o,vb0_+sl_cur,PAF(0),PAF(1),PAF(2),PAF(3)); }
  #undef PKW
  #undef PAF
  #undef VFR
  #undef PIN
  #undef MX3
  #undef GAPA
  #undef GAPB
  #undef EX
  #undef VRD
  #undef KRD
  #undef STEP
  #undef ENDW
  #undef LIM
  {auto rr=__builtin_amdgcn_permlane32_swap(__float_as_uint(l_reg),__float_as_uint(l_reg),false,false);l_reg=__uint_as_float(rr[0])+__uint_as_float(rr[1]);}
  if(hi==0)wsf[32+r32]=l_reg;asm volatile("s_waitcnt lgkmcnt(0)":::"memory");
  float rli[16];
  #pragma unroll
  for(int r=0;r<16;++r)rli[r]=__builtin_amdgcn_rcpf(wsf[32+crow(r,hi)]);
  bf16*Ow=Ou+(long)(wid*QBLK)*OP;
  { bf16*stg=(bf16*)(shm+LDS_OST)+wid*2048;
    #pragma unroll
    for(int r=0;r<16;++r){const int orow=crow(r,hi);
      #pragma unroll
      for(int d0=0;d0<2;++d0)stg[orow*64+d0*32+r32]=__float2bfloat16(o[d0][r]*rli[r]);}
    asm volatile("s_waitcnt lgkmcnt(0)":::"memory");
    #pragma unroll
    for(int i=0;i<4;++i){const int row=i*8+(lane>>3),ch=lane&7; const u32x4 v=*(const u32x4*)(stg+row*64+ch*8); ATTN_STORE16(Ow+(long)row*OP+ch*8,v);} }
  asm volatile("s_waitcnt lgkmcnt(0)\n\ts_barrier":::"memory");
  #undef DMA_K
  #undef PHYS
  #undef DMA_V
  #undef CMASK
  #undef START
  #undef RESC
  #undef ROT
}
constexpr int ATTN_LDS_BYTES=LDS_BYTES;
#undef SBAR
#undef WAIT_BAR
}

#define GAS __attribute__((address_space(1)))
#define LAS __attribute__((address_space(3)))
typedef unsigned short bf16;
typedef unsigned v4u __attribute__((ext_vector_type(4)));
typedef float f32x4 __attribute__((ext_vector_type(4)));
typedef short bf16x8 __attribute__((ext_vector_type(8)));
typedef GAS unsigned gu32;
typedef GAS unsigned long long gu64;
#define RLX_AGENT __ATOMIC_RELAXED, __HIP_MEMORY_SCOPE_AGENT
#define LDS_WAIT() asm volatile("s_waitcnt lgkmcnt(0)" ::: "memory")
#define VM_WAIT() asm volatile("s_waitcnt vmcnt(0)" ::: "memory")
__device__ __forceinline__ unsigned long long rt() { return __builtin_amdgcn_s_memrealtime(); }
__device__ __forceinline__ unsigned f2bf(float f) { unsigned u = __builtin_bit_cast(unsigned, f); return (u + 0x7fffu + ((u >> 16) & 1u)) >> 16; }
__device__ __forceinline__ unsigned pk2(float lo, float hi) { return f2bf(lo) | (f2bf(hi) << 16); }

#define XB_TMO      128
#define XB_XCNT(j)  (256  + 64 * (j))
#define XB_XSUB(j)  (1280 + 64 * (j))
#define XB_XGEN(j)  (2304 + 64 * (j))
#define XB_TOP      3328
#define XB_TOPGEN   3392
#define XCD_BAR_WORDS 3456
#define XB_SPIN_CAP (1u << 18)

__device__ __forceinline__ unsigned xb_ld(unsigned* p)              { return __hip_atomic_load(p, __ATOMIC_RELAXED, __HIP_MEMORY_SCOPE_AGENT); }
__device__ __forceinline__ unsigned xb_add(unsigned* p, unsigned v) { return __hip_atomic_fetch_add(p, v, __ATOMIC_RELAXED, __HIP_MEMORY_SCOPE_AGENT); }
__device__ __forceinline__ unsigned xb_xcc_id() { return (unsigned)__builtin_amdgcn_s_getreg((3 << 11) | 20) & 0xFu; }
#define XB_SPIN(cond, bar) do { unsigned _sp = 0; while (cond) { __builtin_amdgcn_s_sleep(1); \
    if ((++_sp & 255u) == 0u) { if (xb_ld(&(bar)[XB_TMO])) break; if (_sp > XB_SPIN_CAP) { atomicAdd(&(bar)[XB_TMO], 1u); break; } } } } while (0)

struct XcdBarrier {
    unsigned* bar; unsigned x;
    volatile LAS unsigned* st;
};

__device__ __forceinline__ XcdBarrier xcd_barrier_post(unsigned* bar, volatile LAS unsigned* st) {
    XcdBarrier b; b.bar = bar; b.x = xb_xcc_id(); b.st = st;
    if (threadIdx.x == 0) (void)xb_add(&bar[XB_XCNT(b.x)], 1u);
    return b;
}
__device__ __forceinline__ void xcd_barrier_complete(unsigned* bar, unsigned x, unsigned& nloc, unsigned& nx) {
    const unsigned G = gridDim.x * gridDim.y * gridDim.z;
    unsigned sum, cnt, mine, sp = 0u;
    for (;;) {
        sum = 0u; cnt = 0u; mine = 0u;
#pragma unroll
        for (unsigned j = 0; j < 16; ++j) { const unsigned c = xb_ld(&bar[XB_XCNT(j)]); sum += c; cnt += (c > 0u) ? 1u : 0u; mine = (j == x) ? c : mine; }
        if (sum == G) break;
        __builtin_amdgcn_s_sleep(1);
        if ((++sp & 255u) == 0u) { if (xb_ld(&bar[XB_TMO])) break; if (sp > XB_SPIN_CAP) { atomicAdd(&bar[XB_TMO], 1u); break; } }
    }
    nloc = mine > 0u ? mine : 1u; nx = cnt > 0u ? cnt : 1u;
}

__device__ __forceinline__ void xcd_barrier(const XcdBarrier& b) {
    asm volatile("s_waitcnt vmcnt(0)" ::: "memory");
    __syncthreads();
    if (threadIdx.x == 0) {
        unsigned* bar = b.bar;
        __builtin_amdgcn_s_waitcnt(0);
        unsigned nloc = b.st[0], nx = b.st[1];
        if (nloc == 0u) { xcd_barrier_complete(bar, b.x, nloc, nx); b.st[0] = nloc; b.st[1] = nx; }
        const unsigned old = xb_add(&bar[XB_XSUB(b.x)], 1u);
        const unsigned gen = old / nloc;
        if (old + 1u == (gen + 1u) * nloc) {
            __builtin_amdgcn_fence(__ATOMIC_RELEASE, "agent");
            asm volatile("s_waitcnt vmcnt(0)" ::: "memory");
            const unsigned og = xb_add(&bar[XB_TOP], 1u);
            const unsigned tg = og / nx;
            if (og + 1u == (tg + 1u) * nx) xb_add(&bar[XB_TOPGEN], 1u);
            else XB_SPIN(xb_ld(&bar[XB_TOPGEN]) == tg, bar);
            __builtin_amdgcn_fence(__ATOMIC_ACQUIRE, "agent");
            xb_add(&bar[XB_XGEN(b.x)], 1u);
            asm volatile("s_waitcnt vmcnt(0)" ::: "memory");
        } else {
            XB_SPIN(xb_ld(&bar[XB_XGEN(b.x)]) == gen, bar);
            __builtin_amdgcn_fence(__ATOMIC_ACQUIRE, "agent");
            asm volatile("s_waitcnt vmcnt(0)" ::: "memory");
        }
    }
    __syncthreads();
}

typedef float f32x16 __attribute__((ext_vector_type(16)));
template <int I> __device__ __forceinline__ const float* karg() {
    const float* p;
    asm volatile("s_load_dwordx2 %0, %1, %2\n\ts_waitcnt lgkmcnt(0)" : "=s"(p) : "s"(__builtin_amdgcn_kernarg_segment_ptr()), "n"(I * 8) : "memory");
    return p;
}
struct Args { const float* in[26]; float* out; unsigned char* ws; int ph_lo, ph_hi; };
struct Frame {
    LAS unsigned char* lds;
    volatile LAS unsigned* MISC;
    gu32* ctl;
    unsigned char* ws;
    int tid, lane, wave, c, G;
    float* out;
};
#define WSP(T, off) ((T*)(F.ws + (off)))
__device__ __forceinline__ float wave_sum(float v) {
#pragma unroll
    for (int o = 1; o < 64; o <<= 1) v += __shfl_xor(v, o);
    return v;
}
__device__ __forceinline__ float bfbits2f(unsigned short s) { return __uint_as_float(((unsigned)s) << 16); }

__device__ __forceinline__ int frag_off(int r, int k) { return (k >> 4) * 512 + ((k >> 3) & 1) * 256 + r * 8 + (k & 7); }
__device__ __forceinline__ int map_swiglu(int c) { return c < FF ? 256 * (c >> 7) + (c & 127) : 256 * ((c - FF) >> 7) + 128 + ((c - FF) & 127); }
__device__ __forceinline__ int map_head(int c) { return (c & ~255) + 128 * ((c >> 5) & 1) + 32 * ((c >> 6) & 3) + (c & 31); }


template <int NPP, int BASE> struct KStream {
    static constexpr int NX = 1;
    unsigned char* ws; int c; bool on;
    int voff, voffe;
    f32x4 b0, b1, b2, b3, acc;
    const float* cur; const float* curB; int stride; float* dst;
    __device__ __forceinline__ void init(unsigned char* ws_, int c_, bool on_, int wave, int lane) {
        ws = ws_; c = c_; on = on_; voff = (wave >> 1) * 32 * 512 + (wave & 1) * 256 + 4 * lane; voffe = voff & 255;
        b0 = (f32x4){0.f, 0.f, 0.f, 0.f}; b1 = b0; b2 = b0; b3 = b0; acc = b0; cur = (const float*)(ws_ + WS_CTL) + CW_ZERO; curB = cur; stride = 0; dst = nullptr; }
    __device__ __forceinline__ void flush() {
        float* d = dst + ((voff >> 8) & 1) * 256 + ((voff & 255) >> 2);
        atomicAdd(d, acc[0]); atomicAdd(d + 64, acc[1]); atomicAdd(d + 128, acc[2]); atomicAdd(d + 192, acc[3]); }
    __device__ __forceinline__ f32x4 xload() const { f32x4 r; asm volatile("s_nop 4\n\tglobal_load_dwordx4 %0, %1, %2 nt" : "=v"(r) : "v"(voffe * 4), "s"(cur) : "memory"); return r; }
    __device__ __forceinline__ void wait() { asm volatile("s_waitcnt vmcnt(10)" : "+v"(b0), "+v"(b1), "+v"(b2), "+v"(b3) :: "memory"); }
    __device__ __forceinline__ void start_a() { b2 = xload(); }
    __device__ __forceinline__ void start() { b3 = xload(); }
    __device__ __forceinline__ void begin_unit(const int ui) {
        if (ui == 0) asm volatile("s_waitcnt vmcnt(0)" : "+v"(b0), "+v"(b1), "+v"(b2), "+v"(b3) :: "memory"); else asm volatile("" : "+v"(b0), "+v"(b1), "+v"(b2), "+v"(b3) :: "memory");
        acc += b0; acc += b1; acc += b2; acc += b3; b0 = (f32x4){0.f, 0.f, 0.f, 0.f}; b1 = b0; b2 = b0; b3 = b0;
        if (dst) flush();
        acc = (f32x4){0.f, 0.f, 0.f, 0.f};
        const int idx = BASE + (ui * 256 + c) * NPP; const float* zero = (const float*)(ws + WS_CTL) + CW_ZERO;
        if (on && idx + NPP <= 2048) { const int* pt = (const int*)karg<8>(); const float* ck = karg<3>();
            const int pa = __builtin_amdgcn_readfirstlane(pt[idx]), pb = __builtin_amdgcn_readfirstlane(pt[idx + NPP - 1]);
            cur = ck + (size_t)pa * (PAGE * 512); curB = ck + (size_t)pb * (PAGE * 512); stride = 512; voffe = voff;
            dst = (float*)(ws + WS_SKSUM) + (size_t)((idx >> 6) * 32 + ((idx & 63) >> 1)) * 512; }
        else { cur = zero; curB = zero; stride = 0; voffe = voff & 255; dst = nullptr; }
    }
    template <int SEL> __device__ __forceinline__ void sp(const int s, const int) {
        acc += SEL == 0 ? b0 : (SEL == 1 ? b1 : (SEL == 2 ? b2 : b3));
        if (NPP == 2) { if (s == 32) cur = curB; }
        if (s == NPP * 32) { cur = (const float*)(ws + WS_CTL) + CW_ZERO; stride = 0; voffe = voff & 255; }
        const f32x4 v = xload(); cur += stride;
        if (SEL == 0) b0 = v; else if (SEL == 1) b1 = v; else if (SEL == 2) b2 = v; else b3 = v;
    }
    __device__ __forceinline__ void finish() { asm volatile("s_waitcnt vmcnt(0)" : "+v"(b0), "+v"(b1), "+v"(b2), "+v"(b3) :: "memory"); acc += b0; acc += b1; acc += b2; acc += b3; if (dst) flush(); dst = nullptr; }
};

__device__ __forceinline__ void p0_transpose_item(const float* W, int K, int N, bf16* WT, int prow0, const float* gain, LAS float* scr, int k0, int n0, int lane) {
    const int r8 = lane >> 3, c4 = lane & 7;
    f32x4 w[8]; float gk[8];
#pragma unroll
    for (int i = 0; i < 8; ++i) { const int kk = 8 * i + r8; w[i] = __builtin_nontemporal_load((const f32x4*)(W + (size_t)(k0 + kk) * N + n0 + 4 * c4)); gk[i] = gain ? gain[k0 + kk] : 1.0f; }
#pragma unroll
    for (int i = 0; i < 8; ++i) { const int kk = 8 * i + r8; LAS float* d = scr + kk * 33 + 4 * c4; d[0] = w[i][0] * gk[i]; d[1] = w[i][1] * gk[i]; d[2] = w[i][2] * gk[i]; d[3] = w[i][3] * gk[i]; }
    LDS_WAIT(); asm volatile("" ::: "memory");
    const int c = lane & 7;
#pragma unroll
    for (int j = 0; j < 4; ++j) { const int n = (lane >> 3) + 8 * j; const LAS float* s = scr + (8 * c) * 33 + n;
        v4u o; o.x = pk2(s[0 * 33], s[1 * 33]); o.y = pk2(s[2 * 33], s[3 * 33]); o.z = pk2(s[4 * 33], s[5 * 33]); o.w = pk2(s[6 * 33], s[7 * 33]);
        *(GAS v4u*)(WT + (size_t)(prow0 + n) * K + k0 + 8 * c) = o; }
    LDS_WAIT(); asm volatile("" ::: "memory");
}
template <int NR> __device__ __forceinline__ void rows_to_bf16(Frame& F, const float* x, bf16* o, float* ssq, const int m0, const int step) {
    f32x4 v[NR][4];
#pragma unroll
    for (int r = 0; r < NR; ++r)
#pragma unroll
        for (int j = 0; j < 4; ++j) v[r][j] = __builtin_nontemporal_load((const f32x4*)(x + (size_t)(m0 + r * step) * DM) + F.lane + 64 * j);
#pragma unroll
    for (int r = 0; r < NR; ++r) { float s = 0.f;
#pragma unroll
        for (int j = 0; j < 4; ++j) s += (v[r][j].x * v[r][j].x + v[r][j].y * v[r][j].y) + (v[r][j].z * v[r][j].z + v[r][j].w * v[r][j].w);
        s = wave_sum(s);
        GAS unsigned long long* o8 = (GAS unsigned long long*)(o + (size_t)(m0 + r * step) * DM) + F.lane;
#pragma unroll
        for (int j = 0; j < 4; ++j) o8[64 * j] = (unsigned long long)pk2(v[r][j].x, v[r][j].y) | ((unsigned long long)pk2(v[r][j].z, v[r][j].w) << 32);
        if (F.lane == 0) ssq[m0 + r * step] = s; }
}
constexpr int CV_A = (DM / 64) * (FF2 / 32), CV_B = (FF / 64) * (DM / 32), CV_IN = (DM / 64) * (INC / 32), CV_OUT = (DM / 64) * (DM / 32), CV_MEM = (DM / 64) * (512 / 32);
constexpr int CV_EARLY = CV_A + CV_MEM, CV_MID = CV_EARLY + CV_A + CV_B + CV_IN + CV_OUT, CV_ALL = CV_MID + CV_B;
__device__ __forceinline__ void convert_items(Frame& F, const int first, const int last, const int w, const int nw) {
    LAS float* scr = (LAS float*)(F.lds + RING_OFF + F.wave * 16384);
    for (int it = first + w; it < last; it += nw) {
        int r = it;
        if (r < CV_A) { const int nblk = FF2 / 32, kb = r / nblk, nb = r % nblk; p0_transpose_item(karg<10>(), DM, FF2, WSP(bf16, WS_W1A), map_swiglu(32 * nb), karg<9>(), scr, 64 * kb, 32 * nb, F.lane); continue; }
        r -= CV_A;
        if (r < CV_MEM) { const int nblk = 512 / 32, kb = r / nblk, nb = r % nblk; p0_transpose_item(karg<19>(), DM, 512, WSP(bf16, WS_WMEM), map_head(32 * nb), karg<18>(), scr, 64 * kb, 32 * nb, F.lane); continue; }
        r -= CV_MEM;
        if (r < CV_A) { const int nblk = FF2 / 32, kb = r / nblk, nb = r % nblk; p0_transpose_item(karg<24>(), DM, FF2, WSP(bf16, WS_W2A), map_swiglu(32 * nb), karg<23>(), scr, 64 * kb, 32 * nb, F.lane); continue; }
        r -= CV_A;
        if (r < CV_B) { const int nblk = DM / 32, kb = r / nblk, nb = r % nblk; p0_transpose_item(karg<11>(), FF, DM, WSP(bf16, WS_W1B), 32 * nb, nullptr, scr, 64 * kb, 32 * nb, F.lane); continue; }
        r -= CV_B;
        if (r < CV_IN) { const int nblk = INC / 32, kb = r / nblk, nb = r % nblk; p0_transpose_item(karg<13>(), DM, INC, WSP(bf16, WS_WIN), map_head(32 * nb), karg<12>(), scr, 64 * kb, 32 * nb, F.lane); continue; }
        r -= CV_IN;
        if (r < CV_OUT) { const int nblk = DM / 32, kb = r / nblk, nb = r % nblk; p0_transpose_item(karg<22>(), DM, DM, WSP(bf16, WS_WOUT), 32 * nb, nullptr, scr, 64 * kb, 32 * nb, F.lane); continue; }
        r -= CV_OUT;
        { const int nblk = DM / 32, kb = r / nblk, nb = r % nblk; p0_transpose_item(karg<25>(), FF, DM, WSP(bf16, WS_W2B), 32 * nb, nullptr, scr, 64 * kb, 32 * nb, F.lane); }
    }
}
__device__ __forceinline__ void p0_prologue(Frame& F) {
    const int gw = F.c * NWAVES + F.wave, NGW = F.G * NWAVES;
    if (F.c < 128) {
        const int* pt = (const int*)karg<8>(); const float* ck = karg<3>(); float* sks = WSP(float, WS_SKSUM);
        const int idx = 1920 + F.c, phys = pt[idx]; const int voff = (F.wave >> 1) * 32 * 512 + (F.wave & 1) * 256 + 4 * F.lane;
        const float* base = ck + (size_t)phys * (PAGE * 512) + voff; f32x4 a = {0.f, 0.f, 0.f, 0.f};
#pragma unroll 16
        for (int r = 0; r < 32; ++r) a += __builtin_nontemporal_load((const f32x4*)(base + (size_t)r * 512));
        float* d = sks + (size_t)((idx >> 6) * 32 + ((idx & 63) >> 1)) * 512 + (F.wave & 1) * 256 + F.lane;
        atomicAdd(d, a[0]); atomicAdd(d + 64, a[1]); atomicAdd(d + 128, a[2]); atomicAdd(d + 192, a[3]);
    }
    convert_items(F, 0, CV_EARLY, gw, NGW);
    { const float* xin_ = karg<0>(); const float* min_ = karg<2>();
    for (int m = gw; m + 3 * NGW < MP; m += 4 * NGW) rows_to_bf16<4>(F, xin_, WSP(bf16, WS_XB), WSP(float, WS_SSQ0), m, NGW);
    for (int m = gw; m < MM; m += NGW) rows_to_bf16<1>(F, min_, WSP(bf16, WS_MNB), WSP(float, WS_SSQ0) + MP, m, NGW); }
    if (F.c == 0 && F.tid < 256) { const int w = F.tid >> 6, d = F.tid & 63; const float* src = w == 0 ? karg<16>() : (w == 1 ? karg<17>() : (w == 2 ? karg<20>() : karg<21>())); WSP(float, WS_GAIN)[F.tid] = src[d]; }
    if (F.c == 255) { const float* xs = karg<1>(); bf16* img = WSP(bf16, S_IMGX); float* sq = (float*)(F.ws + WS_CTL) + CW_SSQS;
#pragma unroll
        for (int i = 0; i < 4; ++i) { const int r = F.wave * 4 + i; float ss = 0.f;
#pragma unroll
            for (int j = 0; j < 4; ++j) { const int k = j * 256 + 4 * F.lane; const f32x4 v = *(const f32x4*)(xs + r * DM + k); ss += (v.x * v.x + v.y * v.y) + (v.z * v.z + v.w * v.w);
                *(unsigned long long*)(img + frag_off(r, k)) = (unsigned long long)pk2(v.x, v.y) | ((unsigned long long)pk2(v.z, v.w) << 32); }
            ss = wave_sum(ss); if (F.lane == 0) sq[r] = ss; } }
    for (int i = F.c * 512 + F.tid; i < (SEQ + 1) * 8; i += F.G * 512) { const int p = i >> 3, f = i & 7; const float pos = (p == SEQ) ? (float)PAST : (float)p;
        const float inv = powf(500000.0f, -(float)f * 0.125f); const float ang = pos * inv;
        const double kk = rint((double)ang * 0.15915494309189535); const float rr = (float)((double)ang - kk * 6.283185307179586);
        float* rp = WSP(float, WS_ROPE) + (size_t)i * 2; rp[0] = cosf(rr); rp[1] = sinf(rr); }
}

template <int UNR, class AL, class BR, class EP>
__device__ __forceinline__ void sgemm_unit(Frame& F, const AL& al, const BR& br, const bf16* Bt, const int K, const EP& ep) {
    LAS float* red = (LAS float*)(F.lds + RING_OFF);
    LAS unsigned char* bbuf = F.lds + RING_OFF + F.wave * 16384;
    const int r32 = F.lane & 31, hi = F.lane >> 5, nch = K >> 6, c0 = (nch * F.wave) >> 3, c1 = (nch * (F.wave + 1)) >> 3;
    f32x16 acc0 = {}, acc1 = {};
    const int srow = F.lane >> 3, spc = F.lane & 7;
    const bf16* gsrc[8];
#pragma unroll
    for (int i = 0; i < 8; ++i) { const int row = 8 * i + srow; gsrc[i] = Bt + (size_t)br(row >> 5, row & 31) * K + spc * 8; }
    v4u stg[8];
#pragma unroll
    for (int i = 0; i < 8; ++i) stg[i] = *(const v4u*)(gsrc[i] + c0 * 64);
    for (int c = c0; c < c1; ++c) {
        bf16x8 a[4];
#pragma unroll
        for (int st = 0; st < 4; ++st) a[st] = al(r32, c * 64 + st * 16 + 8 * hi);
#pragma unroll
        for (int i = 0; i < 8; ++i) *(LAS v4u*)(bbuf + (8 * i + srow) * 144 + spc * 16) = stg[i];
        if (c + 1 < c1) {
#pragma unroll
            for (int i = 0; i < 8; ++i) stg[i] = *(const v4u*)(gsrc[i] + (c + 1) * 64); }
#pragma unroll
        for (int st = 0; st < 4; ++st) { const bf16x8 b0 = *(const LAS bf16x8*)(bbuf + r32 * 144 + st * 32 + hi * 16), b1 = *(const LAS bf16x8*)(bbuf + (32 + r32) * 144 + st * 32 + hi * 16);
            acc0 = __builtin_amdgcn_mfma_f32_32x32x16_bf16(a[st], b0, acc0, 0, 0, 0); acc1 = __builtin_amdgcn_mfma_f32_32x32x16_bf16(a[st], b1, acc1, 0, 0, 0); }
    }
    __syncthreads();
#pragma unroll
    for (int r = 0; r < 16; ++r) { const int row = (r & 3) + 8 * (r >> 2) + 4 * hi; red[(F.wave * 32 + row) * 64 + r32] = acc0[r]; red[(F.wave * 32 + row) * 64 + 32 + r32] = acc1[r]; }
    __syncthreads();
    const int row = F.tid >> 4, c4 = (F.tid & 15) * 4; f32x4 s = {0.f, 0.f, 0.f, 0.f};
#pragma unroll
    for (int w = 0; w < 8; ++w) s += *(const LAS f32x4*)(red + (w * 32 + row) * 64 + c4);
    ep(row, c4, s);
    __syncthreads();
}
__device__ __forceinline__ bf16x8 pack_bf16x8(const f32x4 a, const f32x4 b) { v4u w; w.x = pk2(a[0], a[1]); w.y = pk2(a[2], a[3]); w.z = pk2(b[0], b[1]); w.w = pk2(b[2], b[3]); return __builtin_bit_cast(bf16x8, w); }
struct ALLds { const LAS bf16* img;
    __device__ __forceinline__ bf16x8 operator()(int r, int k) const { return *(const LAS bf16x8*)(img + frag_off(r, k)); } };
struct ALFrag { const bf16* img;
    __device__ __forceinline__ bf16x8 operator()(int r, int k) const { return *(const bf16x8*)(img + frag_off(r, k)); } };
__device__ __forceinline__ void stage_a_lds(Frame& F, const float* x, const int ld, const LAS float* rs, LAS bf16* img) {
    f32x4 v[16];
#pragma unroll
    for (int j = 0; j < 16; ++j) { const int idx = F.tid + 512 * j, r = idx >> 8, k4 = (idx & 255) * 4; v[j] = *(const f32x4*)(x + r * ld + k4); }
#pragma unroll
    for (int j = 0; j < 16; ++j) { const int idx = F.tid + 512 * j, r = idx >> 8, k4 = (idx & 255) * 4; const float sc = rs ? rs[r] : 1.0f;
        *(LAS unsigned long long*)(img + frag_off(r, k4)) = (unsigned long long)pk2(v[j].x * sc, v[j].y * sc) | ((unsigned long long)pk2(v[j].z * sc, v[j].w * sc) << 32); }
    __syncthreads();
}
__device__ __forceinline__ void sample_rs(Frame& F, const float* x, LAS float* rs) {
#pragma unroll
    for (int i = 0; i < 4; ++i) { const int r = F.wave * 4 + i; float s = 0.f;
#pragma unroll
        for (int j = 0; j < 4; ++j) { const f32x4 v = *(const f32x4*)(x + r * DM + j * 256 + 4 * F.lane); s += (v.x * v.x + v.y * v.y) + (v.z * v.z + v.w * v.w); }
        s = wave_sum(s); if (F.lane == 0) rs[r] = 1.0f / sqrtf(s * (1.0f / DM) + RMS_EPS); }
    __syncthreads();
}
struct BRSwiglu { int v; __device__ __forceinline__ int operator()(int cb, int c) const { return 256 * (v >> 2) + 32 * (v & 3) + 128 * cb + c; } };
struct BRPlain { int v; __device__ __forceinline__ int operator()(int cb, int c) const { return 64 * v + 32 * cb + c; } };
struct BRHead { int v; __device__ __forceinline__ int operator()(int cb, int c) const { return 256 * (v >> 2) + 128 * cb + 32 * (v & 3) + c; } };
struct EPSwigluFrag { bf16* img; int v; const float* ssq;
    __device__ __forceinline__ void operator()(int row, int c4, f32x4 s) const {
        s = s * (1.0f / sqrtf(ssq[row] * (1.0f / DM) + RMS_EPS));
        f32x4 u; u.x = __shfl_xor(s.x, 8); u.y = __shfl_xor(s.y, 8); u.z = __shfl_xor(s.z, 8); u.w = __shfl_xor(s.w, 8);
        if (c4 < 32) { const int k = 32 * v + c4;
            *(unsigned long long*)(img + frag_off(row, k)) = (unsigned long long)pk2(pg8::silu_f(s.x) * u.x, pg8::silu_f(s.y) * u.y) | ((unsigned long long)pk2(pg8::silu_f(s.z) * u.z, pg8::silu_f(s.w) * u.w) << 32); } } };
template <int KIND> struct EPResid { unsigned char* ws; float* outp; const float* xs; int v;
    __device__ __forceinline__ void operator()(int row, int c4, f32x4 s) const { const int o = row * DM + 64 * v + c4;
        const float* base = KIND == 2 ? xs : (const float*)(ws + (KIND == 5 ? S_X1 : S_X2)); float* out = KIND == 2 ? (float*)(ws + S_X1) : (KIND == 5 ? (float*)(ws + S_X2) : outp + O_YS);
        const float alpha = KIND == 5 ? 1.0f : 0.5f;
        const f32x4 r = *(const f32x4*)(base + o) + alpha * s; *(f32x4*)(out + o) = r;
        if (KIND != 7) { bf16* img = (bf16*)(ws + (KIND == 2 ? S_IMGX1 : S_IMGX2)); float* ssq = (float*)(ws + WS_CTL) + CW_SSQS + (KIND == 2 ? 32 : 64);
            *(unsigned long long*)(img + frag_off(row, 64 * v + c4)) = (unsigned long long)pk2(r.x, r.y) | ((unsigned long long)pk2(r.z, r.w) << 32);
            float ss = (r.x * r.x + r.y * r.y) + (r.z * r.z + r.w * r.w); ss += __shfl_xor(ss, 1); ss += __shfl_xor(ss, 2); ss += __shfl_xor(ss, 4); ss += __shfl_xor(ss, 8);
            if ((c4 >> 2) == 0) atomicAdd(ssq + row, ss); } } };
struct EPProjS { int v; unsigned char* ws; float* outp; const float* ssq;
    __device__ __forceinline__ void operator()(int row, int c4, f32x4 s) const {
        s = s * (1.0f / sqrtf(ssq[row] * (1.0f / DM) + RMS_EPS));
        if (v < 4) { *(f32x4*)((float*)(ws + S_U) + row * 256 + 64 * v + c4) = s; return; }
        if (v >= 20 && v < 28) { *(f32x4*)(outp + O_VS + row * 512 + 64 * (v - 20) + c4) = s; return; }
        float ss = (s.x * s.x + s.y * s.y) + (s.z * s.z + s.w * s.w);
        ss += __shfl_xor(ss, 1); ss += __shfl_xor(ss, 2); ss += __shfl_xor(ss, 4); ss += __shfl_xor(ss, 8);
        const float hn = 1.0f / sqrtf(ss * (1.0f / 64.0f) + RMS_EPS);
        const float* g = (const float*)(ws + WS_GAIN) + ((v < 12) ? 0 : (v < 20 ? 64 : 128));
        const f32x4 gv = *(const f32x4*)(g + c4); s = s * hn * gv;
        if (v < 20) {
            const float* rope8192 = (const float*)(ws + WS_ROPE) + SEQ * 16;
            f32x4 y; y.x = __shfl_xor(s.x, 2); y.y = __shfl_xor(s.y, 2); y.z = __shfl_xor(s.z, 2); y.w = __shfl_xor(s.w, 2);
            if (c4 < 16) { const int f0 = c4 & 7; const float sg = (c4 < 8) ? -1.f : 1.f; f32x4 r_;
#pragma unroll
                for (int i = 0; i < 4; ++i) { const float cs_ = rope8192[2 * (f0 + i)], sn = rope8192[2 * (f0 + i) + 1]; r_[i] = s[i] * cs_ + sg * y[i] * sn; }
                s = r_; }
        }
        if (v < 12) *(f32x4*)((float*)(ws + S_Q) + row * 512 + 64 * (v - 4) + c4) = s;
        else if (v < 20) *(f32x4*)(outp + O_KS + row * 512 + 64 * (v - 12) + c4) = s;
        else *(f32x4*)((float*)(ws + S_QM) + row * 256 + 64 * (v - 28) + c4) = s;
    } };

__device__ __forceinline__ void pool_unit(Frame& F, const int pm, const int g) {
    const bf16* U = WSP(bf16, WS_U); bf16* MIX = WSP(bf16, WS_MIX); const float* pw = karg<14>() + g * 4096; const float* psc = karg<15>() + 64 * g;
    const int r32 = F.lane & 31, hi = F.lane >> 5, row = pm * 256 + F.wave * 32 + r32, t = row & (SEQ - 1), W = 2 << g;
    const int cnt = (t + 1 < W) ? t + 1 : W; const float rc = 1.0f / (float)cnt;
    bf16x8 bfr[4][2];
#pragma unroll
    for (int s = 0; s < 4; ++s)
#pragma unroll
        for (int cb = 0; cb < 2; ++cb) { float w[8];
#pragma unroll
            for (int j = 0; j < 8; ++j) w[j] = pw[(16 * s + 8 * hi + j) * 64 + 32 * cb + r32];
            v4u p; p.x = pk2(w[0], w[1]); p.y = pk2(w[2], w[3]); p.z = pk2(w[4], w[5]); p.w = pk2(w[6], w[7]); bfr[s][cb] = __builtin_bit_cast(bf16x8, p); }
    f32x16 acc0 = {}, acc1 = {};
#pragma unroll
    for (int s = 0; s < 4; ++s) { const bf16* up = U + (size_t)row * 256 + 64 * g + 16 * s + 8 * hi;
        bf16x8 xw[16];
#pragma unroll
        for (int i = 0; i < 16; ++i) if (i < W) xw[i] = *(const bf16x8*)(up - (size_t)((i < cnt) ? i : 0) * 256);
        float sum[8], self[8];
#pragma unroll
        for (int j = 0; j < 8; ++j) { self[j] = bfbits2f((unsigned short)xw[0][j]); sum[j] = self[j]; }
#pragma unroll
        for (int i = 1; i < 16; ++i) if (i < W) { const float wgt = (i < cnt) ? 1.f : 0.f;
#pragma unroll
            for (int j = 0; j < 8; ++j) sum[j] += wgt * bfbits2f((unsigned short)xw[i][j]); }
        v4u p;
        p.x = pk2(sum[0] * rc - self[0], sum[1] * rc - self[1]); p.y = pk2(sum[2] * rc - self[2], sum[3] * rc - self[3]); p.z = pk2(sum[4] * rc - self[4], sum[5] * rc - self[5]); p.w = pk2(sum[6] * rc - self[6], sum[7] * rc - self[7]);
        const bf16x8 a = __builtin_bit_cast(bf16x8, p);
        acc0 = __builtin_amdgcn_mfma_f32_32x32x16_bf16(a, bfr[s][0], acc0, 0, 0, 0); acc1 = __builtin_amdgcn_mfma_f32_32x32x16_bf16(a, bfr[s][1], acc1, 0, 0, 0); }
    const float sc0 = psc[r32], sc1 = psc[32 + r32];
    bf16* ob = MIX + (size_t)(pm * 256 + F.wave * 32) * DM + 64 * g;
#pragma unroll
    for (int r = 0; r < 16; ++r) { const int orow = (r & 3) + 8 * (r >> 2) + 4 * hi; ob[(size_t)orow * DM + r32] = (bf16)f2bf(acc0[r] * sc0); ob[(size_t)orow * DM + 32 + r32] = (bf16)f2bf(acc1[r] * sc1); }
}

template <int PER, int CH, class KPF, class VPF>
__device__ __forceinline__ void dec_attn(Frame& F, const float* q, const KPF& KP, const VPF& VP, const float* xk, const float* xv, float* outp, bf16* imgp, const int irow, const int icol) {
    LAS float* st = (LAS float*)(F.lds + RING_OFF);
    const int l16 = F.lane & 15, grp = F.wave * 4 + (F.lane >> 4);
    f32x4 q4 = *(const f32x4*)(q + 4 * l16); q4 = q4 * C2;
    float m = -INFINITY, l = 0.f; f32x4 o = {0.f, 0.f, 0.f, 0.f};
#pragma unroll
    for (int c0 = 0; c0 < PER; c0 += CH) {
        f32x4 kv[CH], vv[CH]; float d[CH];
#pragma unroll
        for (int it = 0; it < CH; ++it) { const int i = grp * PER + c0 + it; kv[it] = *(const f32x4*)(KP(i) + 4 * l16); vv[it] = *(const f32x4*)(VP(i) + 4 * l16); }
        float mc = -INFINITY;
#pragma unroll
        for (int it = 0; it < CH; ++it) { float x = (q4.x * kv[it].x + q4.y * kv[it].y) + (q4.z * kv[it].z + q4.w * kv[it].w);
            x += __shfl_xor(x, 1); x += __shfl_xor(x, 2); x += __shfl_xor(x, 4); x += __shfl_xor(x, 8); d[it] = x; mc = fmaxf(mc, x); }
        const float mn = fmaxf(m, mc), f = __builtin_amdgcn_exp2f(m - mn); l *= f; o = o * f; m = mn;
#pragma unroll
        for (int it = 0; it < CH; ++it) { const float p = __builtin_amdgcn_exp2f(d[it] - mn); l += p; o = o + p * vv[it]; }
    }
    if (l16 == 0) { st[grp * 68] = m; st[grp * 68 + 1] = l; }
    *(LAS f32x4*)(st + grp * 68 + 4 + 4 * l16) = o;
    if (F.wave == 0 && F.lane < 16) {
        if (xk) { const f32x4 kx = *(const f32x4*)(xk + 4 * l16); float x = (q4.x * kx.x + q4.y * kx.y) + (q4.z * kx.z + q4.w * kx.w);
            x += __shfl_xor(x, 1); x += __shfl_xor(x, 2); x += __shfl_xor(x, 4); x += __shfl_xor(x, 8);
            if (l16 == 0) { st[32 * 68] = x; st[32 * 68 + 1] = 1.f; } *(LAS f32x4*)(st + 32 * 68 + 4 + 4 * l16) = *(const f32x4*)(xv + 4 * l16); }
        else { if (l16 == 0) { st[32 * 68] = -INFINITY; st[32 * 68 + 1] = 0.f; } *(LAS f32x4*)(st + 32 * 68 + 4 + 4 * l16) = (f32x4){0.f, 0.f, 0.f, 0.f}; }
    }
    __syncthreads();
    if (F.tid < 64) { float M = -INFINITY;
#pragma unroll
        for (int i = 0; i < 33; ++i) M = fmaxf(M, st[i * 68]);
        float L = 0.f, O = 0.f;
#pragma unroll
        for (int i = 0; i < 33; ++i) { const float e = __builtin_amdgcn_exp2f(st[i * 68] - M); L += st[i * 68 + 1] * e; O += st[i * 68 + 4 + F.tid] * e; }
        outp[F.tid] = O / L; if (imgp) imgp[frag_off(irow, icol + F.tid)] = (bf16)f2bf(O / L); }
    __syncthreads();
}
struct KPaged { const float* base; unsigned long long pa; unsigned pb; int hoff;
    __device__ __forceinline__ const float* operator()(int i) const { const int sl = i >> 7; const unsigned long long w = sl < 4 ? pa : (unsigned long long)pb; const unsigned page = (unsigned)(w >> (16 * (sl & 3))) & 0xffffu; return base + ((size_t)page * PAGE + (i & 127)) * 512 + hoff; } };
struct KLin { const float* base; int ld; __device__ __forceinline__ const float* operator()(int i) const { return base + (size_t)i * ld; } };

__device__ __forceinline__ void sample_item(Frame& F, const int item) {
    float* smix = WSP(float, S_MIX);
    if (item < 256) {
        const int b = item >> 3, h = item & 7; const float* q = WSP(float, S_Q) + b * 512 + h * 64;
        const int myp = ((const int*)karg<8>())[b * NPG + F.lane];
        const int j = F.lane & 31, hh = F.lane >> 5; float sc = 0.f;
        { const float* sj = WSP(float, WS_SKSUM) + ((size_t)b * 32 + j) * 512 + (h >> 2) * 256 + ((h & 3) * 64 + 32 * hh) / 4;
#pragma unroll
          for (int jj = 0; jj < 4; ++jj) { const f32x4 k0 = *(const f32x4*)(sj + 64 * jj), k1 = *(const f32x4*)(sj + 64 * jj + 4);
            sc += (q[32 * hh + jj] * k0[0] + q[32 * hh + jj + 4] * k0[1]) + (q[32 * hh + jj + 8] * k0[2] + q[32 * hh + jj + 12] * k0[3]) + (q[32 * hh + jj + 16] * k1[0] + q[32 * hh + jj + 20] * k1[1]) + (q[32 * hh + jj + 24] * k1[2] + q[32 * hh + jj + 28] * k1[3]); } }
        sc += __shfl_xor(sc, 32);
        int cntb = 0;
        for (int i = 0; i < 32; ++i) { const float o = __shfl(sc, i); cntb += ((o > sc) || (o == sc && i < j)) ? 1 : 0; }
        const unsigned long long bal = __ballot(cntb < 3 && F.lane < 32);
        const unsigned msk = (unsigned)bal; const int b0 = __builtin_ctz(msk), b1 = __builtin_ctz(msk & (msk - 1)), b2 = __builtin_ctz(msk & (msk - 1) & ((msk & (msk - 1)) - 1));
        const unsigned g0 = (unsigned)__shfl(myp, 2 * b0), g1 = (unsigned)__shfl(myp, 2 * b0 + 1), g2 = (unsigned)__shfl(myp, 2 * b1), g3 = (unsigned)__shfl(myp, 2 * b1 + 1), g4 = (unsigned)__shfl(myp, 2 * b2), g5 = (unsigned)__shfl(myp, 2 * b2 + 1);
        const unsigned long long pa_ = (unsigned long long)g0 | ((unsigned long long)g1 << 16) | ((unsigned long long)g2 << 32) | ((unsigned long long)g3 << 48); const unsigned pb_ = g4 | (g5 << 16);
        const KPaged KPf{karg<3>(), pa_, pb_, h * 64}, VPf{karg<4>(), pa_, pb_, h * 64};
        dec_attn<24, 24>(F, q, KPf, VPf, F.out + O_KS + b * 512 + h * 64, F.out + O_VS + b * 512 + h * 64, smix + b * DM + 256 + h * 64, WSP(bf16, S_IMGMIX), b, 256 + h * 64);
    } else if (item < 384) {
        const int b = (item - 256) >> 2, h = (item - 256) & 3; const float* q = WSP(float, S_QM) + b * 256 + h * 64;
        const KLin KPf{karg<5>() + (size_t)b * MEML * 256 + h * 64, 256}, VPf{karg<6>() + (size_t)b * MEML * 256 + h * 64, 256};
        dec_attn<8, 8>(F, q, KPf, VPf, nullptr, nullptr, smix + b * DM + 768 + h * 64, WSP(bf16, S_IMGMIX), b, 768 + h * 64);
    } else if (item < 416) {
        const int b = item - 384; LAS float* pl = (LAS float*)(F.lds + RING_OFF);
        const float* stp = karg<7>() + (size_t)b * 15 * 256; const float* su = WSP(float, S_U) + b * 256; float* pso = F.out + O_PSS + (size_t)b * 15 * 256;
        if (F.tid < 256) { const int c = F.tid, g = c >> 6, W = 2 << g; const float u = su[c]; float s = u;
            float wv[15];
#pragma unroll
            for (int i = 1; i < 16; ++i) wv[i - 1] = stp[(15 - i) * 256 + c];
#pragma unroll
            for (int i = 1; i < 16; ++i) s += (i < W) ? wv[i - 1] : 0.f;
            pl[c] = s / (float)W - u;
            for (int i = 0; i < 14; ++i) pso[i * 256 + c] = stp[(i + 1) * 256 + c];
            pso[14 * 256 + c] = u; }
        __syncthreads();
        if (F.tid < 256) { const int c = F.tid, g = c >> 6, d = c & 63; const float* pw = karg<14>() + g * 4096; float a = 0.f;
#pragma unroll
            for (int cc = 0; cc < 64; ++cc) a += pl[64 * g + cc] * pw[cc * 64 + d];
            const float y_ = a * karg<15>()[c]; smix[b * DM + c] = y_; WSP(bf16, S_IMGMIX)[frag_off(b, c)] = (bf16)f2bf(y_); }
        __syncthreads();
    }
}

__global__ void __launch_bounds__(NWAVES * 64, 2) hymba_fwd(Args args) {
    extern __shared__ __attribute__((aligned(16))) unsigned char lds[];
    Frame F;
    F.lds = (LAS unsigned char*)lds;
    F.MISC = (volatile LAS unsigned*)(F.lds + MISC_OFF);
    F.tid = threadIdx.x; F.lane = F.tid & 63; F.wave = __builtin_amdgcn_readfirstlane(F.tid >> 6);
    F.G = gridDim.x; F.c = blockIdx.x;
    F.ws = args.ws; F.ctl = (gu32*)(args.ws + WS_CTL); F.out = args.out;
    for (int u = F.tid; u < (LDS_BYTES - LDSCTL_OFF) / 4; u += NWAVES * 64) ((LAS unsigned*)(F.lds + LDSCTL_OFF))[u] = 0u;
    __syncthreads();
    XcdBarrier bar; bar.bar = (unsigned*)(F.ctl + CW_BAR); bar.x = 0; bar.st = nullptr;
    if (N_LAUNCHES == 1) bar = xcd_barrier_post((unsigned*)(F.ctl + CW_BAR), F.MISC + 8);
#define GRID_BAR() do { if (N_LAUNCHES == 1) xcd_barrier(bar); } while (0)
    const int lo = args.ph_lo, hi = args.ph_hi;
    pg8::NoStream nostream;
#ifdef DBG_ONLY
#define IN(k) ((k) == DBG_ONLY && lo <= (k) && (k) < hi)
#else
#define IN(k) (lo <= (k) && (k) < hi)
#endif
#define rs ((LAS float*)(F.lds + SM_OFF))
#define ssq1 ((float*)(F.ws + WS_CTL) + CW_SSQ1)
#define ssq2 ((float*)(F.ws + WS_CTL) + CW_SSQ2)
#define ksum ((float*)(F.ws + WS_CTL) + CW_KSUM)
#define ssq0 WSP(float, WS_SSQ0)

#define FRESH() do { int t2_ = threadIdx.x, c2_ = blockIdx.x; asm volatile("" : "+v"(t2_)); asm volatile("" : "+s"(c2_)); F.tid = t2_; F.lane = t2_ & 63; F.wave = __builtin_amdgcn_readfirstlane(t2_ >> 6); F.c = c2_; \
        unsigned char* w2_ = args.ws; float* o2_ = args.out; asm volatile("" : "+s"(w2_)); asm volatile("" : "+s"(o2_)); F.ws = w2_; F.out = o2_; F.ctl = (gu32*)(w2_ + WS_CTL); } while (0)
    if (IN(0)) for (int rep_ = 0; rep_ < REP0; ++rep_) { FRESH(); p0_prologue(F); GRID_BAR(); }

    if (IN(1)) for (int rep_ = 0; rep_ < REP1; ++rep_) { FRESH();
        { pg8::Gemm g{WSP(bf16, WS_XB), WSP(bf16, WS_W1A), MP, FF2, DM}; pg8::StaticOrder S; S.init(MP, FF2, F.G, F.c);
          pg8::EpiSwiglu<false> E{WSP(bf16, WS_H), ssq0, FF, {}};
          KStream<1, 0> X; X.init(F.ws, F.c, !(rep_ + 1 < REP1), F.wave, F.lane);
          pg8::gemm_phase<pg8::EpiSwiglu<false>, pg8::StaticOrder, true, true, KStream<1, 0>>(F.lds + RING_OFF, g, S, E, X); }
        if (F.c >= 128 && F.c < 144) { pg8::Gemm g{WSP(bf16, WS_MNB), WSP(bf16, WS_WMEM), MM, 512, DM}; pg8::ListOrder S; S.init(MM / 256, 2, 128, F.c);
          pg8::EpiHead<true> E{ssq0 + MP, nullptr, F.out, nullptr, F.ws, C2};
          pg8::gemm_phase<pg8::EpiHead<true>, pg8::ListOrder, true, true>(F.lds + RING_OFF, g, S, E, nostream); }
        FRESH();
        if (F.c >= 144 && rep_ + 1 == REP1) { convert_items(F, CV_EARLY, CV_MID, (F.c - 144) * NWAVES + F.wave, (256 - 144) * NWAVES); __syncthreads(); }
        if (F.c >= 144 && F.c < 144 + 88) { const int v = F.c - 144;
          sgemm_unit<8>(F, ALFrag{WSP(bf16, S_IMGX)}, BRSwiglu{v}, WSP(bf16, WS_W1A), DM, EPSwigluFrag{WSP(bf16, S_H), v, (const float*)(F.ws + WS_CTL) + CW_SSQS}); }
        GRID_BAR();
    }
    if (IN(2)) for (int rep_ = 0; rep_ < REP2; ++rep_) { FRESH();
        { pg8::Gemm g{WSP(bf16, WS_H), WSP(bf16, WS_W1B), MP, DM, FF}; pg8::StaticOrder S; S.init(MP, DM, F.G, F.c);
          const bool dm_ = (rep_ + 1 < REP2); pg8::EpiResid<1, 2> E{WSP(bf16, WS_XB), dm_ ? WSP(bf16, WS_DUMMY + 64 * MiB) : WSP(bf16, WS_XB), nullptr, dm_ ? WSP(float, WS_DUMMY + 96 * MiB) : ssq1, 0.5f};
          KStream<2, 1408> X; X.init(F.ws, F.c, !(rep_ + 1 < REP2), F.wave, F.lane);
          pg8::gemm_phase<pg8::EpiResid<1, 2>, pg8::StaticOrder, true, true, KStream<2, 1408>>(F.lds + RING_OFF, g, S, E, X); }
        if (F.c >= 240) { const int v = F.c - 240; sgemm_unit<11>(F, ALFrag{WSP(bf16, S_H)}, BRPlain{v}, WSP(bf16, WS_W1B), FF, EPResid<2>{F.ws, F.out, karg<1>(), v}); }
        GRID_BAR();
    }
    if (IN(3)) for (int rep_ = 0; rep_ < REP3; ++rep_) { FRESH();
        { pg8::Gemm g{WSP(bf16, WS_XB), WSP(bf16, WS_WIN), MP, INC, DM}; pg8::StaticOrder S; S.init(MP, INC, F.G, F.c);
          pg8::EpiHead<false> E{ssq1, WSP(float, WS_ROPE), F.out, (rep_ + 1 < REP3) ? WSP(float, WS_DUMMY + 96 * MiB) : ksum, F.ws, C2};
          pg8::gemm_phase<pg8::EpiHead<false>, pg8::StaticOrder, true, true>(F.lds + RING_OFF, g, S, E, nostream); }
        if (F.c >= 224) { const int v = F.c - 224;
          sgemm_unit<8>(F, ALFrag{WSP(bf16, S_IMGX1)}, BRHead{v}, WSP(bf16, WS_WIN), DM,
                     EPProjS{v, F.ws, F.out, (const float*)(F.ws + WS_CTL) + CW_SSQS + 32}); }
        GRID_BAR();
    }
#ifndef DBG_P4
#define DBG_P4 15
#endif
    if (IN(4)) for (int rep_ = 0; rep_ < REP4; ++rep_) { FRESH();
        if ((DBG_P4 & 8) && ((F.c >> 3) & 3) == 0) { sample_item(F, F.c); if (F.c + 256 < 416) sample_item(F, F.c + 256); }
        FRESH();
        using attn_body::bf16; char* shm = (char*)lds + RING_OFF;
        if (DBG_P4 & 1) { const int bh = F.c >> 2, s = F.c & 3, b = bh >> 3, h = bh & 7;
          const bf16* Qb = (const bf16*)WSP(unsigned short, WS_Q) + (size_t)b * SEQ * 512 + h * 64; const bf16* Kb = (const bf16*)WSP(unsigned short, WS_K) + (size_t)b * SEQ * 512 + h * 64;
          const bf16* Vb = (const bf16*)WSP(unsigned short, WS_V) + (size_t)b * SEQ * 512 + h * 64; bf16* Ob = (bf16*)WSP(unsigned short, WS_MIX) + (size_t)b * SEQ * DM + 256 + h * 64;
          const float* ks = ksum + (size_t)b * 8 * 512 + h * 64;
          LAS unsigned char* selt = (LAS unsigned char*)(F.lds + SM_OFF + 512);
          { const int which = F.tid >> 8, qi = F.tid & 255, qb = which == 0 ? 7 - s : s; unsigned sel = 0x7fu;
            LAS float* ksl = (LAS float*)(F.lds + RING_OFF);
            if (F.tid < 448) ksl[F.tid] = ks[(F.tid >> 6) * 512 + (F.tid & 63)];
            __syncthreads();
            if (qb >= 4) { float sc[7]; float qf[64];
              { const unsigned short* qp = WSP(unsigned short, WS_Q) + ((size_t)b * SEQ + qb * 256 + qi) * 512 + h * 64;
#pragma unroll
                for (int d8 = 0; d8 < 8; ++d8) { const bf16x8 x = *(const bf16x8*)(qp + 8 * d8);
#pragma unroll
                  for (int e = 0; e < 8; ++e) qf[8 * d8 + e] = bfbits2f((unsigned short)x[e]); } }
#pragma unroll
              for (int j = 0; j < 7; ++j) { float a = 0.f; if (j < qb) {
#pragma unroll
                  for (int d4 = 0; d4 < 16; ++d4) { const f32x4 kv = *(const LAS f32x4*)(ksl + j * 64 + 4 * d4); a += (qf[4 * d4] * kv[0] + qf[4 * d4 + 1] * kv[1]) + (qf[4 * d4 + 2] * kv[2] + qf[4 * d4 + 3] * kv[3]); } } else a = -INFINITY;
                sc[j] = a; asm volatile("" : "+v"(a) :: "memory"); }
              sel = 0u;
#pragma unroll
              for (int j = 0; j < 7; ++j) { int cnt = 0;
#pragma unroll
                for (int i = 0; i < 7; ++i) { if (i != j) cnt += ((sc[i] > sc[j]) || (sc[i] == sc[j] && i < j)) ? 1 : 0; }
                if (j < qb && cnt < 3) sel |= (1u << j); } }
            selt[F.tid] = (unsigned char)sel; }
          __syncthreads();
          { const int qb = 7 - s; attn_body::attn_unit<8, 1, 512, 512, DM>(Qb + (size_t)qb * 256 * 512, Kb, Vb, Ob + (size_t)qb * 256 * DM, 4 * qb + 4, selt, shm); }
          { const int qb = s;     attn_body::attn_unit<8, 1, 512, 512, DM>(Qb + (size_t)qb * 256 * 512, Kb, Vb, Ob + (size_t)qb * 256 * DM, 4 * qb + 4, selt + 256, shm); } }
        FRESH();
        if ((DBG_P4 & 8) && ((F.c >> 3) & 3) == 1) { sample_item(F, F.c); if (F.c + 256 < 416) sample_item(F, F.c + 256); }
        FRESH();
        if (DBG_P4 & 2) { const int b = F.c >> 5, hm = (F.c >> 3) & 3, qb = F.c & 7;
          const bf16* Qb = (const bf16*)WSP(unsigned short, WS_QM) + ((size_t)b * SEQ + qb * 256) * 256 + hm * 64; const bf16* Kb = (const bf16*)WSP(unsigned short, WS_MKB) + (size_t)b * MEML * 256 + hm * 64;
          const bf16* Vb = (const bf16*)WSP(unsigned short, WS_MVB) + (size_t)b * MEML * 256 + hm * 64; bf16* Ob = (bf16*)WSP(unsigned short, WS_MIX) + ((size_t)b * SEQ + qb * 256) * DM + 768 + hm * 64;
          attn_body::attn_unit<8, 0, 256, 256, DM>(Qb, Kb, Vb, Ob, 4, nullptr, shm); }
        if ((DBG_P4 & 8) && ((F.c >> 3) & 3) == 2) { sample_item(F, F.c); if (F.c + 256 < 416) sample_item(F, F.c + 256); }
        FRESH();
        if (DBG_P4 & 4) pool_unit(F, F.c >> 2, F.c & 3);
        __syncthreads();
        const int sgrp_ = (F.c >> 3) & 3;
        if ((DBG_P4 & 8) && sgrp_ == 3) { sample_item(F, F.c); if (F.c + 256 < 416) sample_item(F, F.c + 256); }
        GRID_BAR();
    }
    if (IN(5)) for (int rep_ = 0; rep_ < REP5; ++rep_) { FRESH();
        { pg8::Gemm g{WSP(bf16, WS_MIX), WSP(bf16, WS_WOUT), MP, DM, DM}; pg8::StaticOrder S; S.init(MP, DM, F.G, F.c);
          const bool dm_ = (rep_ + 1 < REP5); pg8::EpiResid<1> E{WSP(bf16, WS_XB), dm_ ? WSP(bf16, WS_DUMMY + 64 * MiB) : WSP(bf16, WS_XB), nullptr, dm_ ? WSP(float, WS_DUMMY + 96 * MiB) : ssq2, 1.0f};
          pg8::gemm_phase<pg8::EpiResid<1>, pg8::StaticOrder, true, true>(F.lds + RING_OFF, g, S, E, nostream); }
        if (F.c >= 240) { const int v = F.c - 240; sgemm_unit<8>(F, ALFrag{WSP(bf16, S_IMGMIX)}, BRPlain{v}, WSP(bf16, WS_WOUT), DM, EPResid<5>{F.ws, F.out, nullptr, v}); }
        GRID_BAR();
    }
    if (IN(6)) for (int rep_ = 0; rep_ < REP6; ++rep_) { FRESH();
        if (F.c >= 128 && rep_ + 1 == REP6) { convert_items(F, CV_MID, CV_ALL, (F.c - 128) * NWAVES + F.wave, 128 * NWAVES); __syncthreads(); }
        FRESH();
        { pg8::Gemm g{WSP(bf16, WS_XB), WSP(bf16, WS_W2A), MP, FF2, DM}; pg8::StaticOrder S; S.init(MP, FF2, F.G, F.c);
          pg8::EpiSwiglu<true> E{WSP(bf16, WS_H), ssq2, FF, {}};
          pg8::gemm_phase<pg8::EpiSwiglu<true>, pg8::StaticOrder, true, true>(F.lds + RING_OFF, g, S, E, nostream); }
        if (F.c >= 144 && F.c < 144 + 88) { const int v = F.c - 144;
          sgemm_unit<8>(F, ALFrag{WSP(bf16, S_IMGX2)}, BRSwiglu{v}, WSP(bf16, WS_W2A), DM, EPSwigluFrag{WSP(bf16, S_H), v, (const float*)(F.ws + WS_CTL) + CW_SSQS + 64}); }
        GRID_BAR();
    }
    if (IN(7)) for (int rep_ = 0; rep_ < REP7; ++rep_) { FRESH();
        { pg8::Gemm g{WSP(bf16, WS_H), WSP(bf16, WS_W2B), MP, DM, FF}; pg8::StaticOrder S; S.init(MP, DM, F.G, F.c);
          pg8::EpiResid<0> E{WSP(bf16, WS_XB), nullptr, F.out + O_Y, nullptr, 0.5f};
          pg8::gemm_phase<pg8::EpiResid<0>, pg8::StaticOrder, true, true>(F.lds + RING_OFF, g, S, E, nostream); }
        if (F.c >= 240) { const int v = F.c - 240; sgemm_unit<11>(F, ALFrag{WSP(bf16, S_H)}, BRPlain{v}, WSP(bf16, WS_W2B), FF, EPResid<7>{F.ws, F.out, nullptr, v}); }
    }
#undef IN
#undef GRID_BAR
#undef FRESH
#undef rs
#undef ssq1
#undef ssq2
#undef ksum
#undef ssq0
}

extern "C" void kernel_launch(void* const* d_in, const int* in_sizes, int n_in, void* d_out, int out_size, void* d_ws, size_t ws_size, hipStream_t stream) {
    static int grid = 0;
    if (grid == 0) {
        if (n_in != 26 || (size_t)out_size != O_END || ws_size < WS_END + 128 * MiB) { fprintf(stderr, "kernel_launch: shape mismatch (n_in %d, out %d, ws %zu): nothing launched\n", n_in, out_size, ws_size); grid = -1; return; }
        int dev = 0, cus = 0, per_cu = 0;
        if (hipGetDevice(&dev) != hipSuccess || hipDeviceGetAttribute(&cus, hipDeviceAttributeMultiprocessorCount, dev) != hipSuccess) { grid = -1; return; }
        if (hipFuncSetAttribute((const void*)hymba_fwd, hipFuncAttributeMaxDynamicSharedMemorySize, LDS_BYTES) != hipSuccess) { fprintf(stderr, "kernel_launch: hipFuncSetAttribute failed\n"); grid = -1; return; }
        if (hipOccupancyMaxActiveBlocksPerMultiprocessor(&per_cu, (const void*)hymba_fwd, NWAVES * 64, LDS_BYTES) != hipSuccess || per_cu < 1)
            fprintf(stderr, "kernel_launch: note: occupancy query reports %d workgroups per CU\n", per_cu);
        (void)hipGetLastError();
        grid = cus < 256 ? cus : 256;
    }
    if (grid < 0) return;
    if (hipMemsetAsync((char*)d_ws + WS_CTL, 0, CTL_ZERO_BYTES, stream) != hipSuccess) return;
    Args a{};
    for (int i = 0; i < 26; ++i) a.in[i] = (const float*)d_in[i];
    a.out = (float*)d_out; a.ws = (unsigned char*)d_ws;
    for (int li = 0; li < N_LAUNCHES; ++li) {
        a.ph_lo = (N_LAUNCHES == 1) ? 0 : li; a.ph_hi = (N_LAUNCHES == 1) ? PER_PHASE : li + 1;
        hipLaunchKernelGGL(hymba_fwd, dim3(grid), dim3(NWAVES * 64), LDS_BYTES, stream, a);
        const hipError_t le = hipPeekAtLastError();
        if (le != hipSuccess) { fprintf(stderr, "kernel_launch: launch %d failed: %s\n", li, hipGetErrorName(le)); break; }
    }
}
```

```cpp
#include <hip/hip_runtime.h>
#include <hip/hip_bf16.h>
#include <cstdio>
#include <cstdint>
#include <cmath>
constexpr int NWAVES = 8;
#ifndef MK_N_LAUNCHES
#define MK_N_LAUNCHES 1
#endif
constexpr int PER_PHASE = 8;
constexpr int N_LAUNCHES = MK_N_LAUNCHES;
static_assert(N_LAUNCHES == 1 || N_LAUNCHES == PER_PHASE, "MK_N_LAUNCHES is 1 or 8");

constexpr int DM = 1024, NB = 8, SEQ = 2048, MP = NB * SEQ;
constexpr int NS = 32, PAST = 8192, PAGE = 128, NPG = PAST / PAGE;
constexpr int FF = 2816, FF2 = 2 * FF, INC = 2048, MEML = 256, MM = NB * MEML;
constexpr float RMS_EPS = 1e-6f;
constexpr float C2 = 0.125f * 1.4426950408889634f;
constexpr size_t O_Y = 0, O_YS = O_Y + (size_t)MP * DM, O_KP = O_YS + (size_t)NS * DM, O_VP = O_KP + (size_t)MP * 512, O_MK = O_VP + (size_t)MP * 512, O_MV = O_MK + (size_t)MM * 256,
                 O_PS = O_MV + (size_t)MM * 256, O_KS = O_PS + (size_t)NB * 15 * 256, O_VS = O_KS + (size_t)NS * 512, O_PSS = O_VS + (size_t)NS * 512, O_END = O_PSS + (size_t)NS * 15 * 256;

constexpr size_t MiB = 1u << 20;
constexpr size_t WS_CTL = 0, CTL_ZERO_BYTES = 4 * MiB;
constexpr int CW_TMO = 0, CW_CODE = 1, CW_BAR = 4096;
constexpr int CW_SSQ1 = 16384, CW_SSQ2 = CW_SSQ1 + MP, CW_KSUM = CW_SSQ2 + MP, CW_ZERO = CW_KSUM + NB * 8 * 8 * 64, CW_SKSUM = CW_ZERO + 1024, CW_SSQS = CW_SKSUM + NS * 32 * 512, CW_END = CW_SSQS + 128;
static_assert((size_t)CW_END * 4 <= CTL_ZERO_BYTES, "CTL words inside the memset region");
constexpr size_t WS_W1A = 4 * MiB, WS_W1B = WS_W1A + 11 * MiB, WS_W2A = WS_W1B + 6 * MiB, WS_W2B = WS_W2A + 11 * MiB, WS_WIN = WS_W2B + 6 * MiB, WS_WOUT = WS_WIN + 4 * MiB, WS_WMEM = WS_WOUT + 2 * MiB;
constexpr size_t WS_XB = WS_WMEM + 1 * MiB;
constexpr size_t WS_H = WS_XB + 32 * MiB;
constexpr size_t WS_X1 = WS_H + 88 * MiB;
constexpr size_t WS_U = WS_X1 + 64 * MiB, WS_Q = WS_U + 8 * MiB, WS_K = WS_Q + 16 * MiB, WS_V = WS_K + 16 * MiB, WS_QM = WS_V + 16 * MiB;
constexpr size_t WS_MNB = WS_QM + 8 * MiB, WS_MKB = WS_MNB + 4 * MiB, WS_MVB = WS_MKB + 1 * MiB, WS_MIX = WS_MVB + 1 * MiB;
constexpr size_t WS_ROPE = WS_MIX + 32 * MiB;
constexpr size_t WS_SKSUM = WS_CTL + (size_t)CW_SKSUM * 4;
constexpr size_t WS_SSQ0 = WS_ROPE + 1 * MiB;
constexpr size_t WS_GAIN = WS_SSQ0 + 512 * 1024;
constexpr size_t WS_S = WS_SSQ0 + 1 * MiB;
constexpr size_t S_H = WS_S, S_X1 = S_H + 1 * MiB, S_X2 = S_X1 + 128 * 1024, S_U = S_X2 + 128 * 1024, S_Q = S_U + 32 * 1024, S_QM = S_Q + 64 * 1024, S_MIX = S_QM + 32 * 1024;
constexpr size_t S_IMGX = S_MIX + 128 * 1024, S_IMGX1 = S_IMGX + 64 * 1024, S_IMGX2 = S_IMGX1 + 64 * 1024, S_IMGMIX = S_IMGX2 + 64 * 1024;
constexpr size_t WS_END = S_IMGMIX + 64 * 1024;
static_assert(WS_W1B - WS_W1A >= (size_t)FF2 * DM * 2 && WS_W2A - WS_W1B >= (size_t)DM * FF * 2, "weight copies fit");

#ifndef REP0
#define REP0 1
#endif
#ifndef REP1
#define REP1 1
#endif
#ifndef REP2
#define REP2 1
#endif
#ifndef REP3
#define REP3 1
#endif
#ifndef REP4
#define REP4 1
#endif
#ifndef REP5
#define REP5 1
#endif
#ifndef REP6
#define REP6 1
#endif
#ifndef REP7
#define REP7 1
#endif
constexpr size_t WS_DUMMY = WS_END;
constexpr int RING_OFF = 0, RING_BYTES = 131072;
constexpr int LDSCTL_OFF = RING_BYTES, MISC_OFF = LDSCTL_OFF + 320;
constexpr int SM_OFF = RING_BYTES + 1024;
constexpr int ROPE_OFF = 147456;
constexpr int LDS_BYTES = 163840;
static_assert(MISC_OFF + 128 <= SM_OFF && SM_OFF + 8192 <= ROPE_OFF && ROPE_OFF + 16384 <= LDS_BYTES, "LDS map");


namespace pg8 {
#define PG8_LAS __attribute__((address_space(3)))
typedef unsigned short bf16_t;
typedef short bf16x8 __attribute__((ext_vector_type(8)));
typedef float f32x4 __attribute__((ext_vector_type(4)));
typedef unsigned u32x4 __attribute__((ext_vector_type(4)));
constexpr int BM = 256, BK = 64, HALF = 128, HTB = HALF * BK * 2  , STAGE_BYTES = 8 * HTB, NXCD = 8, WGM = 8;

__host__ __device__ __forceinline__ int lds_byte(int r, int c) { const int st = (r >> 4) * 2 + (c >> 5), rr = r & 15, cc = c & 31, ob = rr * 64 + cc * 2; return st * 1024 + (ob ^ (((ob >> 9) & 1) << 5)); }
__host__ __device__ __forceinline__ void stage_rc(int b, int& R, int& C) { const int st = b / 1024, sb = b % 1024, swz = sb ^ (((sb >> 9) & 1) << 5); R = (st >> 1) * 16 + swz / 64; C = (st & 1) * 32 + (swz % 64) / 2; }
__host__ __device__ __forceinline__ int perm32(int rho) { const int n = rho >> 4, i = rho & 15; return 8 * (i >> 2) + 4 * n + (i & 3); }

struct Unit { int pm, pn; };
struct Gemm { const bf16_t* A; const bf16_t* Bt; int M, N, K; };

struct StaticOrder {
    int nM, nN, nwg, G, c;
    __host__ __device__ void init(int M, int N, int G_, int c_) { nM = M / BM; nN = N / BM; nwg = nM * nN; G = G_; c = c_; }
    __host__ __device__ bool next(int i, Unit& u) const {
        const long L = (long)i * G + c; if (L >= nwg) return false;
        int wgid = (int)L; { const int q = nwg / NXCD, r = nwg % NXCD, xcd = wgid % NXCD, off = wgid / NXCD; wgid = (xcd < r ? xcd * (q + 1) : r * (q + 1) + (xcd - r) * q) + off; }
        const int nig = WGM * nN, gid = wgid / nig, fm = gid * WGM, gsz = (nM - fm) < WGM ? (nM - fm) : WGM;
        u.pm = fm + ((wgid % nig) % gsz); u.pn = (wgid % nig) / gsz; return true;
    }
    __device__ __forceinline__ void a_ready(const Unit&) const {}
    __device__ __forceinline__ void done(const Unit&) const {}
};

__device__ __forceinline__ unsigned cvt_pk_bf16(float lo, float hi) { unsigned r; asm volatile("v_cvt_pk_bf16_f32 %0, %1, %2" : "=v"(r) : "v"(lo), "v"(hi)); return r; }
typedef float f32x2 __attribute__((ext_vector_type(2)));
__device__ __forceinline__ f32x2 gelu_pk(f32x2 v) {
    const f32x2 av = __builtin_elementwise_abs(v), d = av * 0.2316418882f + 1.0f;
    f32x2 t; t.x = __builtin_amdgcn_rcpf(d.x); t.y = __builtin_amdgcn_rcpf(d.y);
    f32x2 q = t * 0.5307027145f + (-0.7265760135f); q = q * t + 0.7107068705f; q = q * t + (-0.142248368f); q = q * t + 0.127414796f; q = q * t;
    const f32x2 s = (v * v) * (-0.72134752044f);
    f32x2 e; e.x = __builtin_amdgcn_exp2f(s.x); e.y = __builtin_amdgcn_exp2f(s.y);
    const f32x2 m = v * (q * e), r = v - m;
    f32x2 o; o.x = v.x < 0.f ? m.x : r.x; o.y = v.y < 0.f ? m.y : r.y; return o;
}

constexpr float RMS_EPS_ = 1e-6f;
__device__ __forceinline__ float silu_f(float x) { return x * __builtin_amdgcn_rcpf(1.0f + __builtin_amdgcn_exp2f(-1.4426950408889634f * x)); }
__device__ __forceinline__ u32x4 pack8(const f32x4 a, const f32x4 b) { u32x4 w; w.x = cvt_pk_bf16(a[0], a[1]); w.y = cvt_pk_bf16(a[2], a[3]); w.z = cvt_pk_bf16(b[0], b[1]); w.w = cvt_pk_bf16(b[2], b[3]); return w; }

struct ListOrder {
    int nM, cnt, idx;
    __device__ __forceinline__ void init(int nM_, int nN_, int first, int c) { nM = nM_; cnt = nM_ * nN_; idx = c - first; }
    __device__ __forceinline__ bool next(int i, Unit& u) const { if (i > 0 || idx < 0 || idx >= cnt) return false; u.pm = idx % nM; u.pn = idx / nM; return true; }
    __device__ __forceinline__ void a_ready(const Unit&) const {}
    __device__ __forceinline__ void done(const Unit&) const {}
};

template <bool PF> struct EpiSwiglu {
    static constexpr bool PERM = true, AFTER_DRAIN = false;
    bf16_t* H; const float* ssq; int ldh;
    mutable float rq[8];
    __device__ __forceinline__ void prefetch(const Unit& u, int wr, int fr) const {
        if (!PF) return;
        const float* p = ssq + u.pm * BM + wr * 64 + fr;
#pragma unroll
        for (int q = 0; q < 8; ++q) asm volatile("global_load_dword %0, %1, off offset:%c2" : "=v"(rq[q]) : "v"(p + (q >> 2) * HALF), "n"((q & 3) * 64) : "memory");
    }
    __device__ __forceinline__ void operator()(const f32x4 (&acc)[2][2][4][2], const Unit& u, int wr, int wc, int fr, int fq) const {
        const int row0 = u.pm * BM + wr * 64 + fr, col0 = u.pn * HALF + wc * 32 + 8 * fq;
        if (PF) asm volatile("" : "+v"(rq[0]), "+v"(rq[1]), "+v"(rq[2]), "+v"(rq[3]), "+v"(rq[4]), "+v"(rq[5]), "+v"(rq[6]), "+v"(rq[7]) :: "memory");
        else {
#pragma unroll
            for (int q = 0; q < 8; ++q) rq[q] = ssq[row0 + (q >> 2) * HALF + (q & 3) * 16]; }
#pragma unroll
        for (int ai = 0; ai < 2; ++ai)
#pragma unroll
            for (int m = 0; m < 4; ++m) { const int row = row0 + ai * HALF + m * 16; const float rr = __builtin_amdgcn_rsqf(rq[ai * 4 + m] * (1.0f / 1024.0f) + RMS_EPS_);
                const float s1 = -1.4426950408889634f * rr, rr2 = rr * rr;
                const f32x4 g0 = acc[ai][0][m][0], g1 = acc[ai][0][m][1], u0 = acc[ai][1][m][0], u1 = acc[ai][1][m][1];
                f32x4 e0 = g0 * s1, e1 = g1 * s1;
#pragma unroll
                for (int i = 0; i < 4; ++i) { e0[i] = __builtin_amdgcn_rcpf(1.0f + __builtin_amdgcn_exp2f(e0[i])); e1[i] = __builtin_amdgcn_rcpf(1.0f + __builtin_amdgcn_exp2f(e1[i])); }
                const f32x4 h0 = (g0 * u0) * (e0 * rr2), h1 = (g1 * u1) * (e1 * rr2);
                *(u32x4*)(H + (size_t)row * ldh + col0) = pack8(h0, h1); }
    }
};

__device__ __forceinline__ f32x4 bf_lo4(const u32x4 w) { return (f32x4){__uint_as_float(w.x << 16), __uint_as_float(w.x & 0xffff0000u), __uint_as_float(w.y << 16), __uint_as_float(w.y & 0xffff0000u)}; }
__device__ __forceinline__ f32x4 bf_hi4(const u32x4 w) { return (f32x4){__uint_as_float(w.z << 16), __uint_as_float(w.z & 0xffff0000u), __uint_as_float(w.w << 16), __uint_as_float(w.w & 0xffff0000u)}; }
template <int MODE, int NBATCH = 1> struct EpiResid {
    static constexpr bool PERM = true, AFTER_DRAIN = false;
    const bf16_t* xin; bf16_t* xout; float* out; float* ssq; float alpha;
    __device__ __forceinline__ void prefetch(const Unit&, int, int) const {}
    __device__ __forceinline__ void operator()(const f32x4 (&acc)[2][2][4][2], const Unit& u, int wr, int wc, int fr, int fq) const {
        const int row0 = u.pm * BM + wr * 64 + fr, col0 = u.pn * BM + wc * 32 + 8 * fq;
        constexpr int AIB = 2 / NBATCH;
#pragma unroll
        for (int a0 = 0; a0 < 2; a0 += AIB) {
            u32x4 b[AIB][4][2];
#pragma unroll
            for (int ai = 0; ai < AIB; ++ai)
#pragma unroll
                for (int m = 0; m < 4; ++m)
#pragma unroll
                    for (int bj = 0; bj < 2; ++bj) b[ai][m][bj] = *(const u32x4*)(xin + (size_t)(row0 + (a0 + ai) * HALF + m * 16) * 1024 + col0 + bj * HALF);
#pragma unroll
            for (int ai = 0; ai < AIB; ++ai)
#pragma unroll
                for (int m = 0; m < 4; ++m) { const int row = row0 + (a0 + ai) * HALF + m * 16; const size_t off = (size_t)row * 1024 + col0; float ss = 0.f;
#pragma unroll
                    for (int bj = 0; bj < 2; ++bj) { const f32x4 o0 = bf_lo4(b[ai][m][bj]) + alpha * acc[a0 + ai][bj][m][0], o1 = bf_hi4(b[ai][m][bj]) + alpha * acc[a0 + ai][bj][m][1];
                        if (MODE == 0) { *(f32x4*)(out + off + bj * HALF) = o0; *(f32x4*)(out + off + bj * HALF + 4) = o1; }
                        else { *(u32x4*)(xout + off + bj * HALF) = pack8(o0, o1);
                            ss += (o0[0] * o0[0] + o0[1] * o0[1]) + (o0[2] * o0[2] + o0[3] * o0[3]) + (o1[0] * o1[0] + o1[1] * o1[1]) + (o1[2] * o1[2] + o1[3] * o1[3]); } }
                    if (MODE == 1) { ss += __shfl_xor(ss, 16); ss += __shfl_xor(ss, 32); if (fq == 0) atomicAdd(ssq + row, ss); } }
            if (NBATCH > 1) asm volatile("" ::: "memory");
        }
    }
};

__device__ __forceinline__ void head_rows(const f32x4 (&acc)[2][2][4][2], const int rowb, const int fq, const int fr, const float* ssq, PG8_LAS const float* rope, float* pstate,
        const bool o_norm, const bool o_rot, const bool o_f32o, const bool o_ks, const bool o_pst, const float o_sc, bf16_t* o_ob, const int o_ldb, float* o_of, const int o_ldf, const float* o_gain, const int o_hcol, float* o_ksum) {
    f32x4 g[2][2];
#pragma unroll
    for (int bj = 0; bj < 2; ++bj)
#pragma unroll
        for (int n = 0; n < 2; ++n) g[bj][n] = o_norm ? *(const f32x4*)(o_gain + 32 * bj + 8 * fq + 4 * n) : (f32x4){1.f, 1.f, 1.f, 1.f};
    float rr8[8];
#pragma unroll
    for (int q = 0; q < 8; ++q) rr8[q] = __builtin_amdgcn_rsqf(ssq[rowb + (q >> 2) * HALF + (q & 3) * 16] * (1.0f / 1024.0f) + RMS_EPS_);
    f32x4 cs[2][2];
#pragma unroll
    for (int bj = 0; bj < 2; ++bj)
#pragma unroll
        for (int n = 0; n < 2; ++n) cs[bj][n] = (f32x4){0.f, 0.f, 0.f, 0.f};
#pragma unroll
    for (int ai = 0; ai < 2; ++ai)
#pragma unroll
        for (int m = 0; m < 4; ++m) { const int row = rowb + ai * HALF + m * 16; const float rr = rr8[ai * 4 + m];
            f32x4 v[2][2];
#pragma unroll
            for (int bj = 0; bj < 2; ++bj)
#pragma unroll
                for (int n = 0; n < 2; ++n) v[bj][n] = acc[ai][bj][m][n] * rr;
            { float ss = 0.f;
#pragma unroll
                for (int bj = 0; bj < 2; ++bj)
#pragma unroll
                    for (int n = 0; n < 2; ++n) ss += (v[bj][n][0] * v[bj][n][0] + v[bj][n][1] * v[bj][n][1]) + (v[bj][n][2] * v[bj][n][2] + v[bj][n][3] * v[bj][n][3]);
                ss += __shfl_xor(ss, 16); ss += __shfl_xor(ss, 32);
                const float hn = o_norm ? __builtin_amdgcn_rsqf(ss * (1.0f / 64.0f) + RMS_EPS_) : 1.0f;
#pragma unroll
                for (int bj = 0; bj < 2; ++bj)
#pragma unroll
                    for (int n = 0; n < 2; ++n) v[bj][n] = v[bj][n] * hn * g[bj][n];
            }
            if (o_rot) { int ro_ = (row & 255) * 16; asm volatile("" : "+v"(ro_)); PG8_LAS const float* rp = rope + ro_;
#pragma unroll
                for (int n = 0; n < 2; ++n) { const f32x4 t0 = *(PG8_LAS const f32x4*)(rp + 8 * n), t1 = *(PG8_LAS const f32x4*)(rp + 8 * n + 4);
                    const f32x4 x = v[0][n]; f32x4 y;
#pragma unroll
                    for (int i = 0; i < 4; ++i) y[i] = __shfl_xor(x[i], 16);
                    const float sg = (fq == 0) ? -1.f : 1.f;
                    f32x4 r_;
                    r_[0] = x[0] * t0[0] + sg * y[0] * t0[1]; r_[1] = x[1] * t0[2] + sg * y[1] * t0[3]; r_[2] = x[2] * t1[0] + sg * y[2] * t1[1]; r_[3] = x[3] * t1[2] + sg * y[3] * t1[3];
                    if (fq < 2) v[0][n] = r_; }
            }
#pragma unroll
            for (int bj = 0; bj < 2; ++bj)
#pragma unroll
                for (int n = 0; n < 2; ++n) cs[bj][n] += v[bj][n];
#pragma unroll
            for (int bj = 0; bj < 2; ++bj) { const int col = o_hcol + 32 * bj + 8 * fq;
                if (o_f32o) { *(f32x4*)(o_of + (size_t)row * o_ldf + col) = v[bj][0]; *(f32x4*)(o_of + (size_t)row * o_ldf + col + 4) = v[bj][1]; }
                if (o_pst) { const int t = row & 2047; if (t >= 2033) { float* pp = pstate + ((size_t)(row >> 11) * 15 + (t - 2033)) * 256 + col; *(f32x4*)pp = v[bj][0]; *(f32x4*)(pp + 4) = v[bj][1]; } }
                *(u32x4*)(o_ob + (size_t)row * o_ldb + col) = pack8(v[bj][0] * o_sc, v[bj][1] * o_sc); }
            if (m & 1) asm volatile("" ::: "memory"); }
    if (o_ks) {
#pragma unroll
        for (int bj = 0; bj < 2; ++bj)
#pragma unroll
            for (int n = 0; n < 2; ++n)
#pragma unroll
                for (int i = 0; i < 4; ++i) { float s = cs[bj][n][i]; s += __shfl_xor(s, 1); s += __shfl_xor(s, 2); s += __shfl_xor(s, 4); s += __shfl_xor(s, 8);
                    if (fr == 0) atomicAdd(o_ksum + 32 * bj + 8 * fq + 4 * n + i, s); }
    }
}
template <bool MEM> struct EpiHead {
    static constexpr bool PERM = true, AFTER_DRAIN = false;
    const float* ssq; PG8_LAS const float* rope; float* outp; float* ksum; unsigned char* ws; float c2;
    __device__ __forceinline__ void prefetch(const Unit&, int, int) const {}
    __device__ __forceinline__ void operator()(const f32x4 (&acc)[2][2][4][2], const Unit& u, int wr, int wc, int fr, int fq) const {
        const int rowb = u.pm * BM + wr * 64 + fr; const int pn = u.pn;
        const float* gains = (const float*)(ws + WS_GAIN);
        if (MEM) {
            head_rows(acc, rowb, fq, fr, ssq, rope, outp + O_PS, pn == 0, false, true, false, false, 1.f, (bf16_t*)(ws + (pn == 0 ? WS_MKB : WS_MVB)), 256, outp + (pn == 0 ? O_MK : O_MV), 256, gains + 3 * 64, 64 * wc, ksum);
        } else {
            const bool isq = (pn == 1 || pn == 2), isk = (pn == 3 || pn == 4), isv = (pn == 5 || pn == 6), ism = (pn == 7);
            const size_t boff = pn == 0 ? WS_U : (isq ? WS_Q : (isk ? WS_K : (isv ? WS_V : WS_QM)));
            head_rows(acc, rowb, fq, fr, ssq, rope, outp + O_PS, isq || isk || ism, isq || isk, isk || isv, isk, pn == 0, (isq || ism) ? c2 : 1.f, (bf16_t*)(ws + boff), (pn == 0 || ism) ? 256 : 512,
                      outp + (isk ? O_KP : O_VP), 512, gains + (isq ? 0 : (isk ? 64 : 128)), ((pn == 0 || ism) ? 0 : 256 * ((pn - 1) & 1)) + 64 * wc, ksum + (size_t)u.pm * 512 + (4 * ((pn - 1) & 1) + wc) * 64);
        }
    }
};

struct NoStream { static constexpr int NX = 0; __device__ __forceinline__ void wait() { asm volatile("s_waitcnt vmcnt(8)" ::: "memory"); } __device__ __forceinline__ void start_a() {} __device__ __forceinline__ void start() {} __device__ __forceinline__ void begin_unit(int) {} template <int SEL> __device__ __forceinline__ void sp(int, int) {} __device__ __forceinline__ void finish() {} };
template <class Epi, class Sched, bool ALIGN_EPI = false, bool SP2 = false, class Strm = NoStream>
__device__ __forceinline__ void gemm_phase(PG8_LAS unsigned char* lds, const Gemm g, const Sched& S, const Epi& E, Strm& X) {
    const int tid = threadIdx.x, wid = __builtin_amdgcn_readfirstlane(tid >> 6), lane = tid & 63, wr = wid >> 2, wc = wid & 3, fr = lane & 15, fq = lane >> 4;
    const int K = g.K, nt = K / BK;
    unsigned voffA[2], voffB[2];
#pragma unroll
    for (int i = 0; i < 2; ++i) { int R, C; stage_rc(tid * 16 + i * 8192, R, C); const int Rb = Epi::PERM ? ((R & ~31) + perm32(R & 31)) : R;
        voffA[i] = (unsigned)(R * K + C) * 2u; voffB[i] = (unsigned)(Rb * K + C) * 2u; }
    const size_t kstep = (size_t)(BK * 2);
    const size_t hstep = (size_t)HALF * K * 2;
    const size_t tstep = 2 * hstep;
    const unsigned ldsw = (unsigned)wid * 1024u;
    const int aoff = lds_byte(wr * 64 + fr, fq * 8), boff = lds_byte(wc * 32 + fr, fq * 8);
#define PG8_SA(b, h) (((b) * 2 + (h)) * HTB)
#define PG8_SB(b, h) ((4 + (b) * 2 + (h)) * HTB)
#define PG8_STAGE(bufoff, gbase, voff) do { _Pragma("unroll") for (int _i = 0; _i < 2; ++_i) \
        __builtin_amdgcn_global_load_lds((const unsigned*)((const char*)(gbase) + (voff)[_i]), (PG8_LAS unsigned*)(lds + (bufoff) + ldsw + _i * 8192), 16, 0, 0); } while (0)
#define PG8_LDA(dst, b, h) do { _Pragma("unroll") for (int m = 0; m < 4; ++m) _Pragma("unroll") for (int k = 0; k < 2; ++k) dst[m][k] = *(const PG8_LAS bf16x8*)(lds + PG8_SA(b, h) + aoff + m * 2048 + k * 1024); } while (0)
#define PG8_LDB(dst, b, h) do { _Pragma("unroll") for (int n = 0; n < 2; ++n) _Pragma("unroll") for (int k = 0; k < 2; ++k) dst[n][k] = *(const PG8_LAS bf16x8*)(lds + PG8_SB(b, h) + boff + n * 2048 + k * 1024); } while (0)
#define PG8_MMA(ai, bj, At, Bt) do { __builtin_amdgcn_s_setprio(1); _Pragma("unroll") for (int m = 0; m < 4; ++m) _Pragma("unroll") for (int n = 0; n < 2; ++n) _Pragma("unroll") for (int k = 0; k < 2; ++k) \
        acc[ai][bj][m][n] = __builtin_amdgcn_mfma_f32_16x16x32_bf16(Bt[n][k], At[m][k], acc[ai][bj][m][n], 0, 0, 0); __builtin_amdgcn_s_setprio(0); } while (0)
#define PG8_WAIT_V(n) asm volatile("s_waitcnt vmcnt(" #n ")" ::: "memory")
#define PG8_WAIT_L(n) asm volatile("s_waitcnt lgkmcnt(" #n ")" ::: "memory")
#define PG8_WAIT_VX X.wait()
#define PG8_BAR __builtin_amdgcn_s_barrier()
#define PG8_SCHED __builtin_amdgcn_sched_barrier(0)
    Unit cur, nxt; int ui = 0;
    if (!S.next(0, cur)) return;
    f32x4 acc[2][2][4][2];
#pragma unroll
    for (int a = 0; a < 2; ++a)
#pragma unroll
        for (int b = 0; b < 2; ++b)
#pragma unroll
            for (int m = 0; m < 4; ++m)
#pragma unroll
                for (int n = 0; n < 2; ++n) acc[a][b][m][n] = (f32x4){0.f, 0.f, 0.f, 0.f};
    bf16x8 At[4][2], B0[2][2], B1[2][2];
    const char* cA = (const char*)g.A + (size_t)cur.pm * tstep; const char* cB = (const char*)g.Bt + (size_t)cur.pn * tstep;
    S.a_ready(cur);
    if constexpr (SP2) {
        PG8_STAGE(PG8_SB(0, 0), cB, voffB); PG8_STAGE(PG8_SB(0, 1), cB + hstep, voffB); PG8_STAGE(PG8_SA(0, 0), cA, voffA); PG8_STAGE(PG8_SA(0, 1), cA + hstep, voffA);
        if (wr == 1) PG8_BAR;
        PG8_WAIT_V(2); PG8_BAR;
        X.start_a();
        PG8_STAGE(PG8_SB(1, 0), cB + kstep, voffB); PG8_STAGE(PG8_SA(1, 0), cA + kstep, voffA); PG8_STAGE(PG8_SB(1, 1), cB + hstep + kstep, voffB);
        PG8_WAIT_V(6); PG8_BAR;
        X.start(); X.begin_unit(0);
    } else {
        PG8_STAGE(PG8_SB(0, 0), cB, voffB); PG8_STAGE(PG8_SA(0, 0), cA, voffA); PG8_STAGE(PG8_SB(0, 1), cB + hstep, voffB); PG8_STAGE(PG8_SA(0, 1), cA + hstep, voffA);
        if (wr == 1) PG8_BAR;
        PG8_WAIT_V(4); PG8_BAR;
        PG8_STAGE(PG8_SB(1, 0), cB + kstep, voffB); PG8_STAGE(PG8_SA(1, 0), cA + kstep, voffA); PG8_STAGE(PG8_SB(1, 1), cB + hstep + kstep, voffB);
        PG8_WAIT_V(6); PG8_BAR;
    }
    for (;;) {
        const bool has_next = S.next(ui + 1, nxt);
        const char* nA = has_next ? (const char*)g.A + (size_t)nxt.pm * tstep : cA; const char* nB = has_next ? (const char*)g.Bt + (size_t)nxt.pn * tstep : cB;
        for (int t = 0; t < nt; t += 2) {
            const bool last = (t == nt - 2);
            const char* a1 = cA + (size_t)(t + 1) * kstep;
            const char* a2 = last ? nA : cA + (size_t)(t + 2) * kstep; const char* b2 = last ? nB : cB + (size_t)(t + 2) * kstep;
            const char* a3 = a2 + kstep; const char* b3 = b2 + kstep;
            if (last && has_next) S.a_ready(nxt);
            if (last) E.prefetch(cur, wr, fr);
            if constexpr (SP2) {
            PG8_LDB(B0, 0, 0); PG8_LDB(B1, 0, 1); PG8_SCHED; PG8_LDA(At, 0, 0); PG8_STAGE(PG8_SA(1, 1), a1 + hstep, voffA);
            PG8_WAIT_VX; X.template sp<0>(2 * t, ui); PG8_WAIT_L(0); PG8_BAR; PG8_MMA(0, 0, At, B0); PG8_MMA(0, 1, At, B1); PG8_BAR; PG8_SCHED;
            PG8_LDA(At, 0, 1); PG8_STAGE(PG8_SB(0, 0), b2, voffB); PG8_STAGE(PG8_SB(0, 1), b2 + hstep, voffB); PG8_STAGE(PG8_SA(0, 0), a2, voffA);
            PG8_WAIT_VX; X.template sp<1>(2 * t + 1, ui); PG8_WAIT_L(0); PG8_BAR; PG8_MMA(1, 0, At, B0); PG8_MMA(1, 1, At, B1); PG8_BAR; PG8_SCHED;
            PG8_LDB(B0, 1, 0); PG8_LDB(B1, 1, 1); PG8_SCHED; PG8_LDA(At, 1, 0); PG8_STAGE(PG8_SA(0, 1), a2 + hstep, voffA);
            PG8_WAIT_VX; X.template sp<2>(2 * t + 2, ui); PG8_WAIT_L(0); PG8_BAR; PG8_MMA(0, 0, At, B0); PG8_MMA(0, 1, At, B1); PG8_BAR; PG8_SCHED;
            PG8_LDA(At, 1, 1); PG8_STAGE(PG8_SB(1, 0), b3, voffB); PG8_STAGE(PG8_SB(1, 1), b3 + hstep, voffB); PG8_STAGE(PG8_SA(1, 0), a3, voffA);
            PG8_WAIT_VX; X.template sp<3>(2 * t + 3, ui); PG8_WAIT_L(0); PG8_BAR; PG8_MMA(1, 0, At, B0); PG8_MMA(1, 1, At, B1); PG8_BAR; PG8_SCHED;
            } else {
            PG8_LDB(B0, 0, 0); PG8_SCHED; PG8_LDA(At, 0, 0); PG8_STAGE(PG8_SA(1, 1), a1 + hstep, voffA);
            PG8_WAIT_L(8); PG8_BAR; PG8_WAIT_L(0); PG8_MMA(0, 0, At, B0); PG8_BAR; PG8_SCHED;
            PG8_LDB(B1, 0, 1); PG8_STAGE(PG8_SB(0, 0), b2, voffB);
            PG8_BAR; PG8_WAIT_L(0); PG8_MMA(0, 1, At, B1); PG8_BAR;
            PG8_LDA(At, 0, 1); PG8_STAGE(PG8_SA(0, 0), a2, voffA);
            PG8_BAR; PG8_WAIT_L(0); PG8_MMA(1, 0, At, B0); PG8_BAR; PG8_SCHED;
            PG8_STAGE(PG8_SB(0, 1), b2 + hstep, voffB);
            PG8_WAIT_V(6); PG8_BAR; PG8_MMA(1, 1, At, B1); PG8_BAR;
            PG8_LDB(B0, 1, 0); PG8_SCHED; PG8_LDA(At, 1, 0); PG8_STAGE(PG8_SA(0, 1), a2 + hstep, voffA);
            PG8_WAIT_L(8); PG8_BAR; PG8_WAIT_L(0); PG8_MMA(0, 0, At, B0); PG8_BAR; PG8_SCHED;
            PG8_LDB(B1, 1, 1); PG8_STAGE(PG8_SB(1, 0), b3, voffB);
            PG8_BAR; PG8_WAIT_L(0); PG8_MMA(0, 1, At, B1); PG8_BAR;
            PG8_LDA(At, 1, 1); PG8_STAGE(PG8_SA(1, 0), a3, voffA);
            PG8_BAR; PG8_WAIT_L(0); PG8_MMA(1, 0, At, B0); PG8_BAR; PG8_SCHED;
            PG8_STAGE(PG8_SB(1, 1), b3 + hstep, voffB);
            PG8_WAIT_V(6); PG8_BAR; PG8_MMA(1, 1, At, B1); PG8_BAR;
            }
        }
        if constexpr (ALIGN_EPI) { if (wr == 0) PG8_BAR; }
        if constexpr (!Epi::AFTER_DRAIN) { E(acc, cur, wr, wc, fr, fq); S.done(cur); }
        if (!has_next) break;
#pragma unroll
        for (int a = 0; a < 2; ++a)
#pragma unroll
            for (int b = 0; b < 2; ++b)
#pragma unroll
                for (int m = 0; m < 4; ++m)
#pragma unroll
                    for (int n = 0; n < 2; ++n) acc[a][b][m][n] = (f32x4){0.f, 0.f, 0.f, 0.f};
        cur = nxt; cA = nA; cB = nB; ++ui;
        X.begin_unit(ui);
        if constexpr (ALIGN_EPI) { if (wr == 1) PG8_BAR; }
    }
    PG8_WAIT_V(0);
    X.finish();
    if constexpr (!ALIGN_EPI) { if (wr == 0) PG8_BAR; }
    PG8_BAR;
    if constexpr (Epi::AFTER_DRAIN) { E.fused(acc, cur, wr, wc, fr, fq, lds, wid, lane); S.done(cur); }
#undef PG8_SA
#undef PG8_SB
#undef PG8_STAGE
#undef PG8_LDA
#undef PG8_LDB
#undef PG8_MMA
#undef PG8_WAIT_V
#undef PG8_WAIT_L
#undef PG8_WAIT_VX
#undef PG8_BAR
#undef PG8_SCHED
}
}

namespace attn_body {
using bf16=__hip_bfloat16;
using bf16x8=__attribute__((ext_vector_type(8)))short;
using s16x4=__attribute__((ext_vector_type(4)))short;
using f32x16=__attribute__((ext_vector_type(16)))float;
using u32x4=__attribute__((ext_vector_type(4)))unsigned;
using f32x4_t=__attribute__((ext_vector_type(4)))float;
__device__ __forceinline__ float bf2f(short s){return __uint_as_float(((unsigned)(unsigned short)s)<<16);}
constexpr int D=64;
constexpr int NW=8,QBLK=32,QB=QBLK*NW,KVBLK=64;
constexpr int ATTN_UNIT_ROWS=QB;
__device__ __forceinline__ int crow(int r,int hi){return (r&3)+8*(r>>2)+4*hi;}
#define SBAR() __builtin_amdgcn_sched_barrier(0)
__device__ __forceinline__ void cmask(f32x16&p0,f32x16&p1,int jb,int qrel,int hi){
  const float NEG=-INFINITY; int kb=64*jb+4*hi;
  #pragma unroll
  for(int r=0;r<16;++r){int kv=kb+(r&3)+8*(r>>2); if(kv>qrel)p0[r]=NEG; if(kv+32>qrel)p1[r]=NEG;}
}

constexpr int NSLOT=3, SLOTB=8192;
constexpr int LDS_K=0, LDS_V=NSLOT*SLOTB, LDS_WS=2*NSLOT*SLOTB, LDS_OST=LDS_WS+NW*64*4, LDS_BYTES=LDS_OST+NW*4096;
constexpr float C2=0.125f*1.4426950408889634f;
__device__ __forceinline__ void glds16(const void*gsrc,unsigned lds_dst){unsigned keep;
  asm volatile("s_mov_b32 %0, m0\n\ts_mov_b32 m0, %2\n\ts_nop 0\n\tglobal_load_lds_dwordx4 %1, off\n\ts_mov_b32 m0, %0":"=&s"(keep):"v"(gsrc),"s"(lds_dst):"memory");}
__device__ __forceinline__ float max3f(float a,float b,float c){float r;asm("v_max3_f32 %0, %1, %2, %3":"=v"(r):"v"(a),"v"(b),"v"(c));return r;}
__device__ __forceinline__ float max2f(float a,float b){float r;asm("v_max_f32_e32 %0, %1, %2":"=v"(r):"v"(a),"v"(b));return r;}
__device__ __forceinline__ float fadd_s(float a,float b){float r;asm("v_add_f32_e32 %0, %1, %2":"=v"(r):"v"(a),"v"(b));return r;}
__device__ __forceinline__ float fsub_s(float a,float b){float r;asm("v_sub_f32_e32 %0, %1, %2":"=v"(r):"v"(a),"v"(b));return r;}
typedef float f32x2_t __attribute__((ext_vector_type(2))); typedef __bf16 bf16x2_t __attribute__((ext_vector_type(2)));
__device__ __forceinline__ unsigned cvtpk_s(float lo,float hi){f32x2_t v={lo,hi};bf16x2_t b=__builtin_convertvector(v,bf16x2_t);return __builtin_bit_cast(unsigned,b);}
#define WAIT_BAR(N) asm volatile("s_waitcnt vmcnt(" #N ") lgkmcnt(0)\n\ts_barrier":::"memory")

__device__ __forceinline__ void qkt(f32x16&p0,f32x16&p1,const char*Kslot,const bf16x8*qr,const f32x16&negm,int r32,int hi){
  const char*kb=Kslot+hi*1024+r32*16;
  #pragma unroll
  for(int d0=0;d0<4;++d0){
    const bf16x8 b0=*reinterpret_cast<const bf16x8*>(kb+d0*2048);
    const bf16x8 b1=*reinterpret_cast<const bf16x8*>(kb+d0*2048+512);
    if(d0==0){p0=__builtin_amdgcn_mfma_f32_32x32x16_bf16(b0,qr[0],negm,0,0,0);p1=__builtin_amdgcn_mfma_f32_32x32x16_bf16(b1,qr[0],negm,0,0,0);}
    else{p0=__builtin_amdgcn_mfma_f32_32x32x16_bf16(b0,qr[d0],p0,0,0,0);p1=__builtin_amdgcn_mfma_f32_32x32x16_bf16(b1,qr[d0],p1,0,0,0);}}
}
typedef __attribute__((address_space(3))) const char* lds_cptr;
typedef short v4i16_t __attribute__((ext_vector_type(4)));
__device__ __forceinline__ void kload8(bf16x8*kf,lds_cptr kp){
  kf[0]=*(const __attribute__((address_space(3))) bf16x8*)(kp);      kf[1]=*(const __attribute__((address_space(3))) bf16x8*)(kp+512);
  kf[2]=*(const __attribute__((address_space(3))) bf16x8*)(kp+2048); kf[3]=*(const __attribute__((address_space(3))) bf16x8*)(kp+2560);
  kf[4]=*(const __attribute__((address_space(3))) bf16x8*)(kp+4096); kf[5]=*(const __attribute__((address_space(3))) bf16x8*)(kp+4608);
  kf[6]=*(const __attribute__((address_space(3))) bf16x8*)(kp+6144); kf[7]=*(const __attribute__((address_space(3))) bf16x8*)(kp+6656);
}
__device__ __forceinline__ void kload2(bf16x8*kf,lds_cptr kp,int j){ kf[2*j]=*(const __attribute__((address_space(3))) bf16x8*)(kp+j*2048); kf[2*j+1]=*(const __attribute__((address_space(3))) bf16x8*)(kp+j*2048+512); }
__device__ __forceinline__ s16x4 vtr(lds_cptr p){ return __builtin_bit_cast(s16x4,__builtin_amdgcn_ds_read_tr16_b64_v4i16((__attribute__((address_space(3))) v4i16_t*)p)); }
__device__ __forceinline__ float rowmax(const f32x16&p0,const f32x16&p1){
  float a=max3f(p0[0],p0[1],p1[0]),b=max3f(p0[2],p0[3],p1[1]);a=max3f(a,p1[2],p1[3]);
  #pragma unroll
  for(int r=4;r<16;r+=4){a=max3f(a,p0[r],p0[r+1]);b=max3f(b,p0[r+2],p0[r+3]);a=max3f(a,p1[r],p1[r+1]);b=max3f(b,p1[r+2],p1[r+3]);}
  const float m=max2f(a,b);
  auto rr=__builtin_amdgcn_permlane32_swap(__float_as_uint(m),__float_as_uint(m),false,false);
  return max2f(__uint_as_float(rr[0]),__uint_as_float(rr[1]));
}
__device__ __forceinline__ void pv(f32x16*o,int vb,bf16x8 pa0,bf16x8 pa1,bf16x8 pa2,bf16x8 pa3){
  #pragma unroll
  for(int d0=0;d0<2;++d0){s16x4 lo[4],hi[4];
    #pragma unroll
    for(int ks=0;ks<4;++ks){
      asm volatile("ds_read_b64_tr_b16 %0,%1 offset:%c2":"=&v"(lo[ks]):"v"(vb),"i"(d0*4096+ks*1024):"memory");
      asm volatile("ds_read_b64_tr_b16 %0,%1 offset:%c2":"=&v"(hi[ks]):"v"(vb),"i"(d0*4096+ks*1024+512):"memory");}
    asm volatile("s_waitcnt lgkmcnt(0)":::"memory");SBAR();
    #define PK(k) (bf16x8){lo[k][0],lo[k][1],lo[k][2],lo[k][3],hi[k][0],hi[k][1],hi[k][2],hi[k][3]}
    o[d0]=__builtin_amdgcn_mfma_f32_32x32x16_bf16(pa0,PK(0),o[d0],0,0,0);
    o[d0]=__builtin_amdgcn_mfma_f32_32x32x16_bf16(pa1,PK(1),o[d0],0,0,0);
    o[d0]=__builtin_amdgcn_mfma_f32_32x32x16_bf16(pa2,PK(2),o[d0],0,0,0);
    o[d0]=__builtin_amdgcn_mfma_f32_32x32x16_bf16(pa3,PK(3),o[d0],0,0,0);
    #undef PK
  }
}

#ifndef ATTN_STORE16
#define ATTN_STORE16(p,v) (*(u32x4*)(p)=(v))
#endif
template<int THRL,int MODE,int QP,int KP,int OP> __device__ __forceinline__ void attn_unit(const bf16*Qu,const bf16*__restrict__ Kh,const bf16*__restrict__ Vh,bf16*Ou,const int NT,const __attribute__((address_space(3))) unsigned char*seltab,char*shm){
  const int tid=threadIdx.x,lane=tid&63,r32=lane&31,hi=lane>>5; const int wid=__builtin_amdgcn_readfirstlane(tid>>6);
  const bf16*Qw=Qu+(long)(wid*QBLK)*QP;
  const unsigned lds0=(unsigned)(uintptr_t)shm;
  float*wsf=(float*)(shm+LDS_WS)+wid*64;
  const bf16*ksrc=Kh+(long)lane*KP+wid*8;
  const bf16*vsrc=Vh+(long)(16*(wid&3)+(lane>>2))*KP+(wid>>2)*32+(lane&3)*8;
  const unsigned kdst=lds0+LDS_K+wid*1024, vdst=lds0+LDS_V+wid*1024;
  #define PHYS(t) (MODE==1?(((t)<4)?((t)+NT-4):((t)-4)):(t))
  #define DMA_K(t,slot) glds16(ksrc+(long)PHYS(t)*KVBLK*KP,(unsigned)__builtin_amdgcn_readfirstlane(kdst+(slot)))
  #define DMA_V(t,slot) glds16(vsrc+(long)PHYS(t)*KVBLK*KP,(unsigned)__builtin_amdgcn_readfirstlane(vdst+(slot)))
  const char*Kbase=shm+LDS_K; bf16x8 kf[8];
  const lds_cptr shm3=(lds_cptr)shm; const lds_cptr kp0=shm3+LDS_K+hi*1024+r32*16; const lds_cptr vp0=shm3+LDS_V+((lane>>4)&1)*32+(lane&3)*8+(4*hi+((lane&15)>>2))*64;
  DMA_K(0,0);DMA_V(0,0);DMA_K(1,SLOTB);
  bf16x8 qr[4];
  #pragma unroll
  for(int d0=0;d0<4;++d0)qr[d0]=*reinterpret_cast<const bf16x8*>(&Qw[(long)r32*QP+d0*16+hi*8]);
  unsigned sel=0x7fu; if(MODE==1) sel=(unsigned)seltab[wid*QBLK+r32];
  float mhat=0.f,l_reg=0.f;f32x16 o[2];o[0]=f32x16{};o[1]=f32x16{};const f32x16 negm=f32x16{};
  const int qrel=wid*QBLK+r32;
  #define CMASK(P0,P1,t) do{ if(MODE==1){ if((t)<4) cmask(P0,P1,(t),qrel,hi); else if(!((sel>>(((t)-4)>>2))&1u)){ _Pragma("unroll") for(int r_=0;r_<16;++r_){P0[r_]=-INFINITY;P1[r_]=-INFINITY;} } } }while(0)
  bool resc=false;
  #define START(P0,P1) do{ const float rm=rowmax(P0,P1); resc=false; \
    { const float dl=rm; mhat=fadd_s(mhat,dl); \
      _Pragma("unroll") for(int r=0;r<16;++r){P0[r]=fsub_s(P0[r],dl);P1[r]=fsub_s(P1[r],dl);} \
      } \
    _Pragma("unroll") for(int r=0;r<16;++r)P0[r]=__builtin_amdgcn_exp2f(P0[r]); }while(0)
  #define RESC() do{ if(resc){ asm volatile("s_waitcnt lgkmcnt(0)":::"memory"); \
      _Pragma("unroll") for(int d_=0;d_<2;++d_) _Pragma("unroll") for(int r=0;r<16;++r)o[d_][r]*=wsf[crow(r,hi)]; } }while(0)
  f32x16 pA0,pA1,pB0,pB1;
  int sl_prev=0,sl_cur=0,sl_next=SLOTB;
  #define ROT() do{sl_prev=sl_cur;sl_cur=sl_next;sl_next=(sl_next==(NSLOT-1)*SLOTB)?0:sl_next+SLOTB;}while(0)
  DMA_K(2,2*SLOTB);
  WAIT_BAR(3);
  qkt(pA0,pA1,Kbase,qr,negm,r32,hi);asm volatile("s_nop 15\n\ts_nop 7":"+v"(pA0),"+v"(pA1));if(MODE==1){ const int lim_=qrel-4*hi; _Pragma("unroll") for(int r_=0;r_<16;++r_){ const int c_=(r_&3)+8*(r_>>2); pA0[r_]=(c_>lim_)?-INFINITY:pA0[r_]; pA1[r_]=(c_+32>lim_)?-INFINITY:pA1[r_]; } }
  START(pA0,pA1);
  _Pragma("unroll") for(int r=0;r<16;++r)pA1[r]=__builtin_amdgcn_exp2f(pA1[r]);
  WAIT_BAR(0);
  DMA_K(3,0);DMA_V(1,SLOTB);
  ROT();
  kload8(kf,kp0+sl_cur);
  WAIT_BAR(2);
  s16x4 vlo[8],vhi[8]; u32x4 pw0,pw1,pw2,pw3;
  #define PKW(P,B) cvtpk_s(P[B],P[B+1])
  #define PAF(k) __builtin_bit_cast(bf16x8,pw##k)
  #define VFR(i) (bf16x8){vlo[i][0],vlo[i][1],vlo[i][2],vlo[i][3],vhi[i][0],vhi[i][1],vhi[i][2],vhi[i][3]}
  #define PIN(x) asm volatile("":"+v"(x))
  #define MX3(a,b,c) __builtin_fmaxf(__builtin_fmaxf((a),(b)),(c))
  #define GAPA(MF,A0,A1,A2,A3,W0,W1,PW) do{ MF; sacc+=A0; sacc+=A1; sacc+=A2; sacc+=A3; PIN(sacc); W0; W1; PIN(PW); SBAR(); }while(0)
  #define EX(v) __builtin_amdgcn_exp2f(v)
  #define GAPB(MF,X,B) do{ MF; X[B]=EX(X[B]); X[B+1]=EX(X[B+1]); X[B+2]=EX(X[B+2]); X[B+3]=EX(X[B+3]); PIN(X); SBAR(); }while(0)
  #define VRD(i) do{ vlo[i]=vtr(vp_+(((i)>>2)*4096+((i)&3)*1024)); vhi[i]=vtr(vp_+(((i)>>2)*4096+((i)&3)*1024+512)); }while(0)
  #define KRD(G,j) do{ if(G){ kload2(kf,kp0+sl_next,j); SBAR(); } }while(0)
  #define STEP(C0,C1,P0,P1,t,GK,GV,GL,PAST) do{ SBAR(); \
    const lds_cptr vp_=vp0+sl_prev; \
    VRD(0); SBAR(); float sacc=(P0[0]+P0[1]); \
    GAPA(C0=__builtin_amdgcn_mfma_f32_32x32x16_bf16(kf[0],qr[0],negm,0,0,0), P0[2],P0[3],P0[4],P0[5],     pw0[0]=PKW(P0,0), pw0[1]=PKW(P0,2), pw0); \
    VRD(4); SBAR(); GAPA(C1=__builtin_amdgcn_mfma_f32_32x32x16_bf16(kf[1],qr[0],negm,0,0,0), P0[6],P0[7],P0[8],P0[9],     pw0[2]=PKW(P0,4), pw0[3]=PKW(P0,6), pw0); \
    VRD(1); SBAR(); GAPA(C0=__builtin_amdgcn_mfma_f32_32x32x16_bf16(kf[2],qr[1],C0,0,0,0),   P0[10],P0[11],P0[12],P0[13], pw1[0]=PKW(P0,8), pw1[1]=PKW(P0,10), pw1); \
    VRD(5); SBAR(); GAPA(C1=__builtin_amdgcn_mfma_f32_32x32x16_bf16(kf[3],qr[1],C1,0,0,0),   P0[14],P0[15],P1[0],P1[1],   pw1[2]=PKW(P0,12),pw1[3]=PKW(P0,14), pw1); \
    VRD(2); SBAR(); GAPA(C0=__builtin_amdgcn_mfma_f32_32x32x16_bf16(kf[4],qr[2],C0,0,0,0),   P1[2],P1[3],P1[4],P1[5],     pw2[0]=PKW(P1,0), pw2[1]=PKW(P1,2), pw2); \
    VRD(6); SBAR(); GAPA(C1=__builtin_amdgcn_mfma_f32_32x32x16_bf16(kf[5],qr[2],C1,0,0,0),   P1[6],P1[7],P1[8],P1[9],     pw2[2]=PKW(P1,4), pw2[3]=PKW(P1,6), pw2); \
    VRD(3); SBAR(); GAPA(C0=__builtin_amdgcn_mfma_f32_32x32x16_bf16(kf[6],qr[3],C0,0,0,0),   P1[10],P1[11],P1[12],P1[13], pw3[0]=PKW(P1,8), pw3[1]=PKW(P1,10), pw3); \
    VRD(7); SBAR(); GAPA(C1=__builtin_amdgcn_mfma_f32_32x32x16_bf16(kf[7],qr[3],C1,0,0,0),   P1[14],P1[15],0.f,0.f,       pw3[2]=PKW(P1,12),pw3[3]=PKW(P1,14), pw3); \
    l_reg+=sacc; \
    if(GK){DMA_K((t)+3,sl_cur);} if(GV){DMA_V((t)+1,sl_next);} \
    if(MODE==1 && (PAST)){ const float mh_=(((sel>>(((t)-4)>>2))&1u)!=0u)?mhat:INFINITY; _Pragma("unroll") for(int r_=0;r_<16;++r_){ C0[r_]-=mh_; C1[r_]-=mh_; } }   \
    else if(MODE==1){ const int lim_=LIM(t); _Pragma("unroll") for(int r_=0;r_<16;++r_){ const int c_=(r_&3)+8*(r_>>2); C0[r_]=(c_>lim_)?-INFINITY:(C0[r_]-mhat); C1[r_]=(c_+32>lim_)?-INFINITY:(C1[r_]-mhat); } } \
    else { _Pragma("unroll") for(int r_=0;r_<16;++r_){ C0[r_]-=mhat; C1[r_]-=mhat; } } \
    { float a=MX3(C0[0],C0[1],C1[0]),b=MX3(C0[2],C0[3],C1[1]); a=MX3(a,C1[2],C1[3]); \
      _Pragma("unroll") for(int r=4;r<16;r+=4){a=MX3(a,C0[r],C0[r+1]);b=MX3(b,C0[r+2],C0[r+3]);a=MX3(a,C1[r],C1[r+1]);b=MX3(b,C1[r+2],C1[r+3]);} \
      float rm=__builtin_fmaxf(a,b); { auto rr=__builtin_amdgcn_permlane32_swap(__float_as_uint(rm),__float_as_uint(rm),false,false); rm=__builtin_fmaxf(__uint_as_float(rr[0]),__uint_as_float(rr[1])); } \
      resc=false; \
      if(__builtin_expect(__any(rm>(float)THRL),0)){ const float dl=__builtin_fmaxf(rm,0.f); mhat+=dl; \
        _Pragma("unroll") for(int r=0;r<16;++r){C0[r]-=dl;C1[r]-=dl;} \
        const float f=__builtin_amdgcn_exp2f(-dl); l_reg*=f; if(hi==0)wsf[r32]=f; resc=true; } } \
    SBAR(); \
    GAPB(o[0]=__builtin_amdgcn_mfma_f32_32x32x16_bf16(PAF(0),VFR(0),o[0],0,0,0), C0,0); \
    GAPB(o[1]=__builtin_amdgcn_mfma_f32_32x32x16_bf16(PAF(0),VFR(4),o[1],0,0,0), C0,4); \
    KRD(GL,0); GAPB(o[0]=__builtin_amdgcn_mfma_f32_32x32x16_bf16(PAF(1),VFR(1),o[0],0,0,0), C0,8); \
    KRD(GL,1); GAPB(o[1]=__builtin_amdgcn_mfma_f32_32x32x16_bf16(PAF(1),VFR(5),o[1],0,0,0), C0,12); \
    KRD(GL,2); GAPB(o[0]=__builtin_amdgcn_mfma_f32_32x32x16_bf16(PAF(2),VFR(2),o[0],0,0,0), C1,0); \
    KRD(GL,3); GAPB(o[1]=__builtin_amdgcn_mfma_f32_32x32x16_bf16(PAF(2),VFR(6),o[1],0,0,0), C1,4); \
    GAPB(o[0]=__builtin_amdgcn_mfma_f32_32x32x16_bf16(PAF(3),VFR(3),o[0],0,0,0), C1,8); \
    GAPB(o[1]=__builtin_amdgcn_mfma_f32_32x32x16_bf16(PAF(3),VFR(7),o[1],0,0,0), C1,12); \
    }while(0)
  #define LIM(t) (((t)<4)?(qrel-64*(t)-4*hi):((((sel>>(((t)-4)>>2))&1u)!=0u)?1000:-1000))
  int t=1;
  for(;t<5&&t+5<NT;t+=2){
    STEP(pB0,pB1,pA0,pA1,t,true,true,true,false);     WAIT_BAR(2); RESC(); ROT();
    STEP(pA0,pA1,pB0,pB1,t+1,true,true,true,false);   WAIT_BAR(2); RESC(); ROT();
  }
  for(;t+5<NT;t+=2){
    STEP(pB0,pB1,pA0,pA1,t,true,true,true,true);      WAIT_BAR(2); RESC(); ROT();
    STEP(pA0,pA1,pB0,pB1,t+1,true,true,true,true);    WAIT_BAR(2); RESC(); ROT();
  }
  #define ENDW(tt) do{ if((tt)+3<NT){WAIT_BAR(2);} else if((tt)+2<NT){WAIT_BAR(1);} else {WAIT_BAR(0);} }while(0)
  for(;t+1<NT;t+=2){
    STEP(pB0,pB1,pA0,pA1,t,(t+3<NT),(t+1<NT),(t+1<NT),false);       ENDW(t);   RESC(); ROT();
    STEP(pA0,pA1,pB0,pB1,t+1,(t+4<NT),(t+2<NT),(t+2<NT),false);     ENDW(t+1); RESC(); ROT();
  }
  STEP(pB0,pB1,pA0,pA1,NT-1,false,false,false,false); RESC();
  { float sacc=pB0[0]+pB0[1]; _Pragma("unroll") for(int r=2;r<16;++r)sacc+=pB0[r]; _Pragma("unroll") for(int r=0;r<16;++r)sacc+=pB1[r]; l_reg+=sacc;
    pw0=(u32x4){PKW(pB0,0),PKW(pB0,2),PKW(pB0,4),PKW(pB0,6)};pw1=(u32x4){PKW(pB0,8),PKW(pB0,10),PKW(pB0,12),PKW(pB0,14)};pw2=(u32x4){PKW(pB1,0),PKW(pB1,2),PKW(pB1,4),PKW(pB1,6)};pw3=(u32x4){PKW(pB1,8),PKW(pB1,10),PKW(pB1,12),PKW(pB1,14)};
    int ln_=threadIdx.x&63; asm volatile("":"+v"(ln_)); const int vb0_=(int)(lds0+LDS_V)+((ln_>>4)&1)*32+(ln_&3)*8+(4*(ln_>>5)+((ln_&15)>>2))*64;
    SBAR(); pv(o,vb0_+sl_cur,PAF(0),PAF(1),PAF(2),PAF(3)); }
  #undef PKW
  #undef PAF
  #undef VFR
  #undef PIN
  #undef MX3
  #undef GAPA
  #undef GAPB
  #undef EX
  #undef VRD
  #undef KRD
  #undef STEP
  #undef ENDW
  #undef LIM
  {auto rr=__builtin_amdgcn_permlane32_swap(__float_as_uint(l_reg),__float_as_uint(l_reg),false,false);l_reg=__uint_as_float(rr[0])+__uint_as_float(rr[1]);}
  if(hi==0)wsf[32+r32]=l_reg;asm volatile("s_waitcnt lgkmcnt(0)":::"memory");
  float rli[16];
  #pragma unroll
  for(int r=0;r<16;++r)rli[r]=__builtin_amdgcn_rcpf(wsf[32+crow(r,hi)]);
  bf16*Ow=Ou+(long)(wid*QBLK)*OP;
  { bf16*stg=(bf16*)(shm+LDS_OST)+wid*2048;
    #pragma unroll
    for(int r=0;r<16;++r){const int orow=crow(r,hi);
      #pragma unroll
      for(int d0=0;d0<2;++d0)stg[orow*64+d0*32+r32]=__float2bfloat16(o[d0][r]*rli[r]);}
    asm volatile("s_waitcnt lgkmcnt(0)":::"memory");
    #pragma unroll
    for(int i=0;i<4;++i){const int row=i*8+(lane>>3),ch=lane&7; const u32x4 v=*(const u32x4*)(stg+row*64+ch*8); ATTN_STORE16(Ow+(long)row*OP+ch*8,v);} }
  asm volatile("s_waitcnt lgkmcnt(0)\n\ts_barrier":::"memory");
  #undef DMA_K
  #undef PHYS
  #undef DMA_V
  #undef CMASK
  #undef START
  #undef RESC
  #undef ROT
}
constexpr int ATTN_LDS_BYTES=LDS_BYTES;
#undef SBAR
#undef WAIT_BAR
}

#define GAS __attribute__((address_space(1)))
#define LAS __attribute__((address_space(3)))
typedef unsigned short bf16;
typedef unsigned v4u __attribute__((ext_vector_type(4)));
typedef float f32x4 __attribute__((ext_vector_type(4)));
typedef short bf16x8 __attribute__((ext_vector_type(8)));
typedef GAS unsigned gu32;
typedef GAS unsigned long long gu64;
#define RLX_AGENT __ATOMIC_RELAXED, __HIP_MEMORY_SCOPE_AGENT
#define LDS_WAIT() asm volatile("s_waitcnt lgkmcnt(0)" ::: "memory")
#define VM_WAIT() asm volatile("s_waitcnt vmcnt(0)" ::: "memory")
__device__ __forceinline__ unsigned long long rt() { return __builtin_amdgcn_s_memrealtime(); }
__device__ __forceinline__ unsigned f2bf(float f) { unsigned u = __builtin_bit_cast(unsigned, f); return (u + 0x7fffu + ((u >> 16) & 1u)) >> 16; }
__device__ __forceinline__ unsigned pk2(float lo, float hi) { return f2bf(lo) | (f2bf(hi) << 16); }

#define XB_TMO      128
#define XB_XCNT(j)  (256  + 64 * (j))
#define XB_XSUB(j)  (1280 + 64 * (j))
#define XB_XGEN(j)  (2304 + 64 * (j))
#define XB_TOP      3328
#define XB_TOPGEN   3392
#define XCD_BAR_WORDS 3456
#define XB_SPIN_CAP (1u << 18)

__device__ __forceinline__ unsigned xb_ld(unsigned* p)              { return __hip_atomic_load(p, __ATOMIC_RELAXED, __HIP_MEMORY_SCOPE_AGENT); }
__device__ __forceinline__ unsigned xb_add(unsigned* p, unsigned v) { return __hip_atomic_fetch_add(p, v, __ATOMIC_RELAXED, __HIP_MEMORY_SCOPE_AGENT); }
__device__ __forceinline__ unsigned xb_xcc_id() { return (unsigned)__builtin_amdgcn_s_getreg((3 << 11) | 20) & 0xFu; }
#define XB_SPIN(cond, bar) do { unsigned _sp = 0; while (cond) { __builtin_amdgcn_s_sleep(1); \
    if ((++_sp & 255u) == 0u) { if (xb_ld(&(bar)[XB_TMO])) break; if (_sp > XB_SPIN_CAP) { atomicAdd(&(bar)[XB_TMO], 1u); break; } } } } while (0)

struct XcdBarrier {
    unsigned* bar; unsigned x;
    volatile LAS unsigned* st;
};

__device__ __forceinline__ XcdBarrier xcd_barrier_post(unsigned* bar, volatile LAS unsigned* st) {
    XcdBarrier b; b.bar = bar; b.x = xb_xcc_id(); b.st = st;
    if (threadIdx.x == 0) (void)xb_add(&bar[XB_XCNT(b.x)], 1u);
    return b;
}
__device__ __forceinline__ void xcd_barrier_complete(unsigned* bar, unsigned x, unsigned& nloc, unsigned& nx) {
    const unsigned G = gridDim.x * gridDim.y * gridDim.z;
    unsigned sum, cnt, mine, sp = 0u;
    for (;;) {
        sum = 0u; cnt = 0u; mine = 0u;
#pragma unroll
        for (unsigned j = 0; j < 16; ++j) { const unsigned c = xb_ld(&bar[XB_XCNT(j)]); sum += c; cnt += (c > 0u) ? 1u : 0u; mine = (j == x) ? c : mine; }
        if (sum == G) break;
        __builtin_amdgcn_s_sleep(1);
        if ((++sp & 255u) == 0u) { if (xb_ld(&bar[XB_TMO])) break; if (sp > XB_SPIN_CAP) { atomicAdd(&bar[XB_TMO], 1u); break; } }
    }
    nloc = mine > 0u ? mine : 1u; nx = cnt > 0u ? cnt : 1u;
}

__device__ __forceinline__ void xcd_barrier(const XcdBarrier& b) {
    asm volatile("s_waitcnt vmcnt(0)" ::: "memory");
    __syncthreads();
    if (threadIdx.x == 0) {
        unsigned* bar = b.bar;
        __builtin_amdgcn_s_waitcnt(0);
        unsigned nloc = b.st[0], nx = b.st[1];
        if (nloc == 0u) { xcd_barrier_complete(bar, b.x, nloc, nx); b.st[0] = nloc; b.st[1] = nx; }
        const unsigned old = xb_add(&bar[XB_XSUB(b.x)], 1u);
        const unsigned gen = old / nloc;
        if (old + 1u == (gen + 1u) * nloc) {
            __builtin_amdgcn_fence(__ATOMIC_RELEASE, "agent");
            asm volatile("s_waitcnt vmcnt(0)" ::: "memory");
            const unsigned og = xb_add(&bar[XB_TOP], 1u);
            const unsigned tg = og / nx;
            if (og + 1u == (tg + 1u) * nx) xb_add(&bar[XB_TOPGEN], 1u);
            else XB_SPIN(xb_ld(&bar[XB_TOPGEN]) == tg, bar);
            __builtin_amdgcn_fence(__ATOMIC_ACQUIRE, "agent");
            xb_add(&bar[XB_XGEN(b.x)], 1u);
            asm volatile("s_waitcnt vmcnt(0)" ::: "memory");
        } else {
            XB_SPIN(xb_ld(&bar[XB_XGEN(b.x)]) == gen, bar);
            __builtin_amdgcn_fence(__ATOMIC_ACQUIRE, "agent");
            asm volatile("s_waitcnt vmcnt(0)" ::: "memory");
        }
    }
    __syncthreads();
}

typedef float f32x16 __attribute__((ext_vector_type(16)));
template <int I> __device__ __forceinline__ const float* karg() {
    const float* p;
    asm volatile("s_load_dwordx2 %0, %1, %2\n\ts_waitcnt lgkmcnt(0)" : "=s"(p) : "s"(__builtin_amdgcn_kernarg_segment_ptr()), "n"(I * 8) : "memory");
    return p;
}
struct Args { const float* in[26]; float* out; unsigned char* ws; int ph_lo, ph_hi; };
struct Frame {
    LAS unsigned char* lds;
    volatile LAS unsigned* MISC;
    gu32* ctl;
    unsigned char* ws;
    int tid, lane, wave, c, G;
    float* out;
};
#define WSP(T, off) ((T*)(F.ws + (off)))
__device__ __forceinline__ float wave_sum(float v) {
#pragma unroll
    for (int o = 1; o < 64; o <<= 1) v += __shfl_xor(v, o);
    return v;
}
__device__ __forceinline__ float bfbits2f(unsigned short s) { return __uint_as_float(((unsigned)s) << 16); }

__device__ __forceinline__ int frag_off(int r, int k) { return (k >> 4) * 512 + ((k >> 3) & 1) * 256 + r * 8 + (k & 7); }
__device__ __forceinline__ int map_swiglu(int c) { return c < FF ? 256 * (c >> 7) + (c & 127) : 256 * ((c - FF) >> 7) + 128 + ((c - FF) & 127); }
__device__ __forceinline__ int map_head(int c) { return (c & ~255) + 128 * ((c >> 5) & 1) + 32 * ((c >> 6) & 3) + (c & 31); }


template <int NPP, int BASE> struct KStream {
    static constexpr int NX = 1;
    unsigned char* ws; int c; bool on;
    int voff, voffe;
    f32x4 b0, b1, b2, b3, acc;
    const float* cur; const float* curB; int stride; float* dst;
    __device__ __forceinline__ void init(unsigned char* ws_, int c_, bool on_, int wave, int lane) {
        ws = ws_; c = c_; on = on_; voff = (wave >> 1) * 32 * 512 + (wave & 1) * 256 + 4 * lane; voffe = voff & 255;
        b0 = (f32x4){0.f, 0.f, 0.f, 0.f}; b1 = b0; b2 = b0; b3 = b0; acc = b0; cur = (const float*)(ws_ + WS_CTL) + CW_ZERO; curB = cur; stride = 0; dst = nullptr; }
    __device__ __forceinline__ void flush() {
        float* d = dst + ((voff >> 8) & 1) * 256 + ((voff & 255) >> 2);
        atomicAdd(d, acc[0]); atomicAdd(d + 64, acc[1]); atomicAdd(d + 128, acc[2]); atomicAdd(d + 192, acc[3]); }
    __device__ __forceinline__ f32x4 xload() const { f32x4 r; asm volatile("s_nop 4\n\tglobal_load_dwordx4 %0, %1, %2 nt" : "=v"(r) : "v"(voffe * 4), "s"(cur) : "memory"); return r; }
    __device__ __forceinline__ void wait() { asm volatile("s_waitcnt vmcnt(10)" : "+v"(b0), "+v"(b1), "+v"(b2), "+v"(b3) :: "memory"); }
    __device__ __forceinline__ void start_a() { b2 = xload(); }
    __device__ __forceinline__ void start() { b3 = xload(); }
    __device__ __forceinline__ void begin_unit(const int ui) {
        if (ui == 0) asm volatile("s_waitcnt vmcnt(0)" : "+v"(b0), "+v"(b1), "+v"(b2), "+v"(b3) :: "memory"); else asm volatile("" : "+v"(b0), "+v"(b1), "+v"(b2), "+v"(b3) :: "memory");
        acc += b0; acc += b1; acc += b2; acc += b3; b0 = (f32x4){0.f, 0.f, 0.f, 0.f}; b1 = b0; b2 = b0; b3 = b0;
        if (dst) flush();
        acc = (f32x4){0.f, 0.f, 0.f, 0.f};
        const int idx = BASE + (ui * 256 + c) * NPP; const float* zero = (const float*)(ws + WS_CTL) + CW_ZERO;
        if (on && idx + NPP <= 2048) { const int* pt = (const int*)karg<8>(); const float* ck = karg<3>();
            const int pa = __builtin_amdgcn_readfirstlane(pt[idx]), pb = __builtin_amdgcn_readfirstlane(pt[idx + NPP - 1]);
            cur = ck + (size_t)pa * (PAGE * 512); curB = ck + (size_t)pb * (PAGE * 512); stride = 512; voffe = voff;
            dst = (float*)(ws + WS_SKSUM) + (size_t)((idx >> 6) * 32 + ((idx & 63) >> 1)) * 512; }
        else { cur = zero; curB = zero; stride = 0; voffe = voff & 255; dst = nullptr; }
    }
    template <int SEL> __device__ __forceinline__ void sp(const int s, const int) {
        acc += SEL == 0 ? b0 : (SEL == 1 ? b1 : (SEL == 2 ? b2 : b3));
        if (NPP == 2) { if (s == 32) cur = curB; }
        if (s == NPP * 32) { cur = (const float*)(ws + WS_CTL) + CW_ZERO; stride = 0; voffe = voff & 255; }
        const f32x4 v = xload(); cur += stride;
        if (SEL == 0) b0 = v; else if (SEL == 1) b1 = v; else if (SEL == 2) b2 = v; else b3 = v;
    }
    __device__ __forceinline__ void finish() { asm volatile("s_waitcnt vmcnt(0)" : "+v"(b0), "+v"(b1), "+v"(b2), "+v"(b3) :: "memory"); acc += b0; acc += b1; acc += b2; acc += b3; if (dst) flush(); dst = nullptr; }
};

__device__ __forceinline__ void p0_transpose_item(const float* W, int K, int N, bf16* WT, int prow0, const float* gain, LAS float* scr, int k0, int n0, int lane) {
    const int r8 = lane >> 3, c4 = lane & 7;
    f32x4 w[8]; float gk[8];
#pragma unroll
    for (int i = 0; i < 8; ++i) { const int kk = 8 * i + r8; w[i] = __builtin_nontemporal_load((const f32x4*)(W + (size_t)(k0 + kk) * N + n0 + 4 * c4)); gk[i] = gain ? gain[k0 + kk] : 1.0f; }
#pragma unroll
    for (int i = 0; i < 8; ++i) { const int kk = 8 * i + r8; LAS float* d = scr + kk * 33 + 4 * c4; d[0] = w[i][0] * gk[i]; d[1] = w[i][1] * gk[i]; d[2] = w[i][2] * gk[i]; d[3] = w[i][3] * gk[i]; }
    LDS_WAIT(); asm volatile("" ::: "memory");
    const int c = lane & 7;
#pragma unroll
    for (int j = 0; j < 4; ++j) { const int n = (lane >> 3) + 8 * j; const LAS float* s = scr + (8 * c) * 33 + n;
        v4u o; o.x = pk2(s[0 * 33], s[1 * 33]); o.y = pk2(s[2 * 33], s[3 * 33]); o.z = pk2(s[4 * 33], s[5 * 33]); o.w = pk2(s[6 * 33], s[7 * 33]);
        *(GAS v4u*)(WT + (size_t)(prow0 + n) * K + k0 + 8 * c) = o; }
    LDS_WAIT(); asm volatile("" ::: "memory");
}
template <int NR> __device__ __forceinline__ void rows_to_bf16(Frame& F, const float* x, bf16* o, float* ssq, const int m0, const int step) {
    f32x4 v[NR][4];
#pragma unroll
    for (int r = 0; r < NR; ++r)
#pragma unroll
        for (int j = 0; j < 4; ++j) v[r][j] = __builtin_nontemporal_load((const f32x4*)(x + (size_t)(m0 + r * step) * DM) + F.lane + 64 * j);
#pragma unroll
    for (int r = 0; r < NR; ++r) { float s = 0.f;
#pragma unroll
        for (int j = 0; j < 4; ++j) s += (v[r][j].x * v[r][j].x + v[r][j].y * v[r][j].y) + (v[r][j].z * v[r][j].z + v[r][j].w * v[r][j].w);
        s = wave_sum(s);
        GAS unsigned long long* o8 = (GAS unsigned long long*)(o + (size_t)(m0 + r * step) * DM) + F.lane;
#pragma unroll
        for (int j = 0; j < 4; ++j) o8[64 * j] = (unsigned long long)pk2(v[r][j].x, v[r][j].y) | ((unsigned long long)pk2(v[r][j].z, v[r][j].w) << 32);
        if (F.lane == 0) ssq[m0 + r * step] = s; }
}
constexpr int CV_A = (DM / 64) * (FF2 / 32), CV_B = (FF / 64) * (DM / 32), CV_IN = (DM / 64) * (INC / 32), CV_OUT = (DM / 64) * (DM / 32), CV_MEM = (DM / 64) * (512 / 32);
constexpr int CV_EARLY = CV_A + CV_MEM, CV_MID = CV_EARLY + CV_A + CV_B + CV_IN + CV_OUT, CV_ALL = CV_MID + CV_B;
__device__ __forceinline__ void convert_items(Frame& F, const int first, const int last, const int w, const int nw) {
    LAS float* scr = (LAS float*)(F.lds + RING_OFF + F.wave * 16384);
    for (int it = first + w; it < last; it += nw) {
        int r = it;
        if (r < CV_A) { const int nblk = FF2 / 32, kb = r / nblk, nb = r % nblk; p0_transpose_item(karg<10>(), DM, FF2, WSP(bf16, WS_W1A), map_swiglu(32 * nb), karg<9>(), scr, 64 * kb, 32 * nb, F.lane); continue; }
        r -= CV_A;
        if (r < CV_MEM) { const int nblk = 512 / 32, kb = r / nblk, nb = r % nblk; p0_transpose_item(karg<19>(), DM, 512, WSP(bf16, WS_WMEM), map_head(32 * nb), karg<18>(), scr, 64 * kb, 32 * nb, F.lane); continue; }
        r -= CV_MEM;
        if (r < CV_A) { const int nblk = FF2 / 32, kb = r / nblk, nb = r % nblk; p0_transpose_item(karg<24>(), DM, FF2, WSP(bf16, WS_W2A), map_swiglu(32 * nb), karg<23>(), scr, 64 * kb, 32 * nb, F.lane); continue; }
        r -= CV_A;
        if (r < CV_B) { const int nblk = DM / 32, kb = r / nblk, nb = r % nblk; p0_transpose_item(karg<11>(), FF, DM, WSP(bf16, WS_W1B), 32 * nb, nullptr, scr, 64 * kb, 32 * nb, F.lane); continue; }
        r -= CV_B;
        if (r < CV_IN) { const int nblk = INC / 32, kb = r / nblk, nb = r % nblk; p0_transpose_item(karg<13>(), DM, INC, WSP(bf16, WS_WIN), map_head(32 * nb), karg<12>(), scr, 64 * kb, 32 * nb, F.lane); continue; }
        r -= CV_IN;
        if (r < CV_OUT) { const int nblk = DM / 32, kb = r / nblk, nb = r % nblk; p0_transpose_item(karg<22>(), DM, DM, WSP(bf16, WS_WOUT), 32 * nb, nullptr, scr, 64 * kb, 32 * nb, F.lane); continue; }
        r -= CV_OUT;
        { const int nblk = DM / 32, kb = r / nblk, nb = r % nblk; p0_transpose_item(karg<25>(), FF, DM, WSP(bf16, WS_W2B), 32 * nb, nullptr, scr, 64 * kb, 32 * nb, F.lane); }
    }
}
__device__ __forceinline__ void p0_prologue(Frame& F) {
    const int gw = F.c * NWAVES + F.wave, NGW = F.G * NWAVES;
    if (F.c < 128) {
        const int* pt = (const int*)karg<8>(); const float* ck = karg<3>(); float* sks = WSP(float, WS_SKSUM);
        const int idx = 1920 + F.c, phys = pt[idx]; const int voff = (F.wave >> 1) * 32 * 512 + (F.wave & 1) * 256 + 4 * F.lane;
        const float* base = ck + (size_t)phys * (PAGE * 512) + voff; f32x4 a = {0.f, 0.f, 0.f, 0.f};
#pragma unroll 16
        for (int r = 0; r < 32; ++r) a += __builtin_nontemporal_load((const f32x4*)(base + (size_t)r * 512));
        float* d = sks + (size_t)((idx >> 6) * 32 + ((idx & 63) >> 1)) * 512 + (F.wave & 1) * 256 + F.lane;
        atomicAdd(d, a[0]); atomicAdd(d + 64, a[1]); atomicAdd(d + 128, a[2]); atomicAdd(d + 192, a[3]);
    }
    convert_items(F, 0, CV_EARLY, gw, NGW);
    { const float* xin_ = karg<0>(); const float* min_ = karg<2>();
    for (int m = gw; m + 3 * NGW < MP; m += 4 * NGW) rows_to_bf16<4>(F, xin_, WSP(bf16, WS_XB), WSP(float, WS_SSQ0), m, NGW);
    for (int m = gw; m < MM; m += NGW) rows_to_bf16<1>(F, min_, WSP(bf16, WS_MNB), WSP(float, WS_SSQ0) + MP, m, NGW); }
    if (F.c == 0 && F.tid < 256) { const int w = F.tid >> 6, d = F.tid & 63; const float* src = w == 0 ? karg<16>() : (w == 1 ? karg<17>() : (w == 2 ? karg<20>() : karg<21>())); WSP(float, WS_GAIN)[F.tid] = src[d]; }
    if (F.c == 255) { const float* xs = karg<1>(); bf16* img = WSP(bf16, S_IMGX); float* sq = (float*)(F.ws + WS_CTL) + CW_SSQS;
#pragma unroll
        for (int i = 0; i < 4; ++i) { const int r = F.wave * 4 + i; float ss = 0.f;
#pragma unroll
            for (int j = 0; j < 4; ++j) { const int k = j * 256 + 4 * F.lane; const f32x4 v = *(const f32x4*)(xs + r * DM + k); ss += (v.x * v.x + v.y * v.y) + (v.z * v.z + v.w * v.w);
                *(unsigned long long*)(img + frag_off(r, k)) = (unsigned long long)pk2(v.x, v.y) | ((unsigned long long)pk2(v.z, v.w) << 32); }
            ss = wave_sum(ss); if (F.lane == 0) sq[r] = ss; } }
    for (int i = F.c * 512 + F.tid; i < (SEQ + 1) * 8; i += F.G * 512) { const int p = i >> 3, f = i & 7; const float pos = (p == SEQ) ? (float)PAST : (float)p;
        const float inv = powf(500000.0f, -(float)f * 0.125f); const float ang = pos * inv;
        const double kk = rint((double)ang * 0.15915494309189535); const float rr = (float)((double)ang - kk * 6.283185307179586);
        float* rp = WSP(float, WS_ROPE) + (size_t)i * 2; rp[0] = cosf(rr); rp[1] = sinf(rr); }
}

template <int UNR, class AL, class BR, class EP>
__device__ __forceinline__ void sgemm_unit(Frame& F, const AL& al, const BR& br, const bf16* Bt, const int K, const EP& ep) {
    LAS float* red = (LAS float*)(F.lds + RING_OFF);
    LAS unsigned char* bbuf = F.lds + RING_OFF + F.wave * 16384;
    const int r32 = F.lane & 31, hi = F.lane >> 5, nch = K >> 6, c0 = (nch * F.wave) >> 3, c1 = (nch * (F.wave + 1)) >> 3;
    f32x16 acc0 = {}, acc1 = {};
    const int srow = F.lane >> 3, spc = F.lane & 7;
    const bf16* gsrc[8];
#pragma unroll
    for (int i = 0; i < 8; ++i) { const int row = 8 * i + srow; gsrc[i] = Bt + (size_t)br(row >> 5, row & 31) * K + spc * 8; }
    v4u stg[8];
#pragma unroll
    for (int i = 0; i < 8; ++i) stg[i] = *(const v4u*)(gsrc[i] + c0 * 64);
    for (int c = c0; c < c1; ++c) {
        bf16x8 a[4];
#pragma unroll
        for (int st = 0; st < 4; ++st) a[st] = al(r32, c * 64 + st * 16 + 8 * hi);
#pragma unroll
        for (int i = 0; i < 8; ++i) *(LAS v4u*)(bbuf + (8 * i + srow) * 144 + spc * 16) = stg[i];
        if (c + 1 < c1) {
#pragma unroll
            for (int i = 0; i < 8; ++i) stg[i] = *(const v4u*)(gsrc[i] + (c + 1) * 64); }
#pragma unroll
        for (int st = 0; st < 4; ++st) { const bf16x8 b0 = *(const LAS bf16x8*)(bbuf + r32 * 144 + st * 32 + hi * 16), b1 = *(const LAS bf16x8*)(bbuf + (32 + r32) * 144 + st * 32 + hi * 16);
            acc0 = __builtin_amdgcn_mfma_f32_32x32x16_bf16(a[st], b0, acc0, 0, 0, 0); acc1 = __builtin_amdgcn_mfma_f32_32x32x16_bf16(a[st], b1, acc1, 0, 0, 0); }
    }
    __syncthreads();
#pragma unroll
    for (int r = 0; r < 16; ++r) { const int row = (r & 3) + 8 * (r >> 2) + 4 * hi; red[(F.wave * 32 + row) * 64 + r32] = acc0[r]; red[(F.wave * 32 + row) * 64 + 32 + r32] = acc1[r]; }
    __syncthreads();
    const int row = F.tid >> 4, c4 = (F.tid & 15) * 4; f32x4 s = {0.f, 0.f, 0.f, 0.f};
#pragma unroll
    for (int w = 0; w < 8; ++w) s += *(const LAS f32x4*)(red + (w * 32 + row) * 64 + c4);
    ep(row, c4, s);
    __syncthreads();
}
__device__ __forceinline__ bf16x8 pack_bf16x8(const f32x4 a, const f32x4 b) { v4u w; w.x = pk2(a[0], a[1]); w.y = pk2(a[2], a[3]); w.z = pk2(b[0], b[1]); w.w = pk2(b[2], b[3]); return __builtin_bit_cast(bf16x8, w); }
struct ALLds { const LAS bf16* img;
    __device__ __forceinline__ bf16x8 operator()(int r, int k) const { return *(const LAS bf16x8*)(img + frag_off(r, k)); } };
struct ALFrag { const bf16* img;
    __device__ __forceinline__ bf16x8 operator()(int r, int k) const { return *(const bf16x8*)(img + frag_off(r, k)); } };
__device__ __forceinline__ void stage_a_lds(Frame& F, const float* x, const int ld, const LAS float* rs, LAS bf16* img) {
    f32x4 v[16];
#pragma unroll
    for (int j = 0; j < 16; ++j) { const int idx = F.tid + 512 * j, r = idx >> 8, k4 = (idx & 255) * 4; v[j] = *(const f32x4*)(x + r * ld + k4); }
#pragma unroll
    for (int j = 0; j < 16; ++j) { const int idx = F.tid + 512 * j, r = idx >> 8, k4 = (idx & 255) * 4; const float sc = rs ? rs[r] : 1.0f;
        *(LAS unsigned long long*)(img + frag_off(r, k4)) = (unsigned long long)pk2(v[j].x * sc, v[j].y * sc) | ((unsigned long long)pk2(v[j].z * sc, v[j].w * sc) << 32); }
    __syncthreads();
}
__device__ __forceinline__ void sample_rs(Frame& F, const float* x, LAS float* rs) {
#pragma unroll
    for (int i = 0; i < 4; ++i) { const int r = F.wave * 4 + i; float s = 0.f;
#pragma unroll
        for (int j = 0; j < 4; ++j) { const f32x4 v = *(const f32x4*)(x + r * DM + j * 256 + 4 * F.lane); s += (v.x * v.x + v.y * v.y) + (v.z * v.z + v.w * v.w); }
        s = wave_sum(s); if (F.lane == 0) rs[r] = 1.0f / sqrtf(s * (1.0f / DM) + RMS_EPS); }
    __syncthreads();
}
struct BRSwiglu { int v; __device__ __forceinline__ int operator()(int cb, int c) const { return 256 * (v >> 2) + 32 * (v & 3) + 128 * cb + c; } };
struct BRPlain { int v; __device__ __forceinline__ int operator()(int cb, int c) const { return 64 * v + 32 * cb + c; } };
struct BRHead { int v; __device__ __forceinline__ int operator()(int cb, int c) const { return 256 * (v >> 2) + 128 * cb + 32 * (v & 3) + c; } };
struct EPSwigluFrag { bf16* img; int v; const float* ssq;
    __device__ __forceinline__ void operator()(int row, int c4, f32x4 s) const {
        s = s * (1.0f / sqrtf(ssq[row] * (1.0f / DM) + RMS_EPS));
        f32x4 u; u.x = __shfl_xor(s.x, 8); u.y = __shfl_xor(s.y, 8); u.z = __shfl_xor(s.z, 8); u.w = __shfl_xor(s.w, 8);
        if (c4 < 32) { const int k = 32 * v + c4;
            *(unsigned long long*)(img + frag_off(row, k)) = (unsigned long long)pk2(pg8::silu_f(s.x) * u.x, pg8::silu_f(s.y) * u.y) | ((unsigned long long)pk2(pg8::silu_f(s.z) * u.z, pg8::silu_f(s.w) * u.w) << 32); } } };
template <int KIND> struct EPResid { unsigned char* ws; float* outp; const float* xs; int v;
    __device__ __forceinline__ void operator()(int row, int c4, f32x4 s) const { const int o = row * DM + 64 * v + c4;
        const float* base = KIND == 2 ? xs : (const float*)(ws + (KIND == 5 ? S_X1 : S_X2)); float* out = KIND == 2 ? (float*)(ws + S_X1) : (KIND == 5 ? (float*)(ws + S_X2) : outp + O_YS);
        const float alpha = KIND == 5 ? 1.0f : 0.5f;
        const f32x4 r = *(const f32x4*)(base + o) + alpha * s; *(f32x4*)(out + o) = r;
        if (KIND != 7) { bf16* img = (bf16*)(ws + (KIND == 2 ? S_IMGX1 : S_IMGX2)); float* ssq = (float*)(ws + WS_CTL) + CW_SSQS + (KIND == 2 ? 32 : 64);
            *(unsigned long long*)(img + frag_off(row, 64 * v + c4)) = (unsigned long long)pk2(r.x, r.y) | ((unsigned long long)pk2(r.z, r.w) << 32);
            float ss = (r.x * r.x + r.y * r.y) + (r.z * r.z + r.w * r.w); ss += __shfl_xor(ss, 1); ss += __shfl_xor(ss, 2); ss += __shfl_xor(ss, 4); ss += __shfl_xor(ss, 8);
            if ((c4 >> 2) == 0) atomicAdd(ssq + row, ss); } } };
struct EPProjS { int v; unsigned char* ws; float* outp; const float* ssq;
    __device__ __forceinline__ void operator()(int row, int c4, f32x4 s) const {
        s = s * (1.0f / sqrtf(ssq[row] * (1.0f / DM) + RMS_EPS));
        if (v < 4) { *(f32x4*)((float*)(ws + S_U) + row * 256 + 64 * v + c4) = s; return; }
        if (v >= 20 && v < 28) { *(f32x4*)(outp + O_VS + row * 512 + 64 * (v - 20) + c4) = s; return; }
        float ss = (s.x * s.x + s.y * s.y) + (s.z * s.z + s.w * s.w);
        ss += __shfl_xor(ss, 1); ss += __shfl_xor(ss, 2); ss += __shfl_xor(ss, 4); ss += __shfl_xor(ss, 8);
        const float hn = 1.0f / sqrtf(ss * (1.0f / 64.0f) + RMS_EPS);
        const float* g = (const float*)(ws + WS_GAIN) + ((v < 12) ? 0 : (v < 20 ? 64 : 128));
        const f32x4 gv = *(const f32x4*)(g + c4); s = s * hn * gv;
        if (v < 20) {
            const float* rope8192 = (const float*)(ws + WS_ROPE) + SEQ * 16;
            f32x4 y; y.x = __shfl_xor(s.x, 2); y.y = __shfl_xor(s.y, 2); y.z = __shfl_xor(s.z, 2); y.w = __shfl_xor(s.w, 2);
            if (c4 < 16) { const int f0 = c4 & 7; const float sg = (c4 < 8) ? -1.f : 1.f; f32x4 r_;
#pragma unroll
                for (int i = 0; i < 4; ++i) { const float cs_ = rope8192[2 * (f0 + i)], sn = rope8192[2 * (f0 + i) + 1]; r_[i] = s[i] * cs_ + sg * y[i] * sn; }
                s = r_; }
        }
        if (v < 12) *(f32x4*)((float*)(ws + S_Q) + row * 512 + 64 * (v - 4) + c4) = s;
        else if (v < 20) *(f32x4*)(outp + O_KS + row * 512 + 64 * (v - 12) + c4) = s;
        else *(f32x4*)((float*)(ws + S_QM) + row * 256 + 64 * (v - 28) + c4) = s;
    } };

__device__ __forceinline__ void pool_unit(Frame& F, const int pm, const int g) {
    const bf16* U = WSP(bf16, WS_U); bf16* MIX = WSP(bf16, WS_MIX); const float* pw = karg<14>() + g * 4096; const float* psc = karg<15>() + 64 * g;
    const int r32 = F.lane & 31, hi = F.lane >> 5, row = pm * 256 + F.wave * 32 + r32, t = row & (SEQ - 1), W = 2 << g;
    const int cnt = (t + 1 < W) ? t + 1 : W; const float rc = 1.0f / (float)cnt;
    bf16x8 bfr[4][2];
#pragma unroll
    for (int s = 0; s < 4; ++s)
#pragma unroll
        for (int cb = 0; cb < 2; ++cb) { float w[8];
#pragma unroll
            for (int j = 0; j < 8; ++j) w[j] = pw[(16 * s + 8 * hi + j) * 64 + 32 * cb + r32];
            v4u p; p.x = pk2(w[0], w[1]); p.y = pk2(w[2], w[3]); p.z = pk2(w[4], w[5]); p.w = pk2(w[6], w[7]); bfr[s][cb] = __builtin_bit_cast(bf16x8, p); }
    f32x16 acc0 = {}, acc1 = {};
#pragma unroll
    for (int s = 0; s < 4; ++s) { const bf16* up = U + (size_t)row * 256 + 64 * g + 16 * s + 8 * hi;
        bf16x8 xw[16];
#pragma unroll
        for (int i = 0; i < 16; ++i) if (i < W) xw[i] = *(const bf16x8*)(up - (size_t)((i < cnt) ? i : 0) * 256);
        float sum[8], self[8];
#pragma unroll
        for (int j = 0; j < 8; ++j) { self[j] = bfbits2f((unsigned short)xw[0][j]); sum[j] = self[j]; }
#pragma unroll
        for (int i = 1; i < 16; ++i) if (i < W) { const float wgt = (i < cnt) ? 1.f : 0.f;
#pragma unroll
            for (int j = 0; j < 8; ++j) sum[j] += wgt * bfbits2f((unsigned short)xw[i][j]); }
        v4u p;
        p.x = pk2(sum[0] * rc - self[0], sum[1] * rc - self[1]); p.y = pk2(sum[2] * rc - self[2], sum[3] * rc - self[3]); p.z = pk2(sum[4] * rc - self[4], sum[5] * rc - self[5]); p.w = pk2(sum[6] * rc - self[6], sum[7] * rc - self[7]);
        const bf16x8 a = __builtin_bit_cast(bf16x8, p);
        acc0 = __builtin_amdgcn_mfma_f32_32x32x16_bf16(a, bfr[s][0], acc0, 0, 0, 0); acc1 = __builtin_amdgcn_mfma_f32_32x32x16_bf16(a, bfr[s][1], acc1, 0, 0, 0); }
    const float sc0 = psc[r32], sc1 = psc[32 + r32];
    bf16* ob = MIX + (size_t)(pm * 256 + F.wave * 32) * DM + 64 * g;
#pragma unroll
    for (int r = 0; r < 16; ++r) { const int orow = (r & 3) + 8 * (r >> 2) + 4 * hi; ob[(size_t)orow * DM + r32] = (bf16)f2bf(acc0[r] * sc0); ob[(size_t)orow * DM + 32 + r32] = (bf16)f2bf(acc1[r] * sc1); }
}

template <int PER, int CH, class KPF, class VPF>
__device__ __forceinline__ void dec_attn(Frame& F, const float* q, const KPF& KP, const VPF& VP, const float* xk, const float* xv, float* outp, bf16* imgp, const int irow, const int icol) {
    LAS float* st = (LAS float*)(F.lds + RING_OFF);
    const int l16 = F.lane & 15, grp = F.wave * 4 + (F.lane >> 4);
    f32x4 q4 = *(const f32x4*)(q + 4 * l16); q4 = q4 * C2;
    float m = -INFINITY, l = 0.f; f32x4 o = {0.f, 0.f, 0.f, 0.f};
#pragma unroll
    for (int c0 = 0; c0 < PER; c0 += CH) {
        f32x4 kv[CH], vv[CH]; float d[CH];
#pragma unroll
        for (int it = 0; it < CH; ++it) { const int i = grp * PER + c0 + it; kv[it] = *(const f32x4*)(KP(i) + 4 * l16); vv[it] = *(const f32x4*)(VP(i) + 4 * l16); }
        float mc = -INFINITY;
#pragma unroll
        for (int it = 0; it < CH; ++it) { float x = (q4.x * kv[it].x + q4.y * kv[it].y) + (q4.z * kv[it].z + q4.w * kv[it].w);
            x += __shfl_xor(x, 1); x += __shfl_xor(x, 2); x += __shfl_xor(x, 4); x += __shfl_xor(x, 8); d[it] = x; mc = fmaxf(mc, x); }
        const float mn = fmaxf(m, mc), f = __builtin_amdgcn_exp2f(m - mn); l *= f; o = o * f; m = mn;
#pragma unroll
        for (int it = 0; it < CH; ++it) { const float p = __builtin_amdgcn_exp2f(d[it] - mn); l += p; o = o + p * vv[it]; }
    }
    if (l16 == 0) { st[grp * 68] = m; st[grp * 68 + 1] = l; }
    *(LAS f32x4*)(st + grp * 68 + 4 + 4 * l16) = o;
    if (F.wave == 0 && F.lane < 16) {
        if (xk) { const f32x4 kx = *(const f32x4*)(xk + 4 * l16); float x = (q4.x * kx.x + q4.y * kx.y) + (q4.z * kx.z + q4.w * kx.w);
            x += __shfl_xor(x, 1); x += __shfl_xor(x, 2); x += __shfl_xor(x, 4); x += __shfl_xor(x, 8);
            if (l16 == 0) { st[32 * 68] = x; st[32 * 68 + 1] = 1.f; } *(LAS f32x4*)(st + 32 * 68 + 4 + 4 * l16) = *(const f32x4*)(xv + 4 * l16); }
        else { if (l16 == 0) { st[32 * 68] = -INFINITY; st[32 * 68 + 1] = 0.f; } *(LAS f32x4*)(st + 32 * 68 + 4 + 4 * l16) = (f32x4){0.f, 0.f, 0.f, 0.f}; }
    }
    __syncthreads();
    if (F.tid < 64) { float M = -INFINITY;
#pragma unroll
        for (int i = 0; i < 33; ++i) M = fmaxf(M, st[i * 68]);
        float L = 0.f, O = 0.f;
#pragma unroll
        for (int i = 0; i < 33; ++i) { const float e = __builtin_amdgcn_exp2f(st[i * 68] - M); L += st[i * 68 + 1] * e; O += st[i * 68 + 4 + F.tid] * e; }
        outp[F.tid] = O / L; if (imgp) imgp[frag_off(irow, icol + F.tid)] = (bf16)f2bf(O / L); }
    __syncthreads();
}
struct KPaged { const float* base; unsigned long long pa; unsigned pb; int hoff;
    __device__ __forceinline__ const float* operator()(int i) const { const int sl = i >> 7; const unsigned long long w = sl < 4 ? pa : (unsigned long long)pb; const unsigned page = (unsigned)(w >> (16 * (sl & 3))) & 0xffffu; return base + ((size_t)page * PAGE + (i & 127)) * 512 + hoff; } };
struct KLin { const float* base; int ld; __device__ __forceinline__ const float* operator()(int i) const { return base + (size_t)i * ld; } };

__device__ __forceinline__ void sample_item(Frame& F, const int item) {
    float* smix = WSP(float, S_MIX);
    if (item < 256) {
        const int b = item >> 3, h = item & 7; const float* q = WSP(float, S_Q) + b * 512 + h * 64;
        const int myp = ((const int*)karg<8>())[b * NPG + F.lane];
        const int j = F.lane & 31, hh = F.lane >> 5; float sc = 0.f;
        { const float* sj = WSP(float, WS_SKSUM) + ((size_t)b * 32 + j) * 512 + (h >> 2) * 256 + ((h & 3) * 64 + 32 * hh) / 4;
#pragma unroll
          for (int jj = 0; jj < 4; ++jj) { const f32x4 k0 = *(const f32x4*)(sj + 64 * jj), k1 = *(const f32x4*)(sj + 64 * jj + 4);
            sc += (q[32 * hh + jj] * k0[0] + q[32 * hh + jj + 4] * k0[1]) + (q[32 * hh + jj + 8] * k0[2] + q[32 * hh + jj + 12] * k0[3]) + (q[32 * hh + jj + 16] * k1[0] + q[32 * hh + jj + 20] * k1[1]) + (q[32 * hh + jj + 24] * k1[2] + q[32 * hh + jj + 28] * k1[3]); } }
        sc += __shfl_xor(sc, 32);
        int cntb = 0;
        for (int i = 0; i < 32; ++i) { const float o = __shfl(sc, i); cntb += ((o > sc) || (o == sc && i < j)) ? 1 : 0; }
        const unsigned long long bal = __ballot(cntb < 3 && F.lane < 32);
        const unsigned msk = (unsigned)bal; const int b0 = __builtin_ctz(msk), b1 = __builtin_ctz(msk & (msk - 1)), b2 = __builtin_ctz(msk & (msk - 1) & ((msk & (msk - 1)) - 1));
        const unsigned g0 = (unsigned)__shfl(myp, 2 * b0), g1 = (unsigned)__shfl(myp, 2 * b0 + 1), g2 = (unsigned)__shfl(myp, 2 * b1), g3 = (unsigned)__shfl(myp, 2 * b1 + 1), g4 = (unsigned)__shfl(myp, 2 * b2), g5 = (unsigned)__shfl(myp, 2 * b2 + 1);
        const unsigned long long pa_ = (unsigned long long)g0 | ((unsigned long long)g1 << 16) | ((unsigned long long)g2 << 32) | ((unsigned long long)g3 << 48); const unsigned pb_ = g4 | (g5 << 16);
        const KPaged KPf{karg<3>(), pa_, pb_, h * 64}, VPf{karg<4>(), pa_, pb_, h * 64};
        dec_attn<24, 24>(F, q, KPf, VPf, F.out + O_KS + b * 512 + h * 64, F.out + O_VS + b * 512 + h * 64, smix + b * DM + 256 + h * 64, WSP(bf16, S_IMGMIX), b, 256 + h * 64);
    } else if (item < 384) {
        const int b = (item - 256) >> 2, h = (item - 256) & 3; const float* q = WSP(float, S_QM) + b * 256 + h * 64;
        const KLin KPf{karg<5>() + (size_t)b * MEML * 256 + h * 64, 256}, VPf{karg<6>() + (size_t)b * MEML * 256 + h * 64, 256};
        dec_attn<8, 8>(F, q, KPf, VPf, nullptr, nullptr, smix + b * DM + 768 + h * 64, WSP(bf16, S_IMGMIX), b, 768 + h * 64);
    } else if (item < 416) {
        const int b = item - 384; LAS float* pl = (LAS float*)(F.lds + RING_OFF);
        const float* stp = karg<7>() + (size_t)b * 15 * 256; const float* su = WSP(float, S_U) + b * 256; float* pso = F.out + O_PSS + (size_t)b * 15 * 256;
        if (F.tid < 256) { const int c = F.tid, g = c >> 6, W = 2 << g; const float u = su[c]; float s = u;
            float wv[15];
#pragma unroll
            for (int i = 1; i < 16; ++i) wv[i - 1] = stp[(15 - i) * 256 + c];
#pragma unroll
            for (int i = 1; i < 16; ++i) s += (i < W) ? wv[i - 1] : 0.f;
            pl[c] = s / (float)W - u;
            for (int i = 0; i < 14; ++i) pso[i * 256 + c] = stp[(i + 1) * 256 + c];
            pso[14 * 256 + c] = u; }
        __syncthreads();
        if (F.tid < 256) { const int c = F.tid, g = c >> 6, d = c & 63; const float* pw = karg<14>() + g * 4096; float a = 0.f;
#pragma unroll
            for (int cc = 0; cc < 64; ++cc) a += pl[64 * g + cc] * pw[cc * 64 + d];
            const float y_ = a * karg<15>()[c]; smix[b * DM + c] = y_; WSP(bf16, S_IMGMIX)[frag_off(b, c)] = (bf16)f2bf(y_); }
        __syncthreads();
    }
}

__global__ void __launch_bounds__(NWAVES * 64, 2) hymba_fwd(Args args) {
    extern __shared__ __attribute__((aligned(16))) unsigned char lds[];
    Frame F;
    F.lds = (LAS unsigned char*)lds;
    F.MISC = (volatile LAS unsigned*)(F.lds + MISC_OFF);
    F.tid = threadIdx.x; F.lane = F.tid & 63; F.wave = __builtin_amdgcn_readfirstlane(F.tid >> 6);
    F.G = gridDim.x; F.c = blockIdx.x;
    F.ws = args.ws; F.ctl = (gu32*)(args.ws + WS_CTL); F.out = args.out;
    { int t0_ = F.tid; asm volatile("" : "+v"(t0_));
      for (int u = t0_; u < (ROPE_OFF - LDSCTL_OFF) / 4; u += NWAVES * 64) ((LAS unsigned*)(F.lds + LDSCTL_OFF))[u] = 0u; }
    __syncthreads();
    XcdBarrier bar; bar.bar = (unsigned*)(F.ctl + CW_BAR); bar.x = 0; bar.st = nullptr;
    if (N_LAUNCHES == 1) bar = xcd_barrier_post((unsigned*)(F.ctl + CW_BAR), F.MISC + 8);
#define GRID_BAR() do { if (N_LAUNCHES == 1) xcd_barrier(bar); } while (0)
    const int lo = args.ph_lo, hi = args.ph_hi;
    pg8::NoStream nostream;
#ifdef DBG_ONLY
#define IN(k) ((k) == DBG_ONLY && lo <= (k) && (k) < hi)
#else
#define IN(k) (lo <= (k) && (k) < hi)
#endif
#define rs ((LAS float*)(F.lds + SM_OFF))
#define ssq1 ((float*)(F.ws + WS_CTL) + CW_SSQ1)
#define ssq2 ((float*)(F.ws + WS_CTL) + CW_SSQ2)
#define ksum ((float*)(F.ws + WS_CTL) + CW_KSUM)
#define ssq0 WSP(float, WS_SSQ0)

#define FRESH() do { int t2_ = threadIdx.x, c2_ = blockIdx.x; asm volatile("" : "+v"(t2_)); asm volatile("" : "+s"(c2_)); F.tid = t2_; F.lane = t2_ & 63; F.wave = __builtin_amdgcn_readfirstlane(t2_ >> 6); F.c = c2_; \
        unsigned char* w2_ = args.ws; float* o2_ = args.out; asm volatile("" : "+s"(w2_)); asm volatile("" : "+s"(o2_)); F.ws = w2_; F.out = o2_; F.ctl = (gu32*)(w2_ + WS_CTL); } while (0)
    if (IN(0)) for (int rep_ = 0; rep_ < REP0; ++rep_) { FRESH(); p0_prologue(F); GRID_BAR(); }

    if (IN(1)) for (int rep_ = 0; rep_ < REP1; ++rep_) { FRESH();
        { pg8::Gemm g{WSP(bf16, WS_XB), WSP(bf16, WS_W1A), MP, FF2, DM}; pg8::StaticOrder S; S.init(MP, FF2, F.G, F.c);
          pg8::EpiSwiglu<false> E{WSP(bf16, WS_H), ssq0, FF, {}};
          KStream<1, 0> X; X.init(F.ws, F.c, !(rep_ + 1 < REP1), F.wave, F.lane);
          pg8::gemm_phase<pg8::EpiSwiglu<false>, pg8::StaticOrder, true, true, KStream<1, 0>>(F.lds + RING_OFF, g, S, E, X); }
        if (F.c >= 128 && F.c < 144) { pg8::Gemm g{WSP(bf16, WS_MNB), WSP(bf16, WS_WMEM), MM, 512, DM}; pg8::ListOrder S; S.init(MM / 256, 2, 128, F.c);
          pg8::EpiHead<true> E{ssq0 + MP, nullptr, F.out, nullptr, F.ws, C2};
          pg8::gemm_phase<pg8::EpiHead<true>, pg8::ListOrder, true, true>(F.lds + RING_OFF, g, S, E, nostream); }
        FRESH();
        if (F.c >= 144 && rep_ + 1 == REP1) { convert_items(F, CV_EARLY, CV_MID, (F.c - 144) * NWAVES + F.wave, (256 - 144) * NWAVES); __syncthreads(); }
        if (F.c >= 144 && F.c < 144 + 88) { const int v = F.c - 144;
          sgemm_unit<8>(F, ALFrag{WSP(bf16, S_IMGX)}, BRSwiglu{v}, WSP(bf16, WS_W1A), DM, EPSwigluFrag{WSP(bf16, S_H), v, (const float*)(F.ws + WS_CTL) + CW_SSQS}); }
        GRID_BAR();
    }
    if (IN(2)) for (int rep_ = 0; rep_ < REP2; ++rep_) { FRESH();
        { pg8::Gemm g{WSP(bf16, WS_H), WSP(bf16, WS_W1B), MP, DM, FF}; pg8::StaticOrder S; S.init(MP, DM, F.G, F.c);
          const bool dm_ = (rep_ + 1 < REP2); pg8::EpiResid<1, 2> E{WSP(bf16, WS_XB), dm_ ? WSP(bf16, WS_DUMMY + 64 * MiB) : WSP(bf16, WS_XB), nullptr, dm_ ? WSP(float, WS_DUMMY + 96 * MiB) : ssq1, 0.5f};
          KStream<2, 1408> X; X.init(F.ws, F.c, !(rep_ + 1 < REP2), F.wave, F.lane);
          pg8::gemm_phase<pg8::EpiResid<1, 2>, pg8::StaticOrder, true, true, KStream<2, 1408>>(F.lds + RING_OFF, g, S, E, X); }
        if (F.c >= 240) { const int v = F.c - 240; sgemm_unit<11>(F, ALFrag{WSP(bf16, S_H)}, BRPlain{v}, WSP(bf16, WS_W1B), FF, EPResid<2>{F.ws, F.out, karg<1>(), v}); }
        GRID_BAR();
    }
    if (IN(3)) for (int rep_ = 0; rep_ < REP3; ++rep_) { FRESH();
        { pg8::Gemm g{WSP(bf16, WS_XB), WSP(bf16, WS_WIN), MP, INC, DM}; pg8::StaticOrder S; S.init(MP, INC, F.G, F.c);
          { const int pm0_ = 8 * (F.c & 7) + ((F.c >> 3) & 7);
            const f32x4* src_ = (const f32x4*)(WSP(float, WS_ROPE) + (size_t)((pm0_ * 256) & 2047) * 16); LAS f32x4* dst_ = (LAS f32x4*)(F.lds + ROPE_OFF);
            const f32x4 r0_ = src_[F.tid], r1_ = src_[F.tid + 512]; dst_[F.tid] = r0_; dst_[F.tid + 512] = r1_; }
          __syncthreads();
          pg8::EpiHead<false> E{ssq1, (LAS const float*)(F.lds + ROPE_OFF), F.out, (rep_ + 1 < REP3) ? WSP(float, WS_DUMMY + 96 * MiB) : ksum, F.ws, C2};
          pg8::gemm_phase<pg8::EpiHead<false>, pg8::StaticOrder, true, true>(F.lds + RING_OFF, g, S, E, nostream); }
        if (F.c >= 96 && F.c < 128) { const int v = F.c - 96;
          sgemm_unit<8>(F, ALFrag{WSP(bf16, S_IMGX1)}, BRHead{v}, WSP(bf16, WS_WIN), DM,
                     EPProjS{v, F.ws, F.out, (const float*)(F.ws + WS_CTL) + CW_SSQS + 32}); }
        GRID_BAR();
    }
#ifndef DBG_P4
#define DBG_P4 15
#endif
    if (IN(4)) for (int rep_ = 0; rep_ < REP4; ++rep_) { FRESH();
        if ((DBG_P4 & 8) && ((F.c >> 3) & 3) == 0) { sample_item(F, F.c); if (F.c + 256 < 416) sample_item(F, F.c + 256); }
        FRESH();
        using attn_body::bf16; char* shm = (char*)lds + RING_OFF;
        if (DBG_P4 & 1) { const int bh = F.c >> 2, s = F.c & 3, b = bh >> 3, h = bh & 7;
          const bf16* Qb = (const bf16*)WSP(unsigned short, WS_Q) + (size_t)b * SEQ * 512 + h * 64; const bf16* Kb = (const bf16*)WSP(unsigned short, WS_K) + (size_t)b * SEQ * 512 + h * 64;
          const bf16* Vb = (const bf16*)WSP(unsigned short, WS_V) + (size_t)b * SEQ * 512 + h * 64; bf16* Ob = (bf16*)WSP(unsigned short, WS_MIX) + (size_t)b * SEQ * DM + 256 + h * 64;
          const float* ks = ksum + (size_t)b * 8 * 512 + h * 64;
          LAS unsigned char* selt = (LAS unsigned char*)(F.lds + SM_OFF + 512);
          { const int which = F.tid >> 8, qi = F.tid & 255, qb = which == 0 ? 7 - s : s; unsigned sel = 0x7fu;
            LAS float* ksl = (LAS float*)(F.lds + RING_OFF);
            if (F.tid < 448) ksl[F.tid] = ks[(F.tid >> 6) * 512 + (F.tid & 63)];
            __syncthreads();
            if (qb >= 4) { float sc[7]; float qf[64];
              { const unsigned short* qp = WSP(unsigned short, WS_Q) + ((size_t)b * SEQ + qb * 256 + qi) * 512 + h * 64;
#pragma unroll
                for (int d8 = 0; d8 < 8; ++d8) { const bf16x8 x = *(const bf16x8*)(qp + 8 * d8);
#pragma unroll
                  for (int e = 0; e < 8; ++e) qf[8 * d8 + e] = bfbits2f((unsigned short)x[e]); } }
#pragma unroll
              for (int j = 0; j < 7; ++j) { float a = 0.f; if (j < qb) {
#pragma unroll
                  for (int d4 = 0; d4 < 16; ++d4) { const f32x4 kv = *(const LAS f32x4*)(ksl + j * 64 + 4 * d4); a += (qf[4 * d4] * kv[0] + qf[4 * d4 + 1] * kv[1]) + (qf[4 * d4 + 2] * kv[2] + qf[4 * d4 + 3] * kv[3]); } } else a = -INFINITY;
                sc[j] = a; asm volatile("" : "+v"(a) :: "memory"); }
              sel = 0u;
#pragma unroll
              for (int j = 0; j < 7; ++j) { int cnt = 0;
#pragma unroll
                for (int i = 0; i < 7; ++i) { if (i != j) cnt += ((sc[i] > sc[j]) || (sc[i] == sc[j] && i < j)) ? 1 : 0; }
                if (j < qb && cnt < 3) sel |= (1u << j); } }
            selt[F.tid] = (unsigned char)sel; }
          __syncthreads();
          { const int qb = 7 - s; attn_body::attn_unit<8, 1, 512, 512, DM>(Qb + (size_t)qb * 256 * 512, Kb, Vb, Ob + (size_t)qb * 256 * DM, 4 * qb + 4, selt, shm); }
          { const int qb = s;     attn_body::attn_unit<8, 1, 512, 512, DM>(Qb + (size_t)qb * 256 * 512, Kb, Vb, Ob + (size_t)qb * 256 * DM, 4 * qb + 4, selt + 256, shm); } }
        FRESH();
        if ((DBG_P4 & 8) && ((F.c >> 3) & 3) == 1) { sample_item(F, F.c); if (F.c + 256 < 416) sample_item(F, F.c + 256); }
        FRESH();
        if (DBG_P4 & 2) { const int b = F.c >> 5, hm = (F.c >> 3) & 3, qb = F.c & 7;
          const bf16* Qb = (const bf16*)WSP(unsigned short, WS_QM) + ((size_t)b * SEQ + qb * 256) * 256 + hm * 64; const bf16* Kb = (const bf16*)WSP(unsigned short, WS_MKB) + (size_t)b * MEML * 256 + hm * 64;
          const bf16* Vb = (const bf16*)WSP(unsigned short, WS_MVB) + (size_t)b * MEML * 256 + hm * 64; bf16* Ob = (bf16*)WSP(unsigned short, WS_MIX) + ((size_t)b * SEQ + qb * 256) * DM + 768 + hm * 64;
          attn_body::attn_unit<8, 0, 256, 256, DM>(Qb, Kb, Vb, Ob, 4, nullptr, shm); }
        if ((DBG_P4 & 8) && ((F.c >> 3) & 3) == 2) { sample_item(F, F.c); if (F.c + 256 < 416) sample_item(F, F.c + 256); }
        FRESH();
        if (DBG_P4 & 4) pool_unit(F, F.c >> 2, F.c & 3);
        __syncthreads();
        const int sgrp_ = (F.c >> 3) & 3;
        if ((DBG_P4 & 8) && sgrp_ == 3) { sample_item(F, F.c); if (F.c + 256 < 416) sample_item(F, F.c + 256); }
        GRID_BAR();
    }
    if (IN(5)) for (int rep_ = 0; rep_ < REP5; ++rep_) { FRESH();
        { pg8::Gemm g{WSP(bf16, WS_MIX), WSP(bf16, WS_WOUT), MP, DM, DM}; pg8::StaticOrder S; S.init(MP, DM, F.G, F.c);
          const bool dm_ = (rep_ + 1 < REP5); pg8::EpiResid<1> E{WSP(bf16, WS_XB), dm_ ? WSP(bf16, WS_DUMMY + 64 * MiB) : WSP(bf16, WS_XB), nullptr, dm_ ? WSP(float, WS_DUMMY + 96 * MiB) : ssq2, 1.0f};
          pg8::gemm_phase<pg8::EpiResid<1>, pg8::StaticOrder, true, true>(F.lds + RING_OFF, g, S, E, nostream); }
        if (F.c >= 240) { const int v = F.c - 240; sgemm_unit<8>(F, ALFrag{WSP(bf16, S_IMGMIX)}, BRPlain{v}, WSP(bf16, WS_WOUT), DM, EPResid<5>{F.ws, F.out, nullptr, v}); }
        GRID_BAR();
    }
    if (IN(6)) for (int rep_ = 0; rep_ < REP6; ++rep_) { FRESH();
        if (F.c >= 128 && rep_ + 1 == REP6) { convert_items(F, CV_MID, CV_ALL, (F.c - 128) * NWAVES + F.wave, 128 * NWAVES); __syncthreads(); }
        FRESH();
        { pg8::Gemm g{WSP(bf16, WS_XB), WSP(bf16, WS_W2A), MP, FF2, DM}; pg8::StaticOrder S; S.init(MP, FF2, F.G, F.c);
          pg8::EpiSwiglu<true> E{WSP(bf16, WS_H), ssq2, FF, {}};
          pg8::gemm_phase<pg8::EpiSwiglu<true>, pg8::StaticOrder, true, true>(F.lds + RING_OFF, g, S, E, nostream); }
        if (F.c >= 144 && F.c < 144 + 88) { const int v = F.c - 144;
          sgemm_unit<8>(F, ALFrag{WSP(bf16, S_IMGX2)}, BRSwiglu{v}, WSP(bf16, WS_W2A), DM, EPSwigluFrag{WSP(bf16, S_H), v, (const float*)(F.ws + WS_CTL) + CW_SSQS + 64}); }
        GRID_BAR();
    }
    if (IN(7)) for (int rep_ = 0; rep_ < REP7; ++rep_) { FRESH();
        { pg8::Gemm g{WSP(bf16, WS_H), WSP(bf16, WS_W2B), MP, DM, FF}; pg8::StaticOrder S; S.init(MP, DM, F.G, F.c);
          pg8::EpiResid<0> E{WSP(bf16, WS_XB), nullptr, F.out + O_Y, nullptr, 0.5f};
          pg8::gemm_phase<pg8::EpiResid<0>, pg8::StaticOrder, true, true>(F.lds + RING_OFF, g, S, E, nostream); }
        if (F.c >= 240) { const int v = F.c - 240; sgemm_unit<11>(F, ALFrag{WSP(bf16, S_H)}, BRPlain{v}, WSP(bf16, WS_W2B), FF, EPResid<7>{F.ws, F.out, nullptr, v}); }
    }
#undef IN
#undef GRID_BAR
#undef FRESH
#undef rs
#undef ssq1
#undef ssq2
#undef ksum
#undef ssq0
}

extern "C" void kernel_launch(void* const* d_in, const int* in_sizes, int n_in, void* d_out, int out_size, void* d_ws, size_t ws_size, hipStream_t stream) {
    static int grid = 0;
    if (grid == 0) {
        if (n_in != 26 || (size_t)out_size != O_END || ws_size < WS_END + 128 * MiB) { fprintf(stderr, "kernel_launch: shape mismatch (n_in %d, out %d, ws %zu): nothing launched\n", n_in, out_size, ws_size); grid = -1; return; }
        int dev = 0, cus = 0, per_cu = 0;
        if (hipGetDevice(&dev) != hipSuccess || hipDeviceGetAttribute(&cus, hipDeviceAttributeMultiprocessorCount, dev) != hipSuccess) { grid = -1; return; }
        if (hipFuncSetAttribute((const void*)hymba_fwd, hipFuncAttributeMaxDynamicSharedMemorySize, LDS_BYTES) != hipSuccess) { fprintf(stderr, "kernel_launch: hipFuncSetAttribute failed\n"); grid = -1; return; }
        if (hipOccupancyMaxActiveBlocksPerMultiprocessor(&per_cu, (const void*)hymba_fwd, NWAVES * 64, LDS_BYTES) != hipSuccess || per_cu < 1)
            fprintf(stderr, "kernel_launch: note: occupancy query reports %d workgroups per CU\n", per_cu);
        (void)hipGetLastError();
        grid = cus < 256 ? cus : 256;
    }
    if (grid < 0) return;
    if (hipMemsetAsync((char*)d_ws + WS_CTL, 0, CTL_ZERO_BYTES, stream) != hipSuccess) return;
    Args a{};
    for (int i = 0; i < 26; ++i) a.in[i] = (const float*)d_in[i];
    a.out = (float*)d_out; a.ws = (unsigned char*)d_ws;
    for (int li = 0; li < N_LAUNCHES; ++li) {
        a.ph_lo = (N_LAUNCHES == 1) ? 0 : li; a.ph_hi = (N_LAUNCHES == 1) ? PER_PHASE : li + 1;
        hipLaunchKernelGGL(hymba_fwd, dim3(grid), dim3(NWAVES * 64), LDS_BYTES, stream, a);
        const hipError_t le = hipPeekAtLastError();
        if (le != hipSuccess) { fprintf(stderr, "kernel_launch: launch %d failed: %s\n", li, hipGetErrorName(le)); break; }
    }
}
```

```cpp
#include <hip/hip_runtime.h>
#include <hip/hip_bf16.h>
#include <cstdio>
#include <cstdint>
#include <cmath>
constexpr int NWAVES = 8;
#ifndef MK_N_LAUNCHES
#define MK_N_LAUNCHES 1
#endif
constexpr int PER_PHASE = 8;
constexpr int N_LAUNCHES = MK_N_LAUNCHES;
static_assert(N_LAUNCHES == 1 || N_LAUNCHES == PER_PHASE, "MK_N_LAUNCHES is 1 or 8");

constexpr int DM = 1024, NB = 8, SEQ = 2048, MP = NB * SEQ;
constexpr int NS = 32, PAST = 8192, PAGE = 128, NPG = PAST / PAGE;
constexpr int FF = 2816, FF2 = 2 * FF, INC = 2048, MEML = 256, MM = NB * MEML;
constexpr float RMS_EPS = 1e-6f;
constexpr float C2 = 0.125f * 1.4426950408889634f;
constexpr size_t O_Y = 0, O_YS = O_Y + (size_t)MP * DM, O_KP = O_YS + (size_t)NS * DM, O_VP = O_KP + (size_t)MP * 512, O_MK = O_VP + (size_t)MP * 512, O_MV = O_MK + (size_t)MM * 256,
                 O_PS = O_MV + (size_t)MM * 256, O_KS = O_PS + (size_t)NB * 15 * 256, O_VS = O_KS + (size_t)NS * 512, O_PSS = O_VS + (size_t)NS * 512, O_END = O_PSS + (size_t)NS * 15 * 256;

constexpr size_t MiB = 1u << 20;
constexpr size_t WS_CTL = 0, CTL_ZERO_BYTES = 4 * MiB;
constexpr int CW_TMO = 0, CW_CODE = 1, CW_BAR = 4096;
constexpr int CW_SSQ1 = 16384, CW_SSQ2 = CW_SSQ1 + MP, CW_KSUM = CW_SSQ2 + MP, CW_ZERO = CW_KSUM + NB * 8 * 8 * 64, CW_SKSUM = CW_ZERO + 1024, CW_SSQS = CW_SKSUM + NS * 32 * 512, CW_END = CW_SSQS + 128;
static_assert((size_t)CW_END * 4 <= CTL_ZERO_BYTES, "CTL words inside the memset region");
constexpr size_t WS_W1A = 4 * MiB, WS_W1B = WS_W1A + 11 * MiB, WS_W2A = WS_W1B + 6 * MiB, WS_W2B = WS_W2A + 11 * MiB, WS_WIN = WS_W2B + 6 * MiB, WS_WOUT = WS_WIN + 4 * MiB, WS_WMEM = WS_WOUT + 2 * MiB;
constexpr size_t WS_XB = WS_WMEM + 1 * MiB;
constexpr size_t WS_H = WS_XB + 32 * MiB;
constexpr size_t WS_X1 = WS_H + 88 * MiB;
constexpr size_t WS_U = WS_X1 + 64 * MiB, WS_Q = WS_U + 8 * MiB, WS_K = WS_Q + 16 * MiB, WS_V = WS_K + 16 * MiB, WS_QM = WS_V + 16 * MiB;
constexpr size_t WS_MNB = WS_QM + 8 * MiB, WS_MKB = WS_MNB + 4 * MiB, WS_MVB = WS_MKB + 1 * MiB, WS_MIX = WS_MVB + 1 * MiB;
constexpr size_t WS_ROPE = WS_MIX + 32 * MiB;
constexpr size_t WS_SKSUM = WS_CTL + (size_t)CW_SKSUM * 4;
constexpr size_t WS_SSQ0 = WS_ROPE + 1 * MiB;
constexpr size_t WS_GAIN = WS_SSQ0 + 512 * 1024;
constexpr size_t WS_S = WS_SSQ0 + 1 * MiB;
constexpr size_t S_H = WS_S, S_X1 = S_H + 1 * MiB, S_X2 = S_X1 + 128 * 1024, S_U = S_X2 + 128 * 1024, S_Q = S_U + 32 * 1024, S_QM = S_Q + 64 * 1024, S_MIX = S_QM + 32 * 1024;
constexpr size_t S_IMGX = S_MIX + 128 * 1024, S_IMGX1 = S_IMGX + 64 * 1024, S_IMGX2 = S_IMGX1 + 64 * 1024, S_IMGMIX = S_IMGX2 + 64 * 1024;
constexpr size_t WS_END = S_IMGMIX + 64 * 1024;
static_assert(WS_W1B - WS_W1A >= (size_t)FF2 * DM * 2 && WS_W2A - WS_W1B >= (size_t)DM * FF * 2, "weight copies fit");

#ifndef REP0
#define REP0 1
#endif
#ifndef REP1
#define REP1 1
#endif
#ifndef REP2
#define REP2 1
#endif
#ifndef REP3
#define REP3 1
#endif
#ifndef REP4
#define REP4 1
#endif
#ifndef REP5
#define REP5 1
#endif
#ifndef REP6
#define REP6 1
#endif
#ifndef REP7
#define REP7 1
#endif
constexpr size_t WS_DUMMY = WS_END;
constexpr int RING_OFF = 0, RING_BYTES = 131072;
constexpr int LDSCTL_OFF = RING_BYTES, MISC_OFF = LDSCTL_OFF + 320;
constexpr int SM_OFF = RING_BYTES + 1024;
constexpr int ROPE_OFF = 147456;
constexpr int LDS_BYTES = 163840;
static_assert(MISC_OFF + 128 <= SM_OFF && SM_OFF + 8192 <= ROPE_OFF && ROPE_OFF + 16384 <= LDS_BYTES, "LDS map");


namespace pg8 {
#define PG8_LAS __attribute__((address_space(3)))
typedef unsigned short bf16_t;
typedef short bf16x8 __attribute__((ext_vector_type(8)));
typedef float f32x4 __attribute__((ext_vector_type(4)));
typedef unsigned u32x4 __attribute__((ext_vector_type(4)));
constexpr int BM = 256, BK = 64, HALF = 128, HTB = HALF * BK * 2  , STAGE_BYTES = 8 * HTB, NXCD = 8, WGM = 8;

__host__ __device__ __forceinline__ int lds_byte(int r, int c) { const int st = (r >> 4) * 2 + (c >> 5), rr = r & 15, cc = c & 31, ob = rr * 64 + cc * 2; return st * 1024 + (ob ^ (((ob >> 9) & 1) << 5)); }
__host__ __device__ __forceinline__ void stage_rc(int b, int& R, int& C) { const int st = b / 1024, sb = b % 1024, swz = sb ^ (((sb >> 9) & 1) << 5); R = (st >> 1) * 16 + swz / 64; C = (st & 1) * 32 + (swz % 64) / 2; }
__host__ __device__ __forceinline__ int perm32(int rho) { const int n = rho >> 4, i = rho & 15; return 8 * (i >> 2) + 4 * n + (i & 3); }

struct Unit { int pm, pn; };
struct Gemm { const bf16_t* A; const bf16_t* Bt; int M, N, K; };

struct StaticOrder {
    int nM, nN, nwg, G, c;
    __host__ __device__ void init(int M, int N, int G_, int c_) { nM = M / BM; nN = N / BM; nwg = nM * nN; G = G_; c = c_; }
    __host__ __device__ bool next(int i, Unit& u) const {
        const long L = (long)i * G + c; if (L >= nwg) return false;
        int wgid = (int)L; { const int q = nwg / NXCD, r = nwg % NXCD, xcd = wgid % NXCD, off = wgid / NXCD; wgid = (xcd < r ? xcd * (q + 1) : r * (q + 1) + (xcd - r) * q) + off; }
        const int nig = WGM * nN, gid = wgid / nig, fm = gid * WGM, gsz = (nM - fm) < WGM ? (nM - fm) : WGM;
        u.pm = fm + ((wgid % nig) % gsz); u.pn = (wgid % nig) / gsz; return true;
    }
    __device__ __forceinline__ void a_ready(const Unit&) const {}
    __device__ __forceinline__ void done(const Unit&) const {}
};

__device__ __forceinline__ unsigned cvt_pk_bf16(float lo, float hi) { unsigned r; asm volatile("v_cvt_pk_bf16_f32 %0, %1, %2" : "=v"(r) : "v"(lo), "v"(hi)); return r; }
typedef float f32x2 __attribute__((ext_vector_type(2)));
__device__ __forceinline__ f32x2 gelu_pk(f32x2 v) {
    const f32x2 av = __builtin_elementwise_abs(v), d = av * 0.2316418882f + 1.0f;
    f32x2 t; t.x = __builtin_amdgcn_rcpf(d.x); t.y = __builtin_amdgcn_rcpf(d.y);
    f32x2 q = t * 0.5307027145f + (-0.7265760135f); q = q * t + 0.7107068705f; q = q * t + (-0.142248368f); q = q * t + 0.127414796f; q = q * t;
    const f32x2 s = (v * v) * (-0.72134752044f);
    f32x2 e; e.x = __builtin_amdgcn_exp2f(s.x); e.y = __builtin_amdgcn_exp2f(s.y);
    const f32x2 m = v * (q * e), r = v - m;
    f32x2 o; o.x = v.x < 0.f ? m.x : r.x; o.y = v.y < 0.f ? m.y : r.y; return o;
}

constexpr float RMS_EPS_ = 1e-6f;
__device__ __forceinline__ float silu_f(float x) { return x * __builtin_amdgcn_rcpf(1.0f + __builtin_amdgcn_exp2f(-1.4426950408889634f * x)); }
__device__ __forceinline__ u32x4 pack8(const f32x4 a, const f32x4 b) { u32x4 w; w.x = cvt_pk_bf16(a[0], a[1]); w.y = cvt_pk_bf16(a[2], a[3]); w.z = cvt_pk_bf16(b[0], b[1]); w.w = cvt_pk_bf16(b[2], b[3]); return w; }

struct ListOrder {
    int nM, cnt, idx;
    __device__ __forceinline__ void init(int nM_, int nN_, int first, int c) { nM = nM_; cnt = nM_ * nN_; idx = c - first; }
    __device__ __forceinline__ bool next(int i, Unit& u) const { if (i > 0 || idx < 0 || idx >= cnt) return false; u.pm = idx % nM; u.pn = idx / nM; return true; }
    __device__ __forceinline__ void a_ready(const Unit&) const {}
    __device__ __forceinline__ void done(const Unit&) const {}
};

template <bool PF> struct EpiSwiglu {
    static constexpr bool PERM = true, AFTER_DRAIN = false;
    bf16_t* H; const float* ssq; int ldh;
    mutable float rq[8];
    __device__ __forceinline__ void prefetch(const Unit& u, int wr, int fr) const {
        if (!PF) return;
        const float* p = ssq + u.pm * BM + wr * 64 + fr;
#pragma unroll
        for (int q = 0; q < 8; ++q) asm volatile("global_load_dword %0, %1, off offset:%c2" : "=v"(rq[q]) : "v"(p + (q >> 2) * HALF), "n"((q & 3) * 64) : "memory");
    }
    __device__ __forceinline__ void operator()(const f32x4 (&acc)[2][2][4][2], const Unit& u, int wr, int wc, int fr, int fq) const {
        const int row0 = u.pm * BM + wr * 64 + fr, col0 = u.pn * HALF + wc * 32 + 8 * fq;
        if (PF) asm volatile("" : "+v"(rq[0]), "+v"(rq[1]), "+v"(rq[2]), "+v"(rq[3]), "+v"(rq[4]), "+v"(rq[5]), "+v"(rq[6]), "+v"(rq[7]) :: "memory");
        else {
#pragma unroll
            for (int q = 0; q < 8; ++q) rq[q] = ssq[row0 + (q >> 2) * HALF + (q & 3) * 16]; }
#pragma unroll
        for (int ai = 0; ai < 2; ++ai)
#pragma unroll
            for (int m = 0; m < 4; ++m) { const int row = row0 + ai * HALF + m * 16; const float rr = __builtin_amdgcn_rsqf(rq[ai * 4 + m] * (1.0f / 1024.0f) + RMS_EPS_);
                const float s1 = -1.4426950408889634f * rr, rr2 = rr * rr;
                const f32x4 g0 = acc[ai][0][m][0], g1 = acc[ai][0][m][1], u0 = acc[ai][1][m][0], u1 = acc[ai][1][m][1];
                f32x4 e0 = g0 * s1, e1 = g1 * s1;
#pragma unroll
                for (int i = 0; i < 4; ++i) { e0[i] = __builtin_amdgcn_rcpf(1.0f + __builtin_amdgcn_exp2f(e0[i])); e1[i] = __builtin_amdgcn_rcpf(1.0f + __builtin_amdgcn_exp2f(e1[i])); }
                const f32x4 h0 = (g0 * u0) * (e0 * rr2), h1 = (g1 * u1) * (e1 * rr2);
                *(u32x4*)(H + (size_t)row * ldh + col0) = pack8(h0, h1); }
    }
};

__device__ __forceinline__ f32x4 bf_lo4(const u32x4 w) { return (f32x4){__uint_as_float(w.x << 16), __uint_as_float(w.x & 0xffff0000u), __uint_as_float(w.y << 16), __uint_as_float(w.y & 0xffff0000u)}; }
__device__ __forceinline__ f32x4 bf_hi4(const u32x4 w) { return (f32x4){__uint_as_float(w.z << 16), __uint_as_float(w.z & 0xffff0000u), __uint_as_float(w.w << 16), __uint_as_float(w.w & 0xffff0000u)}; }
template <int MODE, int NBATCH = 1> struct EpiResid {
    static constexpr bool PERM = true, AFTER_DRAIN = false;
    const bf16_t* xin; bf16_t* xout; float* out; float* ssq; float alpha;
    __device__ __forceinline__ void prefetch(const Unit&, int, int) const {}
    __device__ __forceinline__ void operator()(const f32x4 (&acc)[2][2][4][2], const Unit& u, int wr, int wc, int fr, int fq) const {
        const int row0 = u.pm * BM + wr * 64 + fr, col0 = u.pn * BM + wc * 32 + 8 * fq;
        constexpr int AIB = 2 / NBATCH;
#pragma unroll
        for (int a0 = 0; a0 < 2; a0 += AIB) {
            u32x4 b[AIB][4][2];
#pragma unroll
            for (int ai = 0; ai < AIB; ++ai)
#pragma unroll
                for (int m = 0; m < 4; ++m)
#pragma unroll
                    for (int bj = 0; bj < 2; ++bj) b[ai][m][bj] = *(const u32x4*)(xin + (size_t)(row0 + (a0 + ai) * HALF + m * 16) * 1024 + col0 + bj * HALF);
#pragma unroll
            for (int ai = 0; ai < AIB; ++ai)
#pragma unroll
                for (int m = 0; m < 4; ++m) { const int row = row0 + (a0 + ai) * HALF + m * 16; const size_t off = (size_t)row * 1024 + col0; float ss = 0.f;
#pragma unroll
                    for (int bj = 0; bj < 2; ++bj) { const f32x4 o0 = bf_lo4(b[ai][m][bj]) + alpha * acc[a0 + ai][bj][m][0], o1 = bf_hi4(b[ai][m][bj]) + alpha * acc[a0 + ai][bj][m][1];
                        if (MODE == 0) { *(f32x4*)(out + off + bj * HALF) = o0; *(f32x4*)(out + off + bj * HALF + 4) = o1; }
                        else { *(u32x4*)(xout + off + bj * HALF) = pack8(o0, o1);
                            ss += (o0[0] * o0[0] + o0[1] * o0[1]) + (o0[2] * o0[2] + o0[3] * o0[3]) + (o1[0] * o1[0] + o1[1] * o1[1]) + (o1[2] * o1[2] + o1[3] * o1[3]); } }
                    if (MODE == 1) { ss += __shfl_xor(ss, 16); ss += __shfl_xor(ss, 32); if (fq == 0) atomicAdd(ssq + row, ss); } }
            if (NBATCH > 1) asm volatile("" ::: "memory");
        }
    }
};

__device__ __forceinline__ void head_rows(const f32x4 (&acc)[2][2][4][2], const int rowb, const int fq, const int fr, const float* ssq, PG8_LAS const float* rope, float* pstate,
        const bool o_norm, const bool o_rot, const bool o_f32o, const bool o_ks, const bool o_pst, const float o_sc, bf16_t* o_ob, const int o_ldb, float* o_of, const int o_ldf, const float* o_gain, const int o_hcol, float* o_ksum) {
    f32x4 g[2][2];
#pragma unroll
    for (int bj = 0; bj < 2; ++bj)
#pragma unroll
        for (int n = 0; n < 2; ++n) g[bj][n] = o_norm ? *(const f32x4*)(o_gain + 32 * bj + 8 * fq + 4 * n) : (f32x4){1.f, 1.f, 1.f, 1.f};
    float rr8[8];
#pragma unroll
    for (int q = 0; q < 8; ++q) rr8[q] = __builtin_amdgcn_rsqf(ssq[rowb + (q >> 2) * HALF + (q & 3) * 16] * (1.0f / 1024.0f) + RMS_EPS_);
    f32x4 cs[2][2];
#pragma unroll
    for (int bj = 0; bj < 2; ++bj)
#pragma unroll
        for (int n = 0; n < 2; ++n) cs[bj][n] = (f32x4){0.f, 0.f, 0.f, 0.f};
#pragma unroll
    for (int ai = 0; ai < 2; ++ai)
#pragma unroll
        for (int m = 0; m < 4; ++m) { const int row = rowb + ai * HALF + m * 16; const float rr = rr8[ai * 4 + m];
            f32x4 v[2][2];
#pragma unroll
            for (int bj = 0; bj < 2; ++bj)
#pragma unroll
                for (int n = 0; n < 2; ++n) v[bj][n] = acc[ai][bj][m][n] * rr;
            { float ss = 0.f;
#pragma unroll
                for (int bj = 0; bj < 2; ++bj)
#pragma unroll
                    for (int n = 0; n < 2; ++n) ss += (v[bj][n][0] * v[bj][n][0] + v[bj][n][1] * v[bj][n][1]) + (v[bj][n][2] * v[bj][n][2] + v[bj][n][3] * v[bj][n][3]);
                ss += __shfl_xor(ss, 16); ss += __shfl_xor(ss, 32);
                const float hn = o_norm ? __builtin_amdgcn_rsqf(ss * (1.0f / 64.0f) + RMS_EPS_) : 1.0f;
#pragma unroll
                for (int bj = 0; bj < 2; ++bj)
#pragma unroll
                    for (int n = 0; n < 2; ++n) v[bj][n] = v[bj][n] * hn * g[bj][n];
            }
            if (o_rot) { int ro_ = (row & 255) * 16; asm volatile("" : "+v"(ro_)); PG8_LAS const float* rp = rope + ro_;
#pragma unroll
                for (int n = 0; n < 2; ++n) { const f32x4 t0 = *(PG8_LAS const f32x4*)(rp + 8 * n), t1 = *(PG8_LAS const f32x4*)(rp + 8 * n + 4);
                    const f32x4 x = v[0][n]; f32x4 y;
#pragma unroll
                    for (int i = 0; i < 4; ++i) y[i] = __shfl_xor(x[i], 16);
                    const float sg = (fq == 0) ? -1.f : 1.f;
                    f32x4 r_;
                    r_[0] = x[0] * t0[0] + sg * y[0] * t0[1]; r_[1] = x[1] * t0[2] + sg * y[1] * t0[3]; r_[2] = x[2] * t1[0] + sg * y[2] * t1[1]; r_[3] = x[3] * t1[2] + sg * y[3] * t1[3];
                    if (fq < 2) v[0][n] = r_; }
            }
#pragma unroll
            for (int bj = 0; bj < 2; ++bj)
#pragma unroll
                for (int n = 0; n < 2; ++n) cs[bj][n] += v[bj][n];
#pragma unroll
            for (int bj = 0; bj < 2; ++bj) { const int col = o_hcol + 32 * bj + 8 * fq;
                if (o_f32o) { *(f32x4*)(o_of + (size_t)row * o_ldf + col) = v[bj][0]; *(f32x4*)(o_of + (size_t)row * o_ldf + col + 4) = v[bj][1]; }
                if (o_pst) { const int t = row & 2047; if (t >= 2033) { float* pp = pstate + ((size_t)(row >> 11) * 15 + (t - 2033)) * 256 + col; *(f32x4*)pp = v[bj][0]; *(f32x4*)(pp + 4) = v[bj][1]; } }
                *(u32x4*)(o_ob + (size_t)row * o_ldb + col) = pack8(v[bj][0] * o_sc, v[bj][1] * o_sc); }
            if (m & 1) asm volatile("" ::: "memory"); }
    if (o_ks) {
#pragma unroll
        for (int bj = 0; bj < 2; ++bj)
#pragma unroll
            for (int n = 0; n < 2; ++n)
#pragma unroll
                for (int i = 0; i < 4; ++i) { float s = cs[bj][n][i]; s += __shfl_xor(s, 1); s += __shfl_xor(s, 2); s += __shfl_xor(s, 4); s += __shfl_xor(s, 8);
                    if (fr == 0) atomicAdd(o_ksum + 32 * bj + 8 * fq + 4 * n + i, s); }
    }
}
template <bool MEM> struct EpiHead {
    static constexpr bool PERM = true, AFTER_DRAIN = false;
    const float* ssq; PG8_LAS const float* rope; float* outp; float* ksum; unsigned char* ws; float c2;
    __device__ __forceinline__ void prefetch(const Unit&, int, int) const {}
    __device__ __forceinline__ void operator()(const f32x4 (&acc)[2][2][4][2], const Unit& u, int wr, int wc, int fr, int fq) const {
        const int rowb = u.pm * BM + wr * 64 + fr; const int pn = u.pn;
        const float* gains = (const float*)(ws + WS_GAIN);
        if (MEM) {
            head_rows(acc, rowb, fq, fr, ssq, rope, outp + O_PS, pn == 0, false, true, false, false, 1.f, (bf16_t*)(ws + (pn == 0 ? WS_MKB : WS_MVB)), 256, outp + (pn == 0 ? O_MK : O_MV), 256, gains + 3 * 64, 64 * wc, ksum);
        } else {
            const bool isq = (pn == 1 || pn == 2), isk = (pn == 3 || pn == 4), isv = (pn == 5 || pn == 6), ism = (pn == 7);
            const size_t boff = pn == 0 ? WS_U : (isq ? WS_Q : (isk ? WS_K : (isv ? WS_V : WS_QM)));
            head_rows(acc, rowb, fq, fr, ssq, rope, outp + O_PS, isq || isk || ism, isq || isk, isk || isv, isk, pn == 0, (isq || ism) ? c2 : 1.f, (bf16_t*)(ws + boff), (pn == 0 || ism) ? 256 : 512,
                      outp + (isk ? O_KP : O_VP), 512, gains + (isq ? 0 : (isk ? 64 : 128)), ((pn == 0 || ism) ? 0 : 256 * ((pn - 1) & 1)) + 64 * wc, ksum + (size_t)u.pm * 512 + (4 * ((pn - 1) & 1) + wc) * 64);
        }
    }
};

struct NoStream { static constexpr int NX = 0; __device__ __forceinline__ void wait() { asm volatile("s_waitcnt vmcnt(8)" ::: "memory"); } __device__ __forceinline__ void start_a() {} __device__ __forceinline__ void start() {} __device__ __forceinline__ void begin_unit(int) {} template <int SEL> __device__ __forceinline__ void sp(int, int) {} __device__ __forceinline__ void finish() {} };
template <class Epi, class Sched, bool ALIGN_EPI = false, bool SP2 = false, class Strm = NoStream>
__device__ __forceinline__ void gemm_phase(PG8_LAS unsigned char* lds, const Gemm g, const Sched& S, const Epi& E, Strm& X) {
    const int tid = threadIdx.x, wid = __builtin_amdgcn_readfirstlane(tid >> 6), lane = tid & 63, wr = wid >> 2, wc = wid & 3, fr = lane & 15, fq = lane >> 4;
    const int K = g.K, nt = K / BK;
    unsigned voffA[2], voffB[2];
#pragma unroll
    for (int i = 0; i < 2; ++i) { int R, C; stage_rc(tid * 16 + i * 8192, R, C); const int Rb = Epi::PERM ? ((R & ~31) + perm32(R & 31)) : R;
        voffA[i] = (unsigned)(R * K + C) * 2u; voffB[i] = (unsigned)(Rb * K + C) * 2u; }
    const size_t kstep = (size_t)(BK * 2);
    const size_t hstep = (size_t)HALF * K * 2;
    const size_t tstep = 2 * hstep;
    const unsigned ldsw = (unsigned)wid * 1024u;
    const int aoff = lds_byte(wr * 64 + fr, fq * 8), boff = lds_byte(wc * 32 + fr, fq * 8);
#define PG8_SA(b, h) (((b) * 2 + (h)) * HTB)
#define PG8_SB(b, h) ((4 + (b) * 2 + (h)) * HTB)
#define PG8_STAGE(bufoff, gbase, voff) do { _Pragma("unroll") for (int _i = 0; _i < 2; ++_i) \
        __builtin_amdgcn_global_load_lds((const unsigned*)((const char*)(gbase) + (voff)[_i]), (PG8_LAS unsigned*)(lds + (bufoff) + ldsw + _i * 8192), 16, 0, 0); } while (0)
#define PG8_LDA(dst, b, h) do { _Pragma("unroll") for (int m = 0; m < 4; ++m) _Pragma("unroll") for (int k = 0; k < 2; ++k) dst[m][k] = *(const PG8_LAS bf16x8*)(lds + PG8_SA(b, h) + aoff + m * 2048 + k * 1024); } while (0)
#define PG8_LDB(dst, b, h) do { _Pragma("unroll") for (int n = 0; n < 2; ++n) _Pragma("unroll") for (int k = 0; k < 2; ++k) dst[n][k] = *(const PG8_LAS bf16x8*)(lds + PG8_SB(b, h) + boff + n * 2048 + k * 1024); } while (0)
#define PG8_MMA(ai, bj, At, Bt) do { __builtin_amdgcn_s_setprio(1); _Pragma("unroll") for (int m = 0; m < 4; ++m) _Pragma("unroll") for (int n = 0; n < 2; ++n) _Pragma("unroll") for (int k = 0; k < 2; ++k) \
        acc[ai][bj][m][n] = __builtin_amdgcn_mfma_f32_16x16x32_bf16(Bt[n][k], At[m][k], acc[ai][bj][m][n], 0, 0, 0); __builtin_amdgcn_s_setprio(0); } while (0)
#define PG8_WAIT_V(n) asm volatile("s_waitcnt vmcnt(" #n ")" ::: "memory")
#define PG8_WAIT_L(n) asm volatile("s_waitcnt lgkmcnt(" #n ")" ::: "memory")
#define PG8_WAIT_VX X.wait()
#define PG8_BAR __builtin_amdgcn_s_barrier()
#define PG8_SCHED __builtin_amdgcn_sched_barrier(0)
    Unit cur, nxt; int ui = 0;
    if (!S.next(0, cur)) return;
    f32x4 acc[2][2][4][2];
#pragma unroll
    for (int a = 0; a < 2; ++a)
#pragma unroll
        for (int b = 0; b < 2; ++b)
#pragma unroll
            for (int m = 0; m < 4; ++m)
#pragma unroll
                for (int n = 0; n < 2; ++n) acc[a][b][m][n] = (f32x4){0.f, 0.f, 0.f, 0.f};
    bf16x8 At[4][2], B0[2][2], B1[2][2];
    const char* cA = (const char*)g.A + (size_t)cur.pm * tstep; const char* cB = (const char*)g.Bt + (size_t)cur.pn * tstep;
    S.a_ready(cur);
    if constexpr (SP2) {
        PG8_STAGE(PG8_SB(0, 0), cB, voffB); PG8_STAGE(PG8_SB(0, 1), cB + hstep, voffB); PG8_STAGE(PG8_SA(0, 0), cA, voffA); PG8_STAGE(PG8_SA(0, 1), cA + hstep, voffA);
        if (wr == 1) PG8_BAR;
        PG8_WAIT_V(2); PG8_BAR;
        X.start_a();
        PG8_STAGE(PG8_SB(1, 0), cB + kstep, voffB); PG8_STAGE(PG8_SA(1, 0), cA + kstep, voffA); PG8_STAGE(PG8_SB(1, 1), cB + hstep + kstep, voffB);
        PG8_WAIT_V(6); PG8_BAR;
        X.start(); X.begin_unit(0);
    } else {
        PG8_STAGE(PG8_SB(0, 0), cB, voffB); PG8_STAGE(PG8_SA(0, 0), cA, voffA); PG8_STAGE(PG8_SB(0, 1), cB + hstep, voffB); PG8_STAGE(PG8_SA(0, 1), cA + hstep, voffA);
        if (wr == 1) PG8_BAR;
        PG8_WAIT_V(4); PG8_BAR;
        PG8_STAGE(PG8_SB(1, 0), cB + kstep, voffB); PG8_STAGE(PG8_SA(1, 0), cA + kstep, voffA); PG8_STAGE(PG8_SB(1, 1), cB + hstep + kstep, voffB);
        PG8_WAIT_V(6); PG8_BAR;
    }
    for (;;) {
        const bool has_next = S.next(ui + 1, nxt);
        const char* nA = has_next ? (const char*)g.A + (size_t)nxt.pm * tstep : cA; const char* nB = has_next ? (const char*)g.Bt + (size_t)nxt.pn * tstep : cB;
        for (int t = 0; t < nt; t += 2) {
            const bool last = (t == nt - 2);
            const char* a1 = cA + (size_t)(t + 1) * kstep;
            const char* a2 = last ? nA : cA + (size_t)(t + 2) * kstep; const char* b2 = last ? nB : cB + (size_t)(t + 2) * kstep;
            const char* a3 = a2 + kstep; const char* b3 = b2 + kstep;
            if (last && has_next) S.a_ready(nxt);
            if (last) E.prefetch(cur, wr, fr);
            if constexpr (SP2) {
            PG8_LDB(B0, 0, 0); PG8_LDB(B1, 0, 1); PG8_SCHED; PG8_LDA(At, 0, 0); PG8_STAGE(PG8_SA(1, 1), a1 + hstep, voffA);
            PG8_WAIT_VX; X.template sp<0>(2 * t, ui); PG8_WAIT_L(0); PG8_BAR; PG8_MMA(0, 0, At, B0); PG8_MMA(0, 1, At, B1); PG8_BAR; PG8_SCHED;
            PG8_LDA(At, 0, 1); PG8_STAGE(PG8_SB(0, 0), b2, voffB); PG8_STAGE(PG8_SB(0, 1), b2 + hstep, voffB); PG8_STAGE(PG8_SA(0, 0), a2, voffA);
            PG8_WAIT_VX; X.template sp<1>(2 * t + 1, ui); PG8_WAIT_L(0); PG8_BAR; PG8_MMA(1, 0, At, B0); PG8_MMA(1, 1, At, B1); PG8_BAR; PG8_SCHED;
            PG8_LDB(B0, 1, 0); PG8_LDB(B1, 1, 1); PG8_SCHED; PG8_LDA(At, 1, 0); PG8_STAGE(PG8_SA(0, 1), a2 + hstep, voffA);
            PG8_WAIT_VX; X.template sp<2>(2 * t + 2, ui); PG8_WAIT_L(0); PG8_BAR; PG8_MMA(0, 0, At, B0); PG8_MMA(0, 1, At, B1); PG8_BAR; PG8_SCHED;
            PG8_LDA(At, 1, 1); PG8_STAGE(PG8_SB(1, 0), b3, voffB); PG8_STAGE(PG8_SB(1, 1), b3 + hstep, voffB); PG8_STAGE(PG8_SA(1, 0), a3, voffA);
            PG8_WAIT_VX; X.template sp<3>(2 * t + 3, ui); PG8_WAIT_L(0); PG8_BAR; PG8_MMA(1, 0, At, B0); PG8_MMA(1, 1, At, B1); PG8_BAR; PG8_SCHED;
            } else {
            PG8_LDB(B0, 0, 0); PG8_SCHED; PG8_LDA(At, 0, 0); PG8_STAGE(PG8_SA(1, 1), a1 + hstep, voffA);
            PG8_WAIT_L(8); PG8_BAR; PG8_WAIT_L(0); PG8_MMA(0, 0, At, B0); PG8_BAR; PG8_SCHED;
            PG8_LDB(B1, 0, 1); PG8_STAGE(PG8_SB(0, 0), b2, voffB);
            PG8_BAR; PG8_WAIT_L(0); PG8_MMA(0, 1, At, B1); PG8_BAR;
            PG8_LDA(At, 0, 1); PG8_STAGE(PG8_SA(0, 0), a2, voffA);
            PG8_BAR; PG8_WAIT_L(0); PG8_MMA(1, 0, At, B0); PG8_BAR; PG8_SCHED;
            PG8_STAGE(PG8_SB(0, 1), b2 + hstep, voffB);
            PG8_WAIT_V(6); PG8_BAR; PG8_MMA(1, 1, At, B1); PG8_BAR;
            PG8_LDB(B0, 1, 0); PG8_SCHED; PG8_LDA(At, 1, 0); PG8_STAGE(PG8_SA(0, 1), a2 + hstep, voffA);
            PG8_WAIT_L(8); PG8_BAR; PG8_WAIT_L(0); PG8_MMA(0, 0, At, B0); PG8_BAR; PG8_SCHED;
            PG8_LDB(B1, 1, 1); PG8_STAGE(PG8_SB(1, 0), b3, voffB);
            PG8_BAR; PG8_WAIT_L(0); PG8_MMA(0, 1, At, B1); PG8_BAR;
            PG8_LDA(At, 1, 1); PG8_STAGE(PG8_SA(1, 0), a3, voffA);
            PG8_BAR; PG8_WAIT_L(0); PG8_MMA(1, 0, At, B0); PG8_BAR; PG8_SCHED;
            PG8_STAGE(PG8_SB(1, 1), b3 + hstep, voffB);
            PG8_WAIT_V(6); PG8_BAR; PG8_MMA(1, 1, At, B1); PG8_BAR;
            }
        }
        if constexpr (ALIGN_EPI) { if (wr == 0) PG8_BAR; }
        if constexpr (!Epi::AFTER_DRAIN) { E(acc, cur, wr, wc, fr, fq); S.done(cur); }
        if (!has_next) break;
#pragma unroll
        for (int a = 0; a < 2; ++a)
#pragma unroll
            for (int b = 0; b < 2; ++b)
#pragma unroll
                for (int m = 0; m < 4; ++m)
#pragma unroll
                    for (int n = 0; n < 2; ++n) acc[a][b][m][n] = (f32x4){0.f, 0.f, 0.f, 0.f};
        cur = nxt; cA = nA; cB = nB; ++ui;
        X.begin_unit(ui);
        if constexpr (ALIGN_EPI) { if (wr == 1) PG8_BAR; }
    }
    PG8_WAIT_V(0);
    X.finish();
    if constexpr (!ALIGN_EPI) { if (wr == 0) PG8_BAR; }
    PG8_BAR;
    if constexpr (Epi::AFTER_DRAIN) { E.fused(acc, cur, wr, wc, fr, fq, lds, wid, lane); S.done(cur); }
#undef PG8_SA
#undef PG8_SB
#undef PG8_STAGE
#undef PG8_LDA
#undef PG8_LDB
#undef PG8_MMA
#undef PG8_WAIT_V
#undef PG8_WAIT_L
#undef PG8_WAIT_VX
#undef PG8_BAR
#undef PG8_SCHED
}
}

namespace attn_body {
using bf16=__hip_bfloat16;
using bf16x8=__attribute__((ext_vector_type(8)))short;
using s16x4=__attribute__((ext_vector_type(4)))short;
using f32x16=__attribute__((ext_vector_type(16)))float;
using u32x4=__attribute__((ext_vector_type(4)))unsigned;
using f32x4_t=__attribute__((ext_vector_type(4)))float;
__device__ __forceinline__ float bf2f(short s){return __uint_as_float(((unsigned)(unsigned short)s)<<16);}
constexpr int D=64;
constexpr int NW=8,QBLK=32,QB=QBLK*NW,KVBLK=64;
constexpr int ATTN_UNIT_ROWS=QB;
__device__ __forceinline__ int crow(int r,int hi){return (r&3)+8*(r>>2)+4*hi;}
#define SBAR() __builtin_amdgcn_sched_barrier(0)
__device__ __forceinline__ void cmask(f32x16&p0,f32x16&p1,int jb,int qrel,int hi){
  const float NEG=-INFINITY; int kb=64*jb+4*hi;
  #pragma unroll
  for(int r=0;r<16;++r){int kv=kb+(r&3)+8*(r>>2); if(kv>qrel)p0[r]=NEG; if(kv+32>qrel)p1[r]=NEG;}
}

constexpr int NSLOT=3, SLOTB=8192;
constexpr int LDS_K=0, LDS_V=NSLOT*SLOTB, LDS_WS=2*NSLOT*SLOTB, LDS_OST=LDS_WS+NW*64*4, LDS_BYTES=LDS_OST+NW*4096;
constexpr float C2=0.125f*1.4426950408889634f;
__device__ __forceinline__ void glds16(const void*gsrc,unsigned lds_dst){unsigned keep;
  asm volatile("s_mov_b32 %0, m0\n\ts_mov_b32 m0, %2\n\ts_nop 0\n\tglobal_load_lds_dwordx4 %1, off\n\ts_mov_b32 m0, %0":"=&s"(keep):"v"(gsrc),"s"(lds_dst):"memory");}
__device__ __forceinline__ float max3f(float a,float b,float c){float r;asm("v_max3_f32 %0, %1, %2, %3":"=v"(r):"v"(a),"v"(b),"v"(c));return r;}
__device__ __forceinline__ float max2f(float a,float b){float r;asm("v_max_f32_e32 %0, %1, %2":"=v"(r):"v"(a),"v"(b));return r;}
__device__ __forceinline__ float fadd_s(float a,float b){float r;asm("v_add_f32_e32 %0, %1, %2":"=v"(r):"v"(a),"v"(b));return r;}
__device__ __forceinline__ float fsub_s(float a,float b){float r;asm("v_sub_f32_e32 %0, %1, %2":"=v"(r):"v"(a),"v"(b));return r;}
typedef float f32x2_t __attribute__((ext_vector_type(2))); typedef __bf16 bf16x2_t __attribute__((ext_vector_type(2)));
__device__ __forceinline__ unsigned cvtpk_s(float lo,float hi){f32x2_t v={lo,hi};bf16x2_t b=__builtin_convertvector(v,bf16x2_t);return __builtin_bit_cast(unsigned,b);}
#define WAIT_BAR(N) asm volatile("s_waitcnt vmcnt(" #N ") lgkmcnt(0)\n\ts_barrier":::"memory")

__device__ __forceinline__ void qkt(f32x16&p0,f32x16&p1,const char*Kslot,const bf16x8*qr,const f32x16&negm,int r32,int hi){
  const char*kb=Kslot+hi*1024+r32*16;
  #pragma unroll
  for(int d0=0;d0<4;++d0){
    const bf16x8 b0=*reinterpret_cast<const bf16x8*>(kb+d0*2048);
    const bf16x8 b1=*reinterpret_cast<const bf16x8*>(kb+d0*2048+512);
    if(d0==0){p0=__builtin_amdgcn_mfma_f32_32x32x16_bf16(b0,qr[0],negm,0,0,0);p1=__builtin_amdgcn_mfma_f32_32x32x16_bf16(b1,qr[0],negm,0,0,0);}
    else{p0=__builtin_amdgcn_mfma_f32_32x32x16_bf16(b0,qr[d0],p0,0,0,0);p1=__builtin_amdgcn_mfma_f32_32x32x16_bf16(b1,qr[d0],p1,0,0,0);}}
}
typedef __attribute__((address_space(3))) const char* lds_cptr;
typedef short v4i16_t __attribute__((ext_vector_type(4)));
__device__ __forceinline__ void kload8(bf16x8*kf,lds_cptr kp){
  kf[0]=*(const __attribute__((address_space(3))) bf16x8*)(kp);      kf[1]=*(const __attribute__((address_space(3))) bf16x8*)(kp+512);
  kf[2]=*(const __attribute__((address_space(3))) bf16x8*)(kp+2048); kf[3]=*(const __attribute__((address_space(3))) bf16x8*)(kp+2560);
  kf[4]=*(const __attribute__((address_space(3))) bf16x8*)(kp+4096); kf[5]=*(const __attribute__((address_space(3))) bf16x8*)(kp+4608);
  kf[6]=*(const __attribute__((address_space(3))) bf16x8*)(kp+6144); kf[7]=*(const __attribute__((address_space(3))) bf16x8*)(kp+6656);
}
__device__ __forceinline__ void kload2(bf16x8*kf,lds_cptr kp,int j){ kf[2*j]=*(const __attribute__((address_space(3))) bf16x8*)(kp+j*2048); kf[2*j+1]=*(const __attribute__((address_space(3))) bf16x8*)(kp+j*2048+512); }
__device__ __forceinline__ s16x4 vtr(lds_cptr p){ return __builtin_bit_cast(s16x4,__builtin_amdgcn_ds_read_tr16_b64_v4i16((__attribute__((address_space(3))) v4i16_t*)p)); }
__device__ __forceinline__ float rowmax(const f32x16&p0,const f32x16&p1){
  float a=max3f(p0[0],p0[1],p1[0]),b=max3f(p0[2],p0[3],p1[1]);a=max3f(a,p1[2],p1[3]);
  #pragma unroll
  for(int r=4;r<16;r+=4){a=max3f(a,p0[r],p0[r+1]);b=max3f(b,p0[r+2],p0[r+3]);a=max3f(a,p1[r],p1[r+1]);b=max3f(b,p1[r+2],p1[r+3]);}
  const float m=max2f(a,b);
  auto rr=__builtin_amdgcn_permlane32_swap(__float_as_uint(m),__float_as_uint(m),false,false);
  return max2f(__uint_as_float(rr[0]),__uint_as_float(rr[1]));
}
__device__ __forceinline__ void pv(f32x16*o,int vb,bf16x8 pa0,bf16x8 pa1,bf16x8 pa2,bf16x8 pa3){
  #pragma unroll
  for(int d0=0;d0<2;++d0){s16x4 lo[4],hi[4];
    #pragma unroll
    for(int ks=0;ks<4;++ks){
      asm volatile("ds_read_b64_tr_b16 %0,%1 offset:%c2":"=&v"(lo[ks]):"v"(vb),"i"(d0*4096+ks*1024):"memory");
      asm volatile("ds_read_b64_tr_b16 %0,%1 offset:%c2":"=&v"(hi[ks]):"v"(vb),"i"(d0*4096+ks*1024+512):"memory");}
    asm volatile("s_waitcnt lgkmcnt(0)":::"memory");SBAR();
    #define PK(k) (bf16x8){lo[k][0],lo[k][1],lo[k][2],lo[k][3],hi[k][0],hi[k][1],hi[k][2],hi[k][3]}
    o[d0]=__builtin_amdgcn_mfma_f32_32x32x16_bf16(pa0,PK(0),o[d0],0,0,0);
    o[d0]=__builtin_amdgcn_mfma_f32_32x32x16_bf16(pa1,PK(1),o[d0],0,0,0);
    o[d0]=__builtin_amdgcn_mfma_f32_32x32x16_bf16(pa2,PK(2),o[d0],0,0,0);
    o[d0]=__builtin_amdgcn_mfma_f32_32x32x16_bf16(pa3,PK(3),o[d0],0,0,0);
    #undef PK
  }
}

#ifndef ATTN_STORE16
#define ATTN_STORE16(p,v) (*(u32x4*)(p)=(v))
#endif
template<int THRL,int MODE,int QP,int KP,int OP> __device__ __forceinline__ void attn_unit(const bf16*Qu,const bf16*__restrict__ Kh,const bf16*__restrict__ Vh,bf16*Ou,const int NT,const __attribute__((address_space(3))) unsigned char*seltab,char*shm){
  const int tid=threadIdx.x,lane=tid&63,r32=lane&31,hi=lane>>5; const int wid=__builtin_amdgcn_readfirstlane(tid>>6);
  const bf16*Qw=Qu+(long)(wid*QBLK)*QP;
  const unsigned lds0=(unsigned)(uintptr_t)shm;
  float*wsf=(float*)(shm+LDS_WS)+wid*64;
  const bf16*ksrc=Kh+(long)lane*KP+wid*8;
  const bf16*vsrc=Vh+(long)(16*(wid&3)+(lane>>2))*KP+(wid>>2)*32+(lane&3)*8;
  const unsigned kdst=lds0+LDS_K+wid*1024, vdst=lds0+LDS_V+wid*1024;
  #define PHYS(t) (MODE==1?(((t)<4)?((t)+NT-4):((t)-4)):(t))
  #define DMA_K(t,slot) glds16(ksrc+(long)PHYS(t)*KVBLK*KP,(unsigned)__builtin_amdgcn_readfirstlane(kdst+(slot)))
  #define DMA_V(t,slot) glds16(vsrc+(long)PHYS(t)*KVBLK*KP,(unsigned)__builtin_amdgcn_readfirstlane(vdst+(slot)))
  const char*Kbase=shm+LDS_K; bf16x8 kf[8];
  const lds_cptr shm3=(lds_cptr)shm; const lds_cptr kp0=shm3+LDS_K+hi*1024+r32*16; const lds_cptr vp0=shm3+LDS_V+((lane>>4)&1)*32+(lane&3)*8+(4*hi+((lane&15)>>2))*64;
  DMA_K(0,0);DMA_V(0,0);DMA_K(1,SLOTB);
  bf16x8 qr[4];
  #pragma unroll
  for(int d0=0;d0<4;++d0)qr[d0]=*reinterpret_cast<const bf16x8*>(&Qw[(long)r32*QP+d0*16+hi*8]);
  unsigned sel=0x7fu; if(MODE==1) sel=(unsigned)seltab[wid*QBLK+r32];
  float mhat=0.f,l_reg=0.f;f32x16 o[2];o[0]=f32x16{};o[1]=f32x16{};const f32x16 negm=f32x16{};
  const int qrel=wid*QBLK+r32;
  #define CMASK(P0,P1,t) do{ if(MODE==1){ if((t)<4) cmask(P0,P1,(t),qrel,hi); else if(!((sel>>(((t)-4)>>2))&1u)){ _Pragma("unroll") for(int r_=0;r_<16;++r_){P0[r_]=-INFINITY;P1[r_]=-INFINITY;} } } }while(0)
  bool resc=false;
  #define START(P0,P1) do{ const float rm=rowmax(P0,P1); resc=false; \
    { const float dl=rm; mhat=fadd_s(mhat,dl); \
      _Pragma("unroll") for(int r=0;r<16;++r){P0[r]=fsub_s(P0[r],dl);P1[r]=fsub_s(P1[r],dl);} \
      } \
    _Pragma("unroll") for(int r=0;r<16;++r)P0[r]=__builtin_amdgcn_exp2f(P0[r]); }while(0)
  #define RESC() do{ if(resc){ asm volatile("s_waitcnt lgkmcnt(0)":::"memory"); \
      _Pragma("unroll") for(int d_=0;d_<2;++d_) _Pragma("unroll") for(int r=0;r<16;++r)o[d_][r]*=wsf[crow(r,hi)]; } }while(0)
  f32x16 pA0,pA1,pB0,pB1;
  int sl_prev=0,sl_cur=0,sl_next=SLOTB;
  #define ROT() do{sl_prev=sl_cur;sl_cur=sl_next;sl_next=(sl_next==(NSLOT-1)*SLOTB)?0:sl_next+SLOTB;}while(0)
  DMA_K(2,2*SLOTB);
  WAIT_BAR(3);
  qkt(pA0,pA1,Kbase,qr,negm,r32,hi);asm volatile("s_nop 15\n\ts_nop 7":"+v"(pA0),"+v"(pA1));if(MODE==1){ const int lim_=qrel-4*hi; _Pragma("unroll") for(int r_=0;r_<16;++r_){ const int c_=(r_&3)+8*(r_>>2); pA0[r_]=(c_>lim_)?-INFINITY:pA0[r_]; pA1[r_]=(c_+32>lim_)?-INFINITY:pA1[r_]; } }
  START(pA0,pA1);
  _Pragma("unroll") for(int r=0;r<16;++r)pA1[r]=__builtin_amdgcn_exp2f(pA1[r]);
  WAIT_BAR(0);
  DMA_K(3,0);DMA_V(1,SLOTB);
  ROT();
  kload8(kf,kp0+sl_cur);
  WAIT_BAR(2);
  s16x4 vlo[8],vhi[8]; u32x4 pw0,pw1,pw2,pw3;
  #define PKW(P,B) cvtpk_s(P[B],P[B+1])
  #define PAF(k) __builtin_bit_cast(bf16x8,pw##k)
  #define VFR(i) (bf16x8){vlo[i][0],vlo[i][1],vlo[i][2],vlo[i][3],vhi[i][0],vhi[i][1],vhi[i][2],vhi[i][3]}
  #define PIN(x) asm volatile("":"+v"(x))
  #define MX3(a,b,c) __builtin_fmaxf(__builtin_fmaxf((a),(b)),(c))
  #define GAPA(MF,A0,A1,A2,A3,W0,W1,PW) do{ MF; sacc+=A0; sacc+=A1; sacc+=A2; sacc+=A3; PIN(sacc); W0; W1; PIN(PW); SBAR(); }while(0)
  #define EX(v) __builtin_amdgcn_exp2f(v)
  #define GAPB(MF,X,B) do{ MF; X[B]=EX(X[B]); X[B+1]=EX(X[B+1]); X[B+2]=EX(X[B+2]); X[B+3]=EX(X[B+3]); PIN(X); SBAR(); }while(0)
  #define VRD(i) do{ vlo[i]=vtr(vp_+(((i)>>2)*4096+((i)&3)*1024)); vhi[i]=vtr(vp_+(((i)>>2)*4096+((i)&3)*1024+512)); }while(0)
  #define KRD(G,j) do{ if(G){ kload2(kf,kp0+sl_next,j); SBAR(); } }while(0)
  #define STEP(C0,C1,P0,P1,t,GK,GV,GL,PAST) do{ SBAR(); \
    const lds_cptr vp_=vp0+sl_prev; \
    VRD(0); SBAR(); float sacc=(P0[0]+P0[1]); \
    GAPA(C0=__builtin_amdgcn_mfma_f32_32x32x16_bf16(kf[0],qr[0],negm,0,0,0), P0[2],P0[3],P0[4],P0[5],     pw0[0]=PKW(P0,0), pw0[1]=PKW(P0,2), pw0); \
    VRD(4); SBAR(); GAPA(C1=__builtin_amdgcn_mfma_f32_32x32x16_bf16(kf[1],qr[0],negm,0,0,0), P0[6],P0[7],P0[8],P0[9],     pw0[2]=PKW(P0,4), pw0[3]=PKW(P0,6), pw0); \
    VRD(1); SBAR(); GAPA(C0=__builtin_amdgcn_mfma_f32_32x32x16_bf16(kf[2],qr[1],C0,0,0,0),   P0[10],P0[11],P0[12],P0[13], pw1[0]=PKW(P0,8), pw1[1]=PKW(P0,10), pw1); \
    VRD(5); SBAR(); GAPA(C1=__builtin_amdgcn_mfma_f32_32x32x16_bf16(kf[3],qr[1],C1,0,0,0),   P0[14],P0[15],P1[0],P1[1],   pw1[2]=PKW(P0,12),pw1[3]=PKW(P0,14), pw1); \
    VRD(2); SBAR(); GAPA(C0=__builtin_amdgcn_mfma_f32_32x32x16_bf16(kf[4],qr[2],C0,0,0,0),   P1[2],P1[3],P1[4],P1[5],     pw2[0]=PKW(P1,0), pw2[1]=PKW(P1,2), pw2); \
    VRD(6); SBAR(); GAPA(C1=__builtin_amdgcn_mfma_f32_32x32x16_bf16(kf[5],qr[2],C1,0,0,0),   P1[6],P1[7],P1[8],P1[9],     pw2[2]=PKW(P1,4), pw2[3]=PKW(P1,6), pw2); \
    VRD(3); SBAR(); GAPA(C0=__builtin_amdgcn_mfma_f32_32x32x16_bf16(kf[6],qr[3],C0,0,0,0),   P1[10],P1[11],P1[12],P1[13], pw3[0]=PKW(P1,8), pw3[1]=PKW(P1,10), pw3); \
    VRD(7); SBAR(); GAPA(C1=__builtin_amdgcn_mfma_f32_32x32x16_bf16(kf[7],qr[3],C1,0,0,0),   P1[14],P1[15],0.f,0.f,       pw3[2]=PKW(P1,12),pw3[3]=PKW(P1,14), pw3); \
    l_reg+=sacc; \
    if(GK){DMA_K((t)+3,sl_cur);} if(GV){DMA_V((t)+1,sl_next);} \
    if(MODE==1 && (PAST)){ const float mh_=(((sel>>(((t)-4)>>2))&1u)!=0u)?mhat:INFINITY; _Pragma("unroll") for(int r_=0;r_<16;++r_){ C0[r_]-=mh_; C1[r_]-=mh_; } }   \
    else if(MODE==1){ const int lim_=LIM(t); _Pragma("unroll") for(int r_=0;r_<16;++r_){ const int c_=(r_&3)+8*(r_>>2); C0[r_]=(c_>lim_)?-INFINITY:(C0[r_]-mhat); C1[r_]=(c_+32>lim_)?-INFINITY:(C1[r_]-mhat); } } \
    else { _Pragma("unroll") for(int r_=0;r_<16;++r_){ C0[r_]-=mhat; C1[r_]-=mhat; } } \
    { float a=MX3(C0[0],C0[1],C1[0]),b=MX3(C0[2],C0[3],C1[1]); a=MX3(a,C1[2],C1[3]); \
      _Pragma("unroll") for(int r=4;r<16;r+=4){a=MX3(a,C0[r],C0[r+1]);b=MX3(b,C0[r+2],C0[r+3]);a=MX3(a,C1[r],C1[r+1]);b=MX3(b,C1[r+2],C1[r+3]);} \
      float rm=__builtin_fmaxf(a,b); { auto rr=__builtin_amdgcn_permlane32_swap(__float_as_uint(rm),__float_as_uint(rm),false,false); rm=__builtin_fmaxf(__uint_as_float(rr[0]),__uint_as_float(rr[1])); } \
      resc=false; \
      if(__builtin_expect(__any(rm>(float)THRL),0)){ const float dl=__builtin_fmaxf(rm,0.f); mhat+=dl; \
        _Pragma("unroll") for(int r=0;r<16;++r){C0[r]-=dl;C1[r]-=dl;} \
        const float f=__builtin_amdgcn_exp2f(-dl); l_reg*=f; if(hi==0)wsf[r32]=f; resc=true; } } \
    SBAR(); \
    GAPB(o[0]=__builtin_amdgcn_mfma_f32_32x32x16_bf16(PAF(0),VFR(0),o[0],0,0,0), C0,0); \
    GAPB(o[1]=__builtin_amdgcn_mfma_f32_32x32x16_bf16(PAF(0),VFR(4),o[1],0,0,0), C0,4); \
    KRD(GL,0); GAPB(o[0]=__builtin_amdgcn_mfma_f32_32x32x16_bf16(PAF(1),VFR(1),o[0],0,0,0), C0,8); \
    KRD(GL,1); GAPB(o[1]=__builtin_amdgcn_mfma_f32_32x32x16_bf16(PAF(1),VFR(5),o[1],0,0,0), C0,12); \
    KRD(GL,2); GAPB(o[0]=__builtin_amdgcn_mfma_f32_32x32x16_bf16(PAF(2),VFR(2),o[0],0,0,0), C1,0); \
    KRD(GL,3); GAPB(o[1]=__builtin_amdgcn_mfma_f32_32x32x16_bf16(PAF(2),VFR(6),o[1],0,0,0), C1,4); \
    GAPB(o[0]=__builtin_amdgcn_mfma_f32_32x32x16_bf16(PAF(3),VFR(3),o[0],0,0,0), C1,8); \
    GAPB(o[1]=__builtin_amdgcn_mfma_f32_32x32x16_bf16(PAF(3),VFR(7),o[1],0,0,0), C1,12); \
    }while(0)
  #define LIM(t) (((t)<4)?(qrel-64*(t)-4*hi):((((sel>>(((t)-4)>>2))&1u)!=0u)?1000:-1000))
  int t=1;
  for(;t<5&&t+5<NT;t+=2){
    STEP(pB0,pB1,pA0,pA1,t,true,true,true,false);     WAIT_BAR(2); RESC(); ROT();
    STEP(pA0,pA1,pB0,pB1,t+1,true,true,true,false);   WAIT_BAR(2); RESC(); ROT();
  }
  for(;t+5<NT;t+=2){
    STEP(pB0,pB1,pA0,pA1,t,true,true,true,true);      WAIT_BAR(2); RESC(); ROT();
    STEP(pA0,pA1,pB0,pB1,t+1,true,true,true,true);    WAIT_BAR(2); RESC(); ROT();
  }
  #define ENDW(tt) do{ if((tt)+3<NT){WAIT_BAR(2);} else if((tt)+2<NT){WAIT_BAR(1);} else {WAIT_BAR(0);} }while(0)
  for(;t+1<NT;t+=2){
    STEP(pB0,pB1,pA0,pA1,t,(t+3<NT),(t+1<NT),(t+1<NT),false);       ENDW(t);   RESC(); ROT();
    STEP(pA0,pA1,pB0,pB1,t+1,(t+4<NT),(t+2<NT),(t+2<NT),false);     ENDW(t+1); RESC(); ROT();
  }
  STEP(pB0,pB1,pA0,pA1,NT-1,false,false,false,false); RESC();
  { float sacc=pB0[0]+pB0[1]; _Pragma("unroll") for(int r=2;r<16;++r)sacc+=pB0[r]; _Pragma("unroll") for(int r=0;r<16;++r)sacc+=pB1[r]; l_reg+=sacc;
    pw0=(u32x4){PKW(pB0,0),PKW(pB0,2),PKW(pB0,4),PKW(pB0,6)};pw1=(u32x4){PKW(pB0,8),PKW(pB0,10),PKW(pB0,12),PKW(pB0,14)};pw2=(u32x4){PKW(pB1,0),PKW(pB1,2),PKW(pB1,4),PKW(pB1,6)};pw3=(u32x4){PKW(pB1,8),PKW(pB1,10),PKW(pB1,12),PKW(pB1,14)};
    int ln_=threadIdx.x&63; asm volatile("":"+v"(ln_)); const int vb0_=(int)(lds0+LDS_V)+((ln_>>4)&1)*32+(ln_&3)*8+(4*(ln_>>5)+((ln_&15)>>2))*64;
    SBAR(); pv(o,vb0_+sl_cur,PAF(0),PAF(1),PAF(2),PAF(3)); }
  #undef PKW
  #undef PAF
  #undef VFR
  #undef PIN
  #undef MX3
  #undef GAPA
  #undef GAPB
  #undef EX
  #undef VRD
  #undef KRD
  #undef STEP
  #undef ENDW
  #undef LIM
  {auto rr=__builtin_amdgcn_permlane32_swap(__float_as_uint(l_reg),__float_as_uint(l_reg),false,false);l_reg=__uint_as_float(rr[0])+__uint_as_float(rr[1]);}
  if(hi==0)wsf[32+r32]=l_reg;asm volatile("s_waitcnt lgkmcnt(0)":::"memory");
  float rli[16];
  #pragma unroll
  for(int r=0;r<16;++r)rli[r]=__builtin_amdgcn_rcpf(wsf[32+crow(r,hi)]);
  bf16*Ow=Ou+(long)(wid*QBLK)*OP;
  { bf16*stg=(bf16*)(shm+LDS_OST)+wid*2048;
    #pragma unroll
    for(int r=0;r<16;++r){const int orow=crow(r,hi);
      #pragma unroll
      for(int d0=0;d0<2;++d0)stg[orow*64+d0*32+r32]=__float2bfloat16(o[d0][r]*rli[r]);}
    asm volatile("s_waitcnt lgkmcnt(0)":::"memory");
    #pragma unroll
    for(int i=0;i<4;++i){const int row=i*8+(lane>>3),ch=lane&7; const u32x4 v=*(const u32x4*)(stg+row*64+ch*8); ATTN_STORE16(Ow+(long)row*OP+ch*8,v);} }
  asm volatile("s_waitcnt lgkmcnt(0)\n\ts_barrier":::"memory");
  #undef DMA_K
  #undef PHYS
  #undef DMA_V
  #undef CMASK
  #undef START
  #undef RESC
  #undef ROT
}
constexpr int ATTN_LDS_BYTES=LDS_BYTES;
#undef SBAR
#undef WAIT_BAR
}

#define GAS __attribute__((address_space(1)))
#define LAS __attribute__((address_space(3)))
typedef unsigned short bf16;
typedef unsigned v4u __attribute__((ext_vector_type(4)));
typedef float f32x4 __attribute__((ext_vector_type(4)));
typedef short bf16x8 __attribute__((ext_vector_type(8)));
typedef GAS unsigned gu32;
typedef GAS unsigned long long gu64;
#define RLX_AGENT __ATOMIC_RELAXED, __HIP_MEMORY_SCOPE_AGENT
#define LDS_WAIT() asm volatile("s_waitcnt lgkmcnt(0)" ::: "memory")
#define VM_WAIT() asm volatile("s_waitcnt vmcnt(0)" ::: "memory")
__device__ __forceinline__ unsigned long long rt() { return __builtin_amdgcn_s_memrealtime(); }
__device__ __forceinline__ unsigned f2bf(float f) { unsigned u = __builtin_bit_cast(unsigned, f); return (u + 0x7fffu + ((u >> 16) & 1u)) >> 16; }
__device__ __forceinline__ unsigned pk2(float lo, float hi) { return f2bf(lo) | (f2bf(hi) << 16); }

#define XB_TMO      128
#define XB_XCNT(j)  (256  + 64 * (j))
#define XB_XSUB(j)  (1280 + 64 * (j))
#define XB_XGEN(j)  (2304 + 64 * (j))
#define XB_TOP      3328
#define XB_TOPGEN   3392
#define XCD_BAR_WORDS 3456
#define XB_SPIN_CAP (1u << 18)

__device__ __forceinline__ unsigned xb_ld(unsigned* p)              { return __hip_atomic_load(p, __ATOMIC_RELAXED, __HIP_MEMORY_SCOPE_AGENT); }
__device__ __forceinline__ unsigned xb_add(unsigned* p, unsigned v) { return __hip_atomic_fetch_add(p, v, __ATOMIC_RELAXED, __HIP_MEMORY_SCOPE_AGENT); }
__device__ __forceinline__ unsigned xb_xcc_id() { return (unsigned)__builtin_amdgcn_s_getreg((3 << 11) | 20) & 0xFu; }
#define XB_SPIN(cond, bar) do { unsigned _sp = 0; while (cond) { __builtin_amdgcn_s_sleep(1); \
    if ((++_sp & 255u) == 0u) { if (xb_ld(&(bar)[XB_TMO])) break; if (_sp > XB_SPIN_CAP) { atomicAdd(&(bar)[XB_TMO], 1u); break; } } } } while (0)

struct XcdBarrier {
    unsigned* bar; unsigned x;
    volatile LAS unsigned* st;
};

__device__ __forceinline__ XcdBarrier xcd_barrier_post(unsigned* bar, volatile LAS unsigned* st) {
    XcdBarrier b; b.bar = bar; b.x = xb_xcc_id(); b.st = st;
    if (threadIdx.x == 0) (void)xb_add(&bar[XB_XCNT(b.x)], 1u);
    return b;
}
__device__ __forceinline__ void xcd_barrier_complete(unsigned* bar, unsigned x, unsigned& nloc, unsigned& nx) {
    const unsigned G = gridDim.x * gridDim.y * gridDim.z;
    unsigned sum, cnt, mine, sp = 0u;
    for (;;) {
        sum = 0u; cnt = 0u; mine = 0u;
#pragma unroll
        for (unsigned j = 0; j < 16; ++j) { const unsigned c = xb_ld(&bar[XB_XCNT(j)]); sum += c; cnt += (c > 0u) ? 1u : 0u; mine = (j == x) ? c : mine; }
        if (sum == G) break;
        __builtin_amdgcn_s_sleep(1);
        if ((++sp & 255u) == 0u) { if (xb_ld(&bar[XB_TMO])) break; if (sp > XB_SPIN_CAP) { atomicAdd(&bar[XB_TMO], 1u); break; } }
    }
    nloc = mine > 0u ? mine : 1u; nx = cnt > 0u ? cnt : 1u;
}

__device__ __forceinline__ void xcd_barrier(const XcdBarrier& b) {
    asm volatile("s_waitcnt vmcnt(0)" ::: "memory");
    __syncthreads();
    if (threadIdx.x == 0) {
        unsigned* bar = b.bar;
        __builtin_amdgcn_s_waitcnt(0);
        unsigned nloc = b.st[0], nx = b.st[1];
        if (nloc == 0u) { xcd_barrier_complete(bar, b.x, nloc, nx); b.st[0] = nloc; b.st[1] = nx; }
        const unsigned old = xb_add(&bar[XB_XSUB(b.x)], 1u);
        const unsigned gen = old / nloc;
        if (old + 1u == (gen + 1u) * nloc) {
            __builtin_amdgcn_fence(__ATOMIC_RELEASE, "agent");
            asm volatile("s_waitcnt vmcnt(0)" ::: "memory");
            const unsigned og = xb_add(&bar[XB_TOP], 1u);
            const unsigned tg = og / nx;
            if (og + 1u == (tg + 1u) * nx) xb_add(&bar[XB_TOPGEN], 1u);
            else XB_SPIN(xb_ld(&bar[XB_TOPGEN]) == tg, bar);
            __builtin_amdgcn_fence(__ATOMIC_ACQUIRE, "agent");
            xb_add(&bar[XB_XGEN(b.x)], 1u);
            asm volatile("s_waitcnt vmcnt(0)" ::: "memory");
        } else {
            XB_SPIN(xb_ld(&bar[XB_XGEN(b.x)]) == gen, bar);
            __builtin_amdgcn_fence(__ATOMIC_ACQUIRE, "agent");
            asm volatile("s_waitcnt vmcnt(0)" ::: "memory");
        }
    }
    __syncthreads();
}

typedef float f32x16 __attribute__((ext_vector_type(16)));
template <int I> __device__ __forceinline__ const float* karg() {
    const float* p;
    asm volatile("s_load_dwordx2 %0, %1, %2\n\ts_waitcnt lgkmcnt(0)" : "=s"(p) : "s"(__builtin_amdgcn_kernarg_segment_ptr()), "n"(I * 8) : "memory");
    return p;
}
struct Args { const float* in[26]; float* out; unsigned char* ws; int ph_lo, ph_hi; };
struct Frame {
    LAS unsigned char* lds;
    volatile LAS unsigned* MISC;
    gu32* ctl;
    unsigned char* ws;
    int tid, lane, wave, c, G;
    float* out;
};
#define WSP(T, off) ((T*)(F.ws + (off)))
__device__ __forceinline__ float wave_sum(float v) {
#pragma unroll
    for (int o = 1; o < 64; o <<= 1) v += __shfl_xor(v, o);
    return v;
}
__device__ __forceinline__ float bfbits2f(unsigned short s) { return __uint_as_float(((unsigned)s) << 16); }

__device__ __forceinline__ int frag_off(int r, int k) { return (k >> 4) * 512 + ((k >> 3) & 1) * 256 + r * 8 + (k & 7); }
__device__ __forceinline__ int map_swiglu(int c) { return c < FF ? 256 * (c >> 7) + (c & 127) : 256 * ((c - FF) >> 7) + 128 + ((c - FF) & 127); }
__device__ __forceinline__ int map_head(int c) { return (c & ~255) + 128 * ((c >> 5) & 1) + 32 * ((c >> 6) & 3) + (c & 31); }


template <int NPP, int BASE> struct KStream {
    static constexpr int NX = 1;
    unsigned char* ws; int c; bool on;
    int voff, voffe;
    f32x4 b0, b1, b2, b3, acc;
    const float* cur; const float* curB; int stride; float* dst;
    __device__ __forceinline__ void init(unsigned char* ws_, int c_, bool on_, int wave, int lane) {
        ws = ws_; c = c_; on = on_; voff = (wave >> 1) * 32 * 512 + (wave & 1) * 256 + 4 * lane; voffe = voff & 255;
        b0 = (f32x4){0.f, 0.f, 0.f, 0.f}; b1 = b0; b2 = b0; b3 = b0; acc = b0; cur = (const float*)(ws_ + WS_CTL) + CW_ZERO; curB = cur; stride = 0; dst = nullptr; }
    __device__ __forceinline__ void flush() {
        float* d = dst + ((voff >> 8) & 1) * 256 + ((voff & 255) >> 2);
        atomicAdd(d, acc[0]); atomicAdd(d + 64, acc[1]); atomicAdd(d + 128, acc[2]); atomicAdd(d + 192, acc[3]); }
    __device__ __forceinline__ f32x4 xload() const { f32x4 r; asm volatile("s_nop 4\n\tglobal_load_dwordx4 %0, %1, %2 nt" : "=v"(r) : "v"(voffe * 4), "s"(cur) : "memory"); return r; }
    __device__ __forceinline__ void wait() { asm volatile("s_waitcnt vmcnt(10)" : "+v"(b0), "+v"(b1), "+v"(b2), "+v"(b3) :: "memory"); }
    __device__ __forceinline__ void start_a() { b2 = xload(); }
    __device__ __forceinline__ void start() { b3 = xload(); }
    __device__ __forceinline__ void begin_unit(const int ui) {
        if (ui == 0) asm volatile("s_waitcnt vmcnt(0)" : "+v"(b0), "+v"(b1), "+v"(b2), "+v"(b3) :: "memory"); else asm volatile("" : "+v"(b0), "+v"(b1), "+v"(b2), "+v"(b3) :: "memory");
        acc += b0; acc += b1; acc += b2; acc += b3; b0 = (f32x4){0.f, 0.f, 0.f, 0.f}; b1 = b0; b2 = b0; b3 = b0;
        if (dst) flush();
        acc = (f32x4){0.f, 0.f, 0.f, 0.f};
        const int idx = BASE + (ui * 256 + c) * NPP; const float* zero = (const float*)(ws + WS_CTL) + CW_ZERO;
        if (on && idx + NPP <= 2048) { const int* pt = (const int*)karg<8>(); const float* ck = karg<3>();
            const int pa = __builtin_amdgcn_readfirstlane(pt[idx]), pb = __builtin_amdgcn_readfirstlane(pt[idx + NPP - 1]);
            cur = ck + (size_t)pa * (PAGE * 512); curB = ck + (size_t)pb * (PAGE * 512); stride = 512; voffe = voff;
            dst = (float*)(ws + WS_SKSUM) + (size_t)((idx >> 6) * 32 + ((idx & 63) >> 1)) * 512; }
        else { cur = zero; curB = zero; stride = 0; voffe = voff & 255; dst = nullptr; }
    }
    template <int SEL> __device__ __forceinline__ void sp(const int s, const int) {
        acc += SEL == 0 ? b0 : (SEL == 1 ? b1 : (SEL == 2 ? b2 : b3));
        if (NPP == 2) { if (s == 32) cur = curB; }
        if (s == NPP * 32) { cur = (const float*)(ws + WS_CTL) + CW_ZERO; stride = 0; voffe = voff & 255; }
        const f32x4 v = xload(); cur += stride;
        if (SEL == 0) b0 = v; else if (SEL == 1) b1 = v; else if (SEL == 2) b2 = v; else b3 = v;
    }
    __device__ __forceinline__ void finish() { asm volatile("s_waitcnt vmcnt(0)" : "+v"(b0), "+v"(b1), "+v"(b2), "+v"(b3) :: "memory"); acc += b0; acc += b1; acc += b2; acc += b3; if (dst) flush(); dst = nullptr; }
};

__device__ __forceinline__ void p0_transpose_item(const float* W, int K, int N, bf16* WT, int prow0, const float* gain, LAS float* scr, int k0, int n0, int lane) {
    const int r8 = lane >> 3, c4 = lane & 7;
    f32x4 w[8]; float gk[8];
#pragma unroll
    for (int i = 0; i < 8; ++i) { const int kk = 8 * i + r8; w[i] = __builtin_nontemporal_load((const f32x4*)(W + (size_t)(k0 + kk) * N + n0 + 4 * c4)); gk[i] = gain ? gain[k0 + kk] : 1.0f; }
#pragma unroll
    for (int i = 0; i < 8; ++i) { const int kk = 8 * i + r8; LAS float* d = scr + kk * 33 + 4 * c4; d[0] = w[i][0] * gk[i]; d[1] = w[i][1] * gk[i]; d[2] = w[i][2] * gk[i]; d[3] = w[i][3] * gk[i]; }
    LDS_WAIT(); asm volatile("" ::: "memory");
    const int c = lane & 7;
#pragma unroll
    for (int j = 0; j < 4; ++j) { const int n = (lane >> 3) + 8 * j; const LAS float* s = scr + (8 * c) * 33 + n;
        v4u o; o.x = pk2(s[0 * 33], s[1 * 33]); o.y = pk2(s[2 * 33], s[3 * 33]); o.z = pk2(s[4 * 33], s[5 * 33]); o.w = pk2(s[6 * 33], s[7 * 33]);
        *(GAS v4u*)(WT + (size_t)(prow0 + n) * K + k0 + 8 * c) = o; }
    LDS_WAIT(); asm volatile("" ::: "memory");
}
template <int NR> __device__ __forceinline__ void rows_to_bf16(Frame& F, const float* x, bf16* o, float* ssq, const int m0, const int step) {
    f32x4 v[NR][4];
#pragma unroll
    for (int r = 0; r < NR; ++r)
#pragma unroll
        for (int j = 0; j < 4; ++j) v[r][j] = __builtin_nontemporal_load((const f32x4*)(x + (size_t)(m0 + r * step) * DM) + F.lane + 64 * j);
#pragma unroll
    for (int r = 0; r < NR; ++r) { float s = 0.f;
#pragma unroll
        for (int j = 0; j < 4; ++j) s += (v[r][j].x * v[r][j].x + v[r][j].y * v[r][j].y) + (v[r][j].z * v[r][j].z + v[r][j].w * v[r][j].w);
        s = wave_sum(s);
        GAS unsigned long long* o8 = (GAS unsigned long long*)(o + (size_t)(m0 + r * step) * DM) + F.lane;
#pragma unroll
        for (int j = 0; j < 4; ++j) o8[64 * j] = (unsigned long long)pk2(v[r][j].x, v[r][j].y) | ((unsigned long long)pk2(v[r][j].z, v[r][j].w) << 32);
        if (F.lane == 0) ssq[m0 + r * step] = s; }
}
constexpr int CV_A = (DM / 64) * (FF2 / 32), CV_B = (FF / 64) * (DM / 32), CV_IN = (DM / 64) * (INC / 32), CV_OUT = (DM / 64) * (DM / 32), CV_MEM = (DM / 64) * (512 / 32);
constexpr int CV_EARLY = CV_A + CV_MEM, CV_MID = CV_EARLY + CV_A + CV_B + CV_IN + CV_OUT, CV_ALL = CV_MID + CV_B;
__device__ __forceinline__ void convert_items(Frame& F, const int first, const int last, const int w, const int nw) {
    LAS float* scr = (LAS float*)(F.lds + RING_OFF + F.wave * 16384);
    for (int it = first + w; it < last; it += nw) {
        int r = it;
        if (r < CV_A) { const int nblk = FF2 / 32, kb = r / nblk, nb = r % nblk; p0_transpose_item(karg<10>(), DM, FF2, WSP(bf16, WS_W1A), map_swiglu(32 * nb), karg<9>(), scr, 64 * kb, 32 * nb, F.lane); continue; }
        r -= CV_A;
        if (r < CV_MEM) { const int nblk = 512 / 32, kb = r / nblk, nb = r % nblk; p0_transpose_item(karg<19>(), DM, 512, WSP(bf16, WS_WMEM), map_head(32 * nb), karg<18>(), scr, 64 * kb, 32 * nb, F.lane); continue; }
        r -= CV_MEM;
        if (r < CV_A) { const int nblk = FF2 / 32, kb = r / nblk, nb = r % nblk; p0_transpose_item(karg<24>(), DM, FF2, WSP(bf16, WS_W2A), map_swiglu(32 * nb), karg<23>(), scr, 64 * kb, 32 * nb, F.lane); continue; }
        r -= CV_A;
        if (r < CV_B) { const int nblk = DM / 32, kb = r / nblk, nb = r % nblk; p0_transpose_item(karg<11>(), FF, DM, WSP(bf16, WS_W1B), 32 * nb, nullptr, scr, 64 * kb, 32 * nb, F.lane); continue; }
        r -= CV_B;
        if (r < CV_IN) { const int nblk = INC / 32, kb = r / nblk, nb = r % nblk; p0_transpose_item(karg<13>(), DM, INC, WSP(bf16, WS_WIN), map_head(32 * nb), karg<12>(), scr, 64 * kb, 32 * nb, F.lane); continue; }
        r -= CV_IN;
        if (r < CV_OUT) { const int nblk = DM / 32, kb = r / nblk, nb = r % nblk; p0_transpose_item(karg<22>(), DM, DM, WSP(bf16, WS_WOUT), 32 * nb, nullptr, scr, 64 * kb, 32 * nb, F.lane); continue; }
        r -= CV_OUT;
        { const int nblk = DM / 32, kb = r / nblk, nb = r % nblk; p0_transpose_item(karg<25>(), FF, DM, WSP(bf16, WS_W2B), 32 * nb, nullptr, scr, 64 * kb, 32 * nb, F.lane); }
    }
}
__device__ __forceinline__ void p0_prologue(Frame& F) {
    const int gw = F.c * NWAVES + F.wave, NGW = F.G * NWAVES;
    if (F.c < 128) {
        const int* pt = (const int*)karg<8>(); const float* ck = karg<3>(); float* sks = WSP(float, WS_SKSUM);
        const int idx = 1920 + F.c, phys = pt[idx]; const int voff = (F.wave >> 1) * 32 * 512 + (F.wave & 1) * 256 + 4 * F.lane;
        const float* base = ck + (size_t)phys * (PAGE * 512) + voff; f32x4 a = {0.f, 0.f, 0.f, 0.f};
#pragma unroll 16
        for (int r = 0; r < 32; ++r) a += __builtin_nontemporal_load((const f32x4*)(base + (size_t)r * 512));
        float* d = sks + (size_t)((idx >> 6) * 32 + ((idx & 63) >> 1)) * 512 + (F.wave & 1) * 256 + F.lane;
        atomicAdd(d, a[0]); atomicAdd(d + 64, a[1]); atomicAdd(d + 128, a[2]); atomicAdd(d + 192, a[3]);
    }
    convert_items(F, 0, CV_EARLY, gw, NGW);
    { const float* xin_ = karg<0>(); const float* min_ = karg<2>();
    for (int m = gw; m + 3 * NGW < MP; m += 4 * NGW) rows_to_bf16<4>(F, xin_, WSP(bf16, WS_XB), WSP(float, WS_SSQ0), m, NGW);
    for (int m = gw; m < MM; m += NGW) rows_to_bf16<1>(F, min_, WSP(bf16, WS_MNB), WSP(float, WS_SSQ0) + MP, m, NGW); }
    if (F.c == 0 && F.tid < 256) { const int w = F.tid >> 6, d = F.tid & 63; const float* src = w == 0 ? karg<16>() : (w == 1 ? karg<17>() : (w == 2 ? karg<20>() : karg<21>())); WSP(float, WS_GAIN)[F.tid] = src[d]; }
    if (F.c == 255) { const float* xs = karg<1>(); bf16* img = WSP(bf16, S_IMGX); float* sq = (float*)(F.ws + WS_CTL) + CW_SSQS;
#pragma unroll
        for (int i = 0; i < 4; ++i) { const int r = F.wave * 4 + i; float ss = 0.f;
#pragma unroll
            for (int j = 0; j < 4; ++j) { const int k = j * 256 + 4 * F.lane; const f32x4 v = *(const f32x4*)(xs + r * DM + k); ss += (v.x * v.x + v.y * v.y) + (v.z * v.z + v.w * v.w);
                *(unsigned long long*)(img + frag_off(r, k)) = (unsigned long long)pk2(v.x, v.y) | ((unsigned long long)pk2(v.z, v.w) << 32); }
            ss = wave_sum(ss); if (F.lane == 0) sq[r] = ss; } }
    for (int i = F.c * 512 + F.tid; i < (SEQ + 1) * 8; i += F.G * 512) { const int p = i >> 3, f = i & 7; const float pos = (p == SEQ) ? (float)PAST : (float)p;
        const float inv = powf(500000.0f, -(float)f * 0.125f); const float ang = pos * inv;
        const double kk = rint((double)ang * 0.15915494309189535); const float rr = (float)((double)ang - kk * 6.283185307179586);
        float* rp = WSP(float, WS_ROPE) + (size_t)i * 2; rp[0] = cosf(rr); rp[1] = sinf(rr); }
}

template <int UNR, int NCB, class AL, class BR, class EP>
__device__ __forceinline__ void sgemm_unit(Frame& F, const AL& al, const BR& br, const bf16* Bt, const int K, const EP& ep) {
    LAS float* red = (LAS float*)(F.lds + RING_OFF);
    LAS unsigned char* bbuf = F.lds + RING_OFF + F.wave * 16384;
    const int r32 = F.lane & 31, hi = F.lane >> 5, nch = K >> 6, c0 = (nch * F.wave) >> 3, c1 = (nch * (F.wave + 1)) >> 3;
    f32x16 acc0 = {}, acc1 = {};
    const int srow = F.lane >> 3, spc = F.lane & 7;
    constexpr int NI = 4 * NCB;
    const bf16* gsrc[NI];
#pragma unroll
    for (int i = 0; i < NI; ++i) { const int row = 8 * i + srow; gsrc[i] = Bt + (size_t)br(row >> 5, row & 31) * K + spc * 8; }
    v4u stg[NI];
#pragma unroll
    for (int i = 0; i < NI; ++i) stg[i] = *(const v4u*)(gsrc[i] + c0 * 64);
    for (int c = c0; c < c1; ++c) {
        bf16x8 a[4];
#pragma unroll
        for (int st = 0; st < 4; ++st) a[st] = al(r32, c * 64 + st * 16 + 8 * hi);
#pragma unroll
        for (int i = 0; i < NI; ++i) *(LAS v4u*)(bbuf + (8 * i + srow) * 144 + spc * 16) = stg[i];
        if (c + 1 < c1) {
#pragma unroll
            for (int i = 0; i < NI; ++i) stg[i] = *(const v4u*)(gsrc[i] + (c + 1) * 64); }
#pragma unroll
        for (int st = 0; st < 4; ++st) { const bf16x8 b0 = *(const LAS bf16x8*)(bbuf + r32 * 144 + st * 32 + hi * 16);
            acc0 = __builtin_amdgcn_mfma_f32_32x32x16_bf16(a[st], b0, acc0, 0, 0, 0);
            if (NCB == 2) { const bf16x8 b1 = *(const LAS bf16x8*)(bbuf + (32 + r32) * 144 + st * 32 + hi * 16); acc1 = __builtin_amdgcn_mfma_f32_32x32x16_bf16(a[st], b1, acc1, 0, 0, 0); } }
    }
    __syncthreads();
#pragma unroll
    for (int r = 0; r < 16; ++r) { const int row = (r & 3) + 8 * (r >> 2) + 4 * hi; red[(F.wave * 32 + row) * 64 + r32] = acc0[r]; if (NCB == 2) red[(F.wave * 32 + row) * 64 + 32 + r32] = acc1[r]; }
    __syncthreads();
    const int row = F.tid >> 4, c4 = (F.tid & 15) * 4; f32x4 s = {0.f, 0.f, 0.f, 0.f};
#pragma unroll
    for (int w = 0; w < 8; ++w) s += *(const LAS f32x4*)(red + (w * 32 + row) * 64 + (NCB == 2 ? c4 : (c4 & 31)));
    ep(row, c4, s);
    __syncthreads();
}
__device__ __forceinline__ bf16x8 pack_bf16x8(const f32x4 a, const f32x4 b) { v4u w; w.x = pk2(a[0], a[1]); w.y = pk2(a[2], a[3]); w.z = pk2(b[0], b[1]); w.w = pk2(b[2], b[3]); return __builtin_bit_cast(bf16x8, w); }
struct ALLds { const LAS bf16* img;
    __device__ __forceinline__ bf16x8 operator()(int r, int k) const { return *(const LAS bf16x8*)(img + frag_off(r, k)); } };
struct ALFrag { const bf16* img;
    __device__ __forceinline__ bf16x8 operator()(int r, int k) const { return *(const bf16x8*)(img + frag_off(r, k)); } };
__device__ __forceinline__ void stage_a_lds(Frame& F, const float* x, const int ld, const LAS float* rs, LAS bf16* img) {
    f32x4 v[16];
#pragma unroll
    for (int j = 0; j < 16; ++j) { const int idx = F.tid + 512 * j, r = idx >> 8, k4 = (idx & 255) * 4; v[j] = *(const f32x4*)(x + r * ld + k4); }
#pragma unroll
    for (int j = 0; j < 16; ++j) { const int idx = F.tid + 512 * j, r = idx >> 8, k4 = (idx & 255) * 4; const float sc = rs ? rs[r] : 1.0f;
        *(LAS unsigned long long*)(img + frag_off(r, k4)) = (unsigned long long)pk2(v[j].x * sc, v[j].y * sc) | ((unsigned long long)pk2(v[j].z * sc, v[j].w * sc) << 32); }
    __syncthreads();
}
__device__ __forceinline__ void sample_rs(Frame& F, const float* x, LAS float* rs) {
#pragma unroll
    for (int i = 0; i < 4; ++i) { const int r = F.wave * 4 + i; float s = 0.f;
#pragma unroll
        for (int j = 0; j < 4; ++j) { const f32x4 v = *(const f32x4*)(x + r * DM + j * 256 + 4 * F.lane); s += (v.x * v.x + v.y * v.y) + (v.z * v.z + v.w * v.w); }
        s = wave_sum(s); if (F.lane == 0) rs[r] = 1.0f / sqrtf(s * (1.0f / DM) + RMS_EPS); }
    __syncthreads();
}
struct BRSwiglu { int v; __device__ __forceinline__ int operator()(int cb, int c) const { return 256 * (v >> 2) + 32 * (v & 3) + 128 * cb + c; } };
struct BRPlain { int v; __device__ __forceinline__ int operator()(int cb, int c) const { return 64 * v + 32 * cb + c; } };
struct BRPlain32 { int v; __device__ __forceinline__ int operator()(int, int c) const { return 32 * v + c; } };
struct BRHead { int v; __device__ __forceinline__ int operator()(int cb, int c) const { return 256 * (v >> 2) + 128 * cb + 32 * (v & 3) + c; } };
struct EPSwigluFrag { bf16* img; int v; const float* ssq;
    __device__ __forceinline__ void operator()(int row, int c4, f32x4 s) const {
        s = s * (1.0f / sqrtf(ssq[row] * (1.0f / DM) + RMS_EPS));
        f32x4 u; u.x = __shfl_xor(s.x, 8); u.y = __shfl_xor(s.y, 8); u.z = __shfl_xor(s.z, 8); u.w = __shfl_xor(s.w, 8);
        if (c4 < 32) { const int k = 32 * v + c4;
            *(unsigned long long*)(img + frag_off(row, k)) = (unsigned long long)pk2(pg8::silu_f(s.x) * u.x, pg8::silu_f(s.y) * u.y) | ((unsigned long long)pk2(pg8::silu_f(s.z) * u.z, pg8::silu_f(s.w) * u.w) << 32); } } };
template <int KIND> struct EPResid { unsigned char* ws; float* outp; const float* xs; int v;
    __device__ __forceinline__ void operator()(int row, int c4, f32x4 s) const { const bool valid = c4 < 32; const int o = row * DM + 32 * v + (c4 & 31);
        const float* base = KIND == 2 ? xs : (const float*)(ws + (KIND == 5 ? S_X1 : S_X2)); float* out = KIND == 2 ? (float*)(ws + S_X1) : (KIND == 5 ? (float*)(ws + S_X2) : outp + O_YS);
        const float alpha = KIND == 5 ? 1.0f : 0.5f;
        f32x4 r = {0.f, 0.f, 0.f, 0.f}; if (valid) { r = *(const f32x4*)(base + o) + alpha * s; *(f32x4*)(out + o) = r; }
        if (KIND != 7) { bf16* img = (bf16*)(ws + (KIND == 2 ? S_IMGX1 : S_IMGX2)); float* ssq = (float*)(ws + WS_CTL) + CW_SSQS + (KIND == 2 ? 32 : 64);
            if (valid) *(unsigned long long*)(img + frag_off(row, 32 * v + c4)) = (unsigned long long)pk2(r.x, r.y) | ((unsigned long long)pk2(r.z, r.w) << 32);
            float ss = (r.x * r.x + r.y * r.y) + (r.z * r.z + r.w * r.w); ss += __shfl_xor(ss, 1); ss += __shfl_xor(ss, 2); ss += __shfl_xor(ss, 4); ss += __shfl_xor(ss, 8);
            if ((c4 >> 2) == 0) atomicAdd(ssq + row, ss); } } };
struct EPProjS { int v; unsigned char* ws; float* outp; const float* ssq;
    __device__ __forceinline__ void operator()(int row, int c4, f32x4 s) const {
        s = s * (1.0f / sqrtf(ssq[row] * (1.0f / DM) + RMS_EPS));
        if (v < 4) { *(f32x4*)((float*)(ws + S_U) + row * 256 + 64 * v + c4) = s; return; }
        if (v >= 20 && v < 28) { *(f32x4*)(outp + O_VS + row * 512 + 64 * (v - 20) + c4) = s; return; }
        float ss = (s.x * s.x + s.y * s.y) + (s.z * s.z + s.w * s.w);
        ss += __shfl_xor(ss, 1); ss += __shfl_xor(ss, 2); ss += __shfl_xor(ss, 4); ss += __shfl_xor(ss, 8);
        const float hn = 1.0f / sqrtf(ss * (1.0f / 64.0f) + RMS_EPS);
        const float* g = (const float*)(ws + WS_GAIN) + ((v < 12) ? 0 : (v < 20 ? 64 : 128));
        const f32x4 gv = *(const f32x4*)(g + c4); s = s * hn * gv;
        if (v < 20) {
            const float* rope8192 = (const float*)(ws + WS_ROPE) + SEQ * 16;
            f32x4 y; y.x = __shfl_xor(s.x, 2); y.y = __shfl_xor(s.y, 2); y.z = __shfl_xor(s.z, 2); y.w = __shfl_xor(s.w, 2);
            if (c4 < 16) { const int f0 = c4 & 7; const float sg = (c4 < 8) ? -1.f : 1.f; f32x4 r_;
#pragma unroll
                for (int i = 0; i < 4; ++i) { const float cs_ = rope8192[2 * (f0 + i)], sn = rope8192[2 * (f0 + i) + 1]; r_[i] = s[i] * cs_ + sg * y[i] * sn; }
                s = r_; }
        }
        if (v < 12) *(f32x4*)((float*)(ws + S_Q) + row * 512 + 64 * (v - 4) + c4) = s;
        else if (v < 20) *(f32x4*)(outp + O_KS + row * 512 + 64 * (v - 12) + c4) = s;
        else *(f32x4*)((float*)(ws + S_QM) + row * 256 + 64 * (v - 28) + c4) = s;
    } };

__device__ __forceinline__ void pool_unit(Frame& F, const int pm, const int g) {
    const bf16* U = WSP(bf16, WS_U); bf16* MIX = WSP(bf16, WS_MIX); const float* pw = karg<14>() + g * 4096; const float* psc = karg<15>() + 64 * g;
    const int r32 = F.lane & 31, hi = F.lane >> 5, row = pm * 256 + F.wave * 32 + r32, t = row & (SEQ - 1), W = 2 << g;
    const int cnt = (t + 1 < W) ? t + 1 : W; const float rc = 1.0f / (float)cnt;
    bf16x8 bfr[4][2];
#pragma unroll
    for (int s = 0; s < 4; ++s)
#pragma unroll
        for (int cb = 0; cb < 2; ++cb) { float w[8];
#pragma unroll
            for (int j = 0; j < 8; ++j) w[j] = pw[(16 * s + 8 * hi + j) * 64 + 32 * cb + r32];
            v4u p; p.x = pk2(w[0], w[1]); p.y = pk2(w[2], w[3]); p.z = pk2(w[4], w[5]); p.w = pk2(w[6], w[7]); bfr[s][cb] = __builtin_bit_cast(bf16x8, p); }
    f32x16 acc0 = {}, acc1 = {};
#pragma unroll
    for (int s = 0; s < 4; ++s) { const bf16* up = U + (size_t)row * 256 + 64 * g + 16 * s + 8 * hi;
        bf16x8 xw[16];
#pragma unroll
        for (int i = 0; i < 16; ++i) if (i < W) xw[i] = *(const bf16x8*)(up - (size_t)((i < cnt) ? i : 0) * 256);
        float sum[8], self[8];
#pragma unroll
        for (int j = 0; j < 8; ++j) { self[j] = bfbits2f((unsigned short)xw[0][j]); sum[j] = self[j]; }
#pragma unroll
        for (int i = 1; i < 16; ++i) if (i < W) { const float wgt = (i < cnt) ? 1.f : 0.f;
#pragma unroll
            for (int j = 0; j < 8; ++j) sum[j] += wgt * bfbits2f((unsigned short)xw[i][j]); }
        v4u p;
        p.x = pk2(sum[0] * rc - self[0], sum[1] * rc - self[1]); p.y = pk2(sum[2] * rc - self[2], sum[3] * rc - self[3]); p.z = pk2(sum[4] * rc - self[4], sum[5] * rc - self[5]); p.w = pk2(sum[6] * rc - self[6], sum[7] * rc - self[7]);
        const bf16x8 a = __builtin_bit_cast(bf16x8, p);
        acc0 = __builtin_amdgcn_mfma_f32_32x32x16_bf16(a, bfr[s][0], acc0, 0, 0, 0); acc1 = __builtin_amdgcn_mfma_f32_32x32x16_bf16(a, bfr[s][1], acc1, 0, 0, 0); }
    const float sc0 = psc[r32], sc1 = psc[32 + r32];
    bf16* ob = MIX + (size_t)(pm * 256 + F.wave * 32) * DM + 64 * g;
#pragma unroll
    for (int r = 0; r < 16; ++r) { const int orow = (r & 3) + 8 * (r >> 2) + 4 * hi; ob[(size_t)orow * DM + r32] = (bf16)f2bf(acc0[r] * sc0); ob[(size_t)orow * DM + 32 + r32] = (bf16)f2bf(acc1[r] * sc1); }
}

template <int PER, int CH, class KPF, class VPF>
__device__ __forceinline__ void dec_attn(Frame& F, const float* q, const KPF& KP, const VPF& VP, const float* xk, const float* xv, float* outp, bf16* imgp, const int irow, const int icol) {
    LAS float* st = (LAS float*)(F.lds + RING_OFF);
    const int l16 = F.lane & 15, grp = F.wave * 4 + (F.lane >> 4);
    f32x4 q4 = *(const f32x4*)(q + 4 * l16); q4 = q4 * C2;
    float m = -INFINITY, l = 0.f; f32x4 o = {0.f, 0.f, 0.f, 0.f};
#pragma unroll
    for (int c0 = 0; c0 < PER; c0 += CH) {
        f32x4 kv[CH], vv[CH]; float d[CH];
#pragma unroll
        for (int it = 0; it < CH; ++it) { const int i = grp * PER + c0 + it; kv[it] = *(const f32x4*)(KP(i) + 4 * l16); vv[it] = *(const f32x4*)(VP(i) + 4 * l16); }
        float mc = -INFINITY;
#pragma unroll
        for (int it = 0; it < CH; ++it) { float x = (q4.x * kv[it].x + q4.y * kv[it].y) + (q4.z * kv[it].z + q4.w * kv[it].w);
            x += __shfl_xor(x, 1); x += __shfl_xor(x, 2); x += __shfl_xor(x, 4); x += __shfl_xor(x, 8); d[it] = x; mc = fmaxf(mc, x); }
        const float mn = fmaxf(m, mc), f = __builtin_amdgcn_exp2f(m - mn); l *= f; o = o * f; m = mn;
#pragma unroll
        for (int it = 0; it < CH; ++it) { const float p = __builtin_amdgcn_exp2f(d[it] - mn); l += p; o = o + p * vv[it]; }
    }
    if (l16 == 0) { st[grp * 68] = m; st[grp * 68 + 1] = l; }
    *(LAS f32x4*)(st + grp * 68 + 4 + 4 * l16) = o;
    if (F.wave == 0 && F.lane < 16) {
        if (xk) { const f32x4 kx = *(const f32x4*)(xk + 4 * l16); float x = (q4.x * kx.x + q4.y * kx.y) + (q4.z * kx.z + q4.w * kx.w);
            x += __shfl_xor(x, 1); x += __shfl_xor(x, 2); x += __shfl_xor(x, 4); x += __shfl_xor(x, 8);
            if (l16 == 0) { st[32 * 68] = x; st[32 * 68 + 1] = 1.f; } *(LAS f32x4*)(st + 32 * 68 + 4 + 4 * l16) = *(const f32x4*)(xv + 4 * l16); }
        else { if (l16 == 0) { st[32 * 68] = -INFINITY; st[32 * 68 + 1] = 0.f; } *(LAS f32x4*)(st + 32 * 68 + 4 + 4 * l16) = (f32x4){0.f, 0.f, 0.f, 0.f}; }
    }
    __syncthreads();
    if (F.tid < 64) { float M = -INFINITY;
#pragma unroll
        for (int i = 0; i < 33; ++i) M = fmaxf(M, st[i * 68]);
        float L = 0.f, O = 0.f;
#pragma unroll
        for (int i = 0; i < 33; ++i) { const float e = __builtin_amdgcn_exp2f(st[i * 68] - M); L += st[i * 68 + 1] * e; O += st[i * 68 + 4 + F.tid] * e; }
        outp[F.tid] = O / L; if (imgp) imgp[frag_off(irow, icol + F.tid)] = (bf16)f2bf(O / L); }
    __syncthreads();
}
struct KPaged { const float* base; unsigned long long pa; unsigned pb; int hoff;
    __device__ __forceinline__ const float* operator()(int i) const { const int sl = i >> 7; const unsigned long long w = sl < 4 ? pa : (unsigned long long)pb; const unsigned page = (unsigned)(w >> (16 * (sl & 3))) & 0xffffu; return base + ((size_t)page * PAGE + (i & 127)) * 512 + hoff; } };
struct KLin { const float* base; int ld; __device__ __forceinline__ const float* operator()(int i) const { return base + (size_t)i * ld; } };

__device__ __forceinline__ void sample_item(Frame& F, const int item) {
    float* smix = WSP(float, S_MIX);
    if (item < 256) {
        const int b = item >> 3, h = item & 7; const float* q = WSP(float, S_Q) + b * 512 + h * 64;
        const int myp = ((const int*)karg<8>())[b * NPG + F.lane];
        const int j = F.lane & 31, hh = F.lane >> 5; float sc = 0.f;
        { const float* sj = WSP(float, WS_SKSUM) + ((size_t)b * 32 + j) * 512 + (h >> 2) * 256 + ((h & 3) * 64 + 32 * hh) / 4;
#pragma unroll
          for (int jj = 0; jj < 4; ++jj) { const f32x4 k0 = *(const f32x4*)(sj + 64 * jj), k1 = *(const f32x4*)(sj + 64 * jj + 4);
            sc += (q[32 * hh + jj] * k0[0] + q[32 * hh + jj + 4] * k0[1]) + (q[32 * hh + jj + 8] * k0[2] + q[32 * hh + jj + 12] * k0[3]) + (q[32 * hh + jj + 16] * k1[0] + q[32 * hh + jj + 20] * k1[1]) + (q[32 * hh + jj + 24] * k1[2] + q[32 * hh + jj + 28] * k1[3]); } }
        sc += __shfl_xor(sc, 32);
        int cntb = 0;
        for (int i = 0; i < 32; ++i) { const float o = __shfl(sc, i); cntb += ((o > sc) || (o == sc && i < j)) ? 1 : 0; }
        const unsigned long long bal = __ballot(cntb < 3 && F.lane < 32);
        const unsigned msk = (unsigned)bal; const int b0 = __builtin_ctz(msk), b1 = __builtin_ctz(msk & (msk - 1)), b2 = __builtin_ctz(msk & (msk - 1) & ((msk & (msk - 1)) - 1));
        const unsigned g0 = (unsigned)__shfl(myp, 2 * b0), g1 = (unsigned)__shfl(myp, 2 * b0 + 1), g2 = (unsigned)__shfl(myp, 2 * b1), g3 = (unsigned)__shfl(myp, 2 * b1 + 1), g4 = (unsigned)__shfl(myp, 2 * b2), g5 = (unsigned)__shfl(myp, 2 * b2 + 1);
        const unsigned long long pa_ = (unsigned long long)g0 | ((unsigned long long)g1 << 16) | ((unsigned long long)g2 << 32) | ((unsigned long long)g3 << 48); const unsigned pb_ = g4 | (g5 << 16);
        const KPaged KPf{karg<3>(), pa_, pb_, h * 64}, VPf{karg<4>(), pa_, pb_, h * 64};
        dec_attn<24, 24>(F, q, KPf, VPf, F.out + O_KS + b * 512 + h * 64, F.out + O_VS + b * 512 + h * 64, smix + b * DM + 256 + h * 64, WSP(bf16, S_IMGMIX), b, 256 + h * 64);
    } else if (item < 384) {
        const int b = (item - 256) >> 2, h = (item - 256) & 3; const float* q = WSP(float, S_QM) + b * 256 + h * 64;
        const KLin KPf{karg<5>() + (size_t)b * MEML * 256 + h * 64, 256}, VPf{karg<6>() + (size_t)b * MEML * 256 + h * 64, 256};
        dec_attn<8, 8>(F, q, KPf, VPf, nullptr, nullptr, smix + b * DM + 768 + h * 64, WSP(bf16, S_IMGMIX), b, 768 + h * 64);
    } else if (item < 416) {
        const int b = item - 384; LAS float* pl = (LAS float*)(F.lds + RING_OFF);
        const float* stp = karg<7>() + (size_t)b * 15 * 256; const float* su = WSP(float, S_U) + b * 256; float* pso = F.out + O_PSS + (size_t)b * 15 * 256;
        if (F.tid < 256) { const int c = F.tid, g = c >> 6, W = 2 << g; const float u = su[c]; float s = u;
            float wv[15];
#pragma unroll
            for (int i = 1; i < 16; ++i) wv[i - 1] = stp[(15 - i) * 256 + c];
#pragma unroll
            for (int i = 1; i < 16; ++i) s += (i < W) ? wv[i - 1] : 0.f;
            pl[c] = s / (float)W - u;
            for (int i = 0; i < 14; ++i) pso[i * 256 + c] = stp[(i + 1) * 256 + c];
            pso[14 * 256 + c] = u; }
        __syncthreads();
        if (F.tid < 256) { const int c = F.tid, g = c >> 6, d = c & 63; const float* pw = karg<14>() + g * 4096; float a = 0.f;
#pragma unroll
            for (int cc = 0; cc < 64; ++cc) a += pl[64 * g + cc] * pw[cc * 64 + d];
            const float y_ = a * karg<15>()[c]; smix[b * DM + c] = y_; WSP(bf16, S_IMGMIX)[frag_off(b, c)] = (bf16)f2bf(y_); }
        __syncthreads();
    }
}

__global__ void __launch_bounds__(NWAVES * 64, 2) hymba_fwd(Args args) {
    extern __shared__ __attribute__((aligned(16))) unsigned char lds[];
    Frame F;
    F.lds = (LAS unsigned char*)lds;
    F.MISC = (volatile LAS unsigned*)(F.lds + MISC_OFF);
    F.tid = threadIdx.x; F.lane = F.tid & 63; F.wave = __builtin_amdgcn_readfirstlane(F.tid >> 6);
    F.G = gridDim.x; F.c = blockIdx.x;
    F.ws = args.ws; F.ctl = (gu32*)(args.ws + WS_CTL); F.out = args.out;
    { int t0_ = F.tid; asm volatile("" : "+v"(t0_));
      for (int u = t0_; u < (ROPE_OFF - LDSCTL_OFF) / 4; u += NWAVES * 64) ((LAS unsigned*)(F.lds + LDSCTL_OFF))[u] = 0u; }
    __syncthreads();
    XcdBarrier bar; bar.bar = (unsigned*)(F.ctl + CW_BAR); bar.x = 0; bar.st = nullptr;
    if (N_LAUNCHES == 1) bar = xcd_barrier_post((unsigned*)(F.ctl + CW_BAR), F.MISC + 8);
#define GRID_BAR() do { if (N_LAUNCHES == 1) xcd_barrier(bar); } while (0)
    const int lo = args.ph_lo, hi = args.ph_hi;
    pg8::NoStream nostream;
#ifdef DBG_ONLY
#define IN(k) ((k) == DBG_ONLY && lo <= (k) && (k) < hi)
#else
#define IN(k) (lo <= (k) && (k) < hi)
#endif
#define rs ((LAS float*)(F.lds + SM_OFF))
#define ssq1 ((float*)(F.ws + WS_CTL) + CW_SSQ1)
#define ssq2 ((float*)(F.ws + WS_CTL) + CW_SSQ2)
#define ksum ((float*)(F.ws + WS_CTL) + CW_KSUM)
#define ssq0 WSP(float, WS_SSQ0)

#define FRESH() do { int t2_ = threadIdx.x, c2_ = blockIdx.x; asm volatile("" : "+v"(t2_)); asm volatile("" : "+s"(c2_)); F.tid = t2_; F.lane = t2_ & 63; F.wave = __builtin_amdgcn_readfirstlane(t2_ >> 6); F.c = c2_; \
        unsigned char* w2_ = args.ws; float* o2_ = args.out; asm volatile("" : "+s"(w2_)); asm volatile("" : "+s"(o2_)); F.ws = w2_; F.out = o2_; F.ctl = (gu32*)(w2_ + WS_CTL); } while (0)
    if (IN(0)) for (int rep_ = 0; rep_ < REP0; ++rep_) { FRESH(); p0_prologue(F); GRID_BAR(); }

    if (IN(1)) for (int rep_ = 0; rep_ < REP1; ++rep_) { FRESH();
        { pg8::Gemm g{WSP(bf16, WS_XB), WSP(bf16, WS_W1A), MP, FF2, DM}; pg8::StaticOrder S; S.init(MP, FF2, F.G, F.c);
          pg8::EpiSwiglu<false> E{WSP(bf16, WS_H), ssq0, FF, {}};
          KStream<1, 0> X; X.init(F.ws, F.c, !(rep_ + 1 < REP1), F.wave, F.lane);
          pg8::gemm_phase<pg8::EpiSwiglu<false>, pg8::StaticOrder, true, true, KStream<1, 0>>(F.lds + RING_OFF, g, S, E, X); }
        if (F.c >= 128 && F.c < 144) { pg8::Gemm g{WSP(bf16, WS_MNB), WSP(bf16, WS_WMEM), MM, 512, DM}; pg8::ListOrder S; S.init(MM / 256, 2, 128, F.c);
          pg8::EpiHead<true> E{ssq0 + MP, nullptr, F.out, nullptr, F.ws, C2};
          pg8::gemm_phase<pg8::EpiHead<true>, pg8::ListOrder, true, true>(F.lds + RING_OFF, g, S, E, nostream); }
        FRESH();
        if (F.c >= 144 && rep_ + 1 == REP1) { convert_items(F, CV_EARLY, CV_MID, (F.c - 144) * NWAVES + F.wave, (256 - 144) * NWAVES); __syncthreads(); }
        if (F.c >= 144 && F.c < 144 + 88) { const int v = F.c - 144;
          sgemm_unit<8, 2>(F, ALFrag{WSP(bf16, S_IMGX)}, BRSwiglu{v}, WSP(bf16, WS_W1A), DM, EPSwigluFrag{WSP(bf16, S_H), v, (const float*)(F.ws + WS_CTL) + CW_SSQS}); }
        GRID_BAR();
    }
    if (IN(2)) for (int rep_ = 0; rep_ < REP2; ++rep_) { FRESH();
        { pg8::Gemm g{WSP(bf16, WS_H), WSP(bf16, WS_W1B), MP, DM, FF}; pg8::StaticOrder S; S.init(MP, DM, F.G, F.c);
          const bool dm_ = (rep_ + 1 < REP2); pg8::EpiResid<1, 2> E{WSP(bf16, WS_XB), dm_ ? WSP(bf16, WS_DUMMY + 64 * MiB) : WSP(bf16, WS_XB), nullptr, dm_ ? WSP(float, WS_DUMMY + 96 * MiB) : ssq1, 0.5f};
          KStream<2, 1408> X; X.init(F.ws, F.c, !(rep_ + 1 < REP2), F.wave, F.lane);
          pg8::gemm_phase<pg8::EpiResid<1, 2>, pg8::StaticOrder, true, true, KStream<2, 1408>>(F.lds + RING_OFF, g, S, E, X); }
        if (F.c >= 224) { const int v = F.c - 224; sgemm_unit<11, 1>(F, ALFrag{WSP(bf16, S_H)}, BRPlain32{v}, WSP(bf16, WS_W1B), FF, EPResid<2>{F.ws, F.out, karg<1>(), v}); }
        GRID_BAR();
    }
    if (IN(3)) for (int rep_ = 0; rep_ < REP3; ++rep_) { FRESH();
        { pg8::Gemm g{WSP(bf16, WS_XB), WSP(bf16, WS_WIN), MP, INC, DM}; pg8::StaticOrder S; S.init(MP, INC, F.G, F.c);
          { const int pm0_ = 8 * (F.c & 7) + ((F.c >> 3) & 7);
            const f32x4* src_ = (const f32x4*)(WSP(float, WS_ROPE) + (size_t)((pm0_ * 256) & 2047) * 16); LAS f32x4* dst_ = (LAS f32x4*)(F.lds + ROPE_OFF);
            const f32x4 r0_ = src_[F.tid], r1_ = src_[F.tid + 512]; dst_[F.tid] = r0_; dst_[F.tid + 512] = r1_; }
          __syncthreads();
          pg8::EpiHead<false> E{ssq1, (LAS const float*)(F.lds + ROPE_OFF), F.out, (rep_ + 1 < REP3) ? WSP(float, WS_DUMMY + 96 * MiB) : ksum, F.ws, C2};
          pg8::gemm_phase<pg8::EpiHead<false>, pg8::StaticOrder, true, true>(F.lds + RING_OFF, g, S, E, nostream); }
        if (F.c >= 96 && F.c < 128) { const int v = F.c - 96;
          sgemm_unit<8, 2>(F, ALFrag{WSP(bf16, S_IMGX1)}, BRHead{v}, WSP(bf16, WS_WIN), DM,
                     EPProjS{v, F.ws, F.out, (const float*)(F.ws + WS_CTL) + CW_SSQS + 32}); }
        GRID_BAR();
    }
#ifndef DBG_P4
#define DBG_P4 15
#endif
    if (IN(4)) for (int rep_ = 0; rep_ < REP4; ++rep_) { FRESH();
        if ((DBG_P4 & 8) && ((F.c >> 3) & 3) == 0) { sample_item(F, F.c); if (F.c + 256 < 416) sample_item(F, F.c + 256); }
        FRESH();
        using attn_body::bf16; char* shm = (char*)lds + RING_OFF;
        if (DBG_P4 & 1) { const int bh = F.c >> 2, s = F.c & 3, b = bh >> 3, h = bh & 7;
          const bf16* Qb = (const bf16*)WSP(unsigned short, WS_Q) + (size_t)b * SEQ * 512 + h * 64; const bf16* Kb = (const bf16*)WSP(unsigned short, WS_K) + (size_t)b * SEQ * 512 + h * 64;
          const bf16* Vb = (const bf16*)WSP(unsigned short, WS_V) + (size_t)b * SEQ * 512 + h * 64; bf16* Ob = (bf16*)WSP(unsigned short, WS_MIX) + (size_t)b * SEQ * DM + 256 + h * 64;
          const float* ks = ksum + (size_t)b * 8 * 512 + h * 64;
          LAS unsigned char* selt = (LAS unsigned char*)(F.lds + SM_OFF + 512);
          { const int which = F.tid >> 8, qi = F.tid & 255, qb = which == 0 ? 7 - s : s; unsigned sel = 0x7fu;
            LAS float* ksl = (LAS float*)(F.lds + RING_OFF);
            if (F.tid < 448) ksl[F.tid] = ks[(F.tid >> 6) * 512 + (F.tid & 63)];
            __syncthreads();
            if (qb >= 4) { float sc[7]; float qf[64];
              { const unsigned short* qp = WSP(unsigned short, WS_Q) + ((size_t)b * SEQ + qb * 256 + qi) * 512 + h * 64;
#pragma unroll
                for (int d8 = 0; d8 < 8; ++d8) { const bf16x8 x = *(const bf16x8*)(qp + 8 * d8);
#pragma unroll
                  for (int e = 0; e < 8; ++e) qf[8 * d8 + e] = bfbits2f((unsigned short)x[e]); } }
#pragma unroll
              for (int j = 0; j < 7; ++j) { float a = 0.f; if (j < qb) {
#pragma unroll
                  for (int d4 = 0; d4 < 16; ++d4) { const f32x4 kv = *(const LAS f32x4*)(ksl + j * 64 + 4 * d4); a += (qf[4 * d4] * kv[0] + qf[4 * d4 + 1] * kv[1]) + (qf[4 * d4 + 2] * kv[2] + qf[4 * d4 + 3] * kv[3]); } } else a = -INFINITY;
                sc[j] = a; asm volatile("" : "+v"(a) :: "memory"); }
              sel = 0u;
#pragma unroll
              for (int j = 0; j < 7; ++j) { int cnt = 0;
#pragma unroll
                for (int i = 0; i < 7; ++i) { if (i != j) cnt += ((sc[i] > sc[j]) || (sc[i] == sc[j] && i < j)) ? 1 : 0; }
                if (j < qb && cnt < 3) sel |= (1u << j); } }
            selt[F.tid] = (unsigned char)sel; }
          __syncthreads();
          { const int qb = 7 - s; attn_body::attn_unit<8, 1, 512, 512, DM>(Qb + (size_t)qb * 256 * 512, Kb, Vb, Ob + (size_t)qb * 256 * DM, 4 * qb + 4, selt, shm); }
          { const int qb = s;     attn_body::attn_unit<8, 1, 512, 512, DM>(Qb + (size_t)qb * 256 * 512, Kb, Vb, Ob + (size_t)qb * 256 * DM, 4 * qb + 4, selt + 256, shm); } }
        FRESH();
        if ((DBG_P4 & 8) && ((F.c >> 3) & 3) == 1) { sample_item(F, F.c); if (F.c + 256 < 416) sample_item(F, F.c + 256); }
        FRESH();
        if (DBG_P4 & 2) { const int b = F.c >> 5, hm = (F.c >> 3) & 3, qb = F.c & 7;
          const bf16* Qb = (const bf16*)WSP(unsigned short, WS_QM) + ((size_t)b * SEQ + qb * 256) * 256 + hm * 64; const bf16* Kb = (const bf16*)WSP(unsigned short, WS_MKB) + (size_t)b * MEML * 256 + hm * 64;
          const bf16* Vb = (const bf16*)WSP(unsigned short, WS_MVB) + (size_t)b * MEML * 256 + hm * 64; bf16* Ob = (bf16*)WSP(unsigned short, WS_MIX) + ((size_t)b * SEQ + qb * 256) * DM + 768 + hm * 64;
          attn_body::attn_unit<8, 0, 256, 256, DM>(Qb, Kb, Vb, Ob, 4, nullptr, shm); }
        if ((DBG_P4 & 8) && ((F.c >> 3) & 3) == 2) { sample_item(F, F.c); if (F.c + 256 < 416) sample_item(F, F.c + 256); }
        FRESH();
        if (DBG_P4 & 4) pool_unit(F, F.c >> 2, F.c & 3);
        __syncthreads();
        const int sgrp_ = (F.c >> 3) & 3;
        if ((DBG_P4 & 8) && sgrp_ == 3) { sample_item(F, F.c); if (F.c + 256 < 416) sample_item(F, F.c + 256); }
        GRID_BAR();
    }
    if (IN(5)) for (int rep_ = 0; rep_ < REP5; ++rep_) { FRESH();
        { pg8::Gemm g{WSP(bf16, WS_MIX), WSP(bf16, WS_WOUT), MP, DM, DM}; pg8::StaticOrder S; S.init(MP, DM, F.G, F.c);
          const bool dm_ = (rep_ + 1 < REP5); pg8::EpiResid<1> E{WSP(bf16, WS_XB), dm_ ? WSP(bf16, WS_DUMMY + 64 * MiB) : WSP(bf16, WS_XB), nullptr, dm_ ? WSP(float, WS_DUMMY + 96 * MiB) : ssq2, 1.0f};
          pg8::gemm_phase<pg8::EpiResid<1>, pg8::StaticOrder, true, true>(F.lds + RING_OFF, g, S, E, nostream); }
        if (F.c >= 224) { const int v = F.c - 224; sgemm_unit<8, 1>(F, ALFrag{WSP(bf16, S_IMGMIX)}, BRPlain32{v}, WSP(bf16, WS_WOUT), DM, EPResid<5>{F.ws, F.out, nullptr, v}); }
        GRID_BAR();
    }
    if (IN(6)) for (int rep_ = 0; rep_ < REP6; ++rep_) { FRESH();
        if (F.c >= 128 && rep_ + 1 == REP6) { convert_items(F, CV_MID, CV_ALL, (F.c - 128) * NWAVES + F.wave, 128 * NWAVES); __syncthreads(); }
        FRESH();
        { pg8::Gemm g{WSP(bf16, WS_XB), WSP(bf16, WS_W2A), MP, FF2, DM}; pg8::StaticOrder S; S.init(MP, FF2, F.G, F.c);
          pg8::EpiSwiglu<true> E{WSP(bf16, WS_H), ssq2, FF, {}};
          pg8::gemm_phase<pg8::EpiSwiglu<true>, pg8::StaticOrder, true, true>(F.lds + RING_OFF, g, S, E, nostream); }
        if (F.c >= 144 && F.c < 144 + 88) { const int v = F.c - 144;
          sgemm_unit<8, 2>(F, ALFrag{WSP(bf16, S_IMGX2)}, BRSwiglu{v}, WSP(bf16, WS_W2A), DM, EPSwigluFrag{WSP(bf16, S_H), v, (const float*)(F.ws + WS_CTL) + CW_SSQS + 64}); }
        GRID_BAR();
    }
    if (IN(7)) for (int rep_ = 0; rep_ < REP7; ++rep_) { FRESH();
        { pg8::Gemm g{WSP(bf16, WS_H), WSP(bf16, WS_W2B), MP, DM, FF}; pg8::StaticOrder S; S.init(MP, DM, F.G, F.c);
          pg8::EpiResid<0> E{WSP(bf16, WS_XB), nullptr, F.out + O_Y, nullptr, 0.5f};
          pg8::gemm_phase<pg8::EpiResid<0>, pg8::StaticOrder, true, true>(F.lds + RING_OFF, g, S, E, nostream); }
        if (F.c >= 224) { const int v = F.c - 224; sgemm_unit<11, 1>(F, ALFrag{WSP(bf16, S_H)}, BRPlain32{v}, WSP(bf16, WS_W2B), FF, EPResid<7>{F.ws, F.out, nullptr, v}); }
    }
#undef IN
#undef GRID_BAR
#undef FRESH
#undef rs
#undef ssq1
#undef ssq2
#undef ksum
#undef ssq0
}

extern "C" void kernel_launch(void* const* d_in, const int* in_sizes, int n_in, void* d_out, int out_size, void* d_ws, size_t ws_size, hipStream_t stream) {
    static int grid = 0;
    if (grid == 0) {
        if (n_in != 26 || (size_t)out_size != O_END || ws_size < WS_END + 128 * MiB) { fprintf(stderr, "kernel_launch: shape mismatch (n_in %d, out %d, ws %zu): nothing launched\n", n_in, out_size, ws_size); grid = -1; return; }
        int dev = 0, cus = 0, per_cu = 0;
        if (hipGetDevice(&dev) != hipSuccess || hipDeviceGetAttribute(&cus, hipDeviceAttributeMultiprocessorCount, dev) != hipSuccess) { grid = -1; return; }
        if (hipFuncSetAttribute((const void*)hymba_fwd, hipFuncAttributeMaxDynamicSharedMemorySize, LDS_BYTES) != hipSuccess) { fprintf(stderr, "kernel_launch: hipFuncSetAttribute failed\n"); grid = -1; return; }
        if (hipOccupancyMaxActiveBlocksPerMultiprocessor(&per_cu, (const void*)hymba_fwd, NWAVES * 64, LDS_BYTES) != hipSuccess || per_cu < 1)
            fprintf(stderr, "kernel_launch: note: occupancy query reports %d workgroups per CU\n", per_cu);
        (void)hipGetLastError();
        grid = cus < 256 ? cus : 256;
    }
    if (grid < 0) return;
    if (hipMemsetAsync((char*)d_ws + WS_CTL, 0, CTL_ZERO_BYTES, stream) != hipSuccess) return;
    Args a{};
    for (int i = 0; i < 26; ++i) a.in[i] = (const float*)d_in[i];
    a.out = (float*)d_out; a.ws = (unsigned char*)d_ws;
    for (int li = 0; li < N_LAUNCHES; ++li) {
        a.ph_lo = (N_LAUNCHES == 1) ? 0 : li; a.ph_hi = (N_LAUNCHES == 1) ? PER_PHASE : li + 1;
        hipLaunchKernelGGL(hymba_fwd, dim3(grid), dim3(NWAVES * 64), LDS_BYTES, stream, a);
        const hipError_t le = hipPeekAtLastError();
        if (le != hipSuccess) { fprintf(stderr, "kernel_launch: launch %d failed: %s\n", li, hipGetErrorName(le)); break; }
    }
}
```
